# Optimizing an MI355X kernel written in HIP

```python
import jax, jax.numpy as jnp
from jax import lax
import numpy as np

D_MODEL = 2048
BATCH = 16
SEQ = 2048
DEPTH = 4

HEAD_DIM = 128
MIX_WIDTH = D_MODEL
N_HEADS_NSA = MIX_WIDTH // (2 * HEAD_DIM)
N_KV_NSA = 2
GQA_GROUP = N_HEADS_NSA // N_KV_NSA
N_HEADS_FOX = MIX_WIDTH // (2 * HEAD_DIM)
NSA_WIDTH = N_HEADS_NSA * HEAD_DIM
FOX_WIDTH = N_HEADS_FOX * HEAD_DIM
ROPE_DIM = HEAD_DIM // 4
ROPE_THETA = 500000.0
CMP_BLOCK = 32
CMP_STRIDE = 16
CMP_HIDDEN = 256
SLC_BLOCK = 64
SLC_TOPK = 8
N_LOCAL_SLC = 2
WINDOW = 512
Q_BLOCK = 128
SLC_Q_CHUNK = 32
D_FF = 5632
EPS = 1e-6
NEG_INF = -1e30
FORCED_SCORE = 1e9
N_NSA_BRANCHES = 3
COLS_NSA_Q = NSA_WIDTH
COLS_NSA_KV = N_NSA_BRANCHES * 2 * N_KV_NSA * HEAD_DIM
COLS_NSA_GATE = N_NSA_BRANCHES * N_HEADS_NSA
COLS_FOX_QKV = 3 * FOX_WIDTH
COLS_FOX_F = N_HEADS_FOX
PROJ_COLS = COLS_NSA_Q + COLS_NSA_KV + COLS_NSA_GATE + COLS_FOX_QKV + COLS_FOX_F
SPLITS = (COLS_NSA_Q,
          COLS_NSA_Q + COLS_NSA_KV,
          COLS_NSA_Q + COLS_NSA_KV + COLS_NSA_GATE,
          COLS_NSA_Q + COLS_NSA_KV + COLS_NSA_GATE + COLS_FOX_QKV)

kernel_name = "hymba_nsa_fox_macaron"


def rms_norm(x, g):
    xf = x.astype(jnp.float32)
    y = xf * lax.rsqrt(jnp.mean(xf * xf, axis=-1, keepdims=True) + EPS)
    return (y * g.astype(jnp.float32)).astype(x.dtype)


def swiglu(h, w_gate, w_up, w_down):
    return (jax.nn.silu(h @ w_gate) * (h @ w_up)) @ w_down


def rope_tables(pos):
    inv = ROPE_THETA ** (-jnp.arange(0, ROPE_DIM, 2, dtype=jnp.float32) / ROPE_DIM)
    ang = pos.astype(jnp.float32)[:, None] * inv[None, :]
    return jnp.cos(ang), jnp.sin(ang)


def partial_rope(x, cos, sin):
    half = ROPE_DIM // 2
    shape = (1, cos.shape[0]) + (1,) * (x.ndim - 3) + (half,)
    c = cos.reshape(shape).astype(x.dtype)
    s = sin.reshape(shape).astype(x.dtype)
    x1, x2, xp = x[..., :half], x[..., half:ROPE_DIM], x[..., ROPE_DIM:]
    return jnp.concatenate([x1 * c - x2 * s, x2 * c + x1 * s, xp], axis=-1)


def masked_probs(s, mask):
    s = jnp.where(mask, s, NEG_INF)
    m = jnp.max(s, axis=-1, keepdims=True)
    p = jnp.where(mask, jnp.exp(s - m), 0.0)
    return p / jnp.maximum(jnp.sum(p, axis=-1, keepdims=True), 1e-30)


def to_blocks(a, size):
    return a.reshape((a.shape[0], a.shape[1] // size, size) + a.shape[2:]).swapaxes(0, 1)


def from_blocks(a):
    a = a.swapaxes(0, 1)
    return a.reshape((a.shape[0], a.shape[1] * a.shape[2]) + a.shape[3:])


def compress_blocks(k, cmp_idx, pos_emb, w1, w2):
    B = k.shape[0]
    n_cmp = cmp_idx.shape[0]
    blocks = k[:, cmp_idx] + pos_emb[None, None, :, None, :]
    blocks = blocks.transpose(0, 1, 3, 2, 4).reshape(B, n_cmp, N_KV_NSA, CMP_BLOCK * HEAD_DIM)
    return jax.nn.gelu(blocks @ w1) @ w2


def nsa_attention(q, k_c, v_c, k_s, v_s, k_w, v_w, gates, k_norm, cmp_pos_emb, cmp_w1, cmp_w2):
    B, T = q.shape[:2]
    scale = HEAD_DIM ** -0.5
    pos = jnp.arange(T)
    cos, sin = rope_tables(pos)

    n_cmp = (T - CMP_BLOCK) // CMP_STRIDE + 1
    cmp_start = np.arange(n_cmp) * CMP_STRIDE
    cmp_idx = cmp_start[:, None] + np.arange(CMP_BLOCK)[None, :]
    cmp_end = cmp_start + CMP_BLOCK - 1
    kc = compress_blocks(k_c, cmp_idx, cmp_pos_emb[0], cmp_w1[0], cmp_w2[0])
    vc = compress_blocks(v_c, cmp_idx, cmp_pos_emb[1], cmp_w1[1], cmp_w2[1])
    cos_c, sin_c = rope_tables(jnp.asarray(cmp_end))
    kc = partial_rope(rms_norm(kc, k_norm[0]), cos_c, sin_c)
    s_c = jnp.einsum('btkgd,bckd->bkgtc', q, kc, preferred_element_type=jnp.float32) * scale
    p_c = masked_probs(s_c, jnp.asarray(cmp_end)[None, :] <= pos[:, None])
    o_cmp = jnp.einsum('bkgtc,bckd->btkgd', p_c.astype(vc.dtype), vc)

    n_slc = T // SLC_BLOCK
    top_n = min(SLC_TOPK, n_slc)
    slc_start = np.arange(n_slc) * SLC_BLOCK
    overlap = ((cmp_start[:, None] < slc_start[None, :] + SLC_BLOCK)
               & (cmp_start[:, None] + CMP_BLOCK > slc_start[None, :])).astype(np.float32)
    imp = jnp.einsum('bkgtc,cj->btkj', p_c, jnp.asarray(overlap))
    t_blk = pos // SLC_BLOCK
    j = jnp.arange(n_slc)
    causal_blk = j[None, :] <= t_blk[:, None]
    forced = (j[None, :] == 0) | (causal_blk & (j[None, :] > t_blk[:, None] - N_LOCAL_SLC))
    score = jnp.where(forced[None, :, None, :], FORCED_SCORE,
                      jnp.where(causal_blk[None, :, None, :], imp, NEG_INF))
    _, sel = lax.top_k(score, top_n)

    s_norm = rms_norm(k_s, k_norm[1])
    k_s = partial_rope(s_norm, cos, sin)
    kb = k_s.reshape(B, n_slc, SLC_BLOCK, N_KV_NSA, HEAD_DIM).transpose(0, 3, 1, 2, 4)
    vb = v_s.reshape(B, n_slc, SLC_BLOCK, N_KV_NSA, HEAD_DIM).transpose(0, 3, 1, 2, 4)
    b_idx = jnp.arange(B)[:, None, None, None]
    h_idx = jnp.arange(N_KV_NSA)[None, None, :, None]
    n_keys = top_n * SLC_BLOCK

    def slc_chunk(args):
        q_c, sel_c, t_c = args
        kg = kb[b_idx, h_idx, sel_c].reshape(B, SLC_Q_CHUNK, N_KV_NSA, n_keys, HEAD_DIM)
        vg = vb[b_idx, h_idx, sel_c].reshape(B, SLC_Q_CHUNK, N_KV_NSA, n_keys, HEAD_DIM)
        kpos = (sel_c[..., None] * SLC_BLOCK + jnp.arange(SLC_BLOCK)).reshape(B, SLC_Q_CHUNK, N_KV_NSA, n_keys)
        mask = (kpos <= t_c[None, :, None, None])[:, :, :, None, :]
        s = jnp.einsum('bckgd,bckjd->bckgj', q_c, kg, preferred_element_type=jnp.float32) * scale
        p = masked_probs(s, mask)
        return jnp.einsum('bckgj,bckjd->bckgd', p.astype(vg.dtype), vg)

    o_slc = from_blocks(lax.map(slc_chunk, (to_blocks(q, SLC_Q_CHUNK), to_blocks(sel, SLC_Q_CHUNK),
                                            pos.reshape(-1, SLC_Q_CHUNK))))

    k_w = partial_rope(rms_norm(k_w, k_norm[2]), cos, sin)
    kp = jnp.pad(k_w, ((0, 0), (WINDOW, 0), (0, 0), (0, 0)))
    vp = jnp.pad(v_w, ((0, 0), (WINDOW, 0), (0, 0), (0, 0)))
    band = WINDOW + Q_BLOCK

    def win_block(args):
        q_b, qb = args
        start = qb * Q_BLOCK
        k_b = lax.dynamic_slice_in_dim(kp, start, band, axis=1)
        v_b = lax.dynamic_slice_in_dim(vp, start, band, axis=1)
        kpos = start - WINDOW + jnp.arange(band)
        tq = start + jnp.arange(Q_BLOCK)
        mask = ((kpos[None, :] <= tq[:, None]) & (kpos[None, :] > tq[:, None] - WINDOW)
                & (kpos[None, :] >= 0))
        s = jnp.einsum('bqkgd,bskd->bkgqs', q_b, k_b, preferred_element_type=jnp.float32) * scale
        p = masked_probs(s, mask)
        return jnp.einsum('bkgqs,bskd->bqkgd', p.astype(v_b.dtype), v_b)

    o_win = from_blocks(lax.map(win_block, (to_blocks(q, Q_BLOCK), jnp.arange(T // Q_BLOCK))))

    return gates[..., 0:1] * o_cmp + gates[..., 1:2] * o_slc + gates[..., 2:3] * o_win


def forgetting_attention(q, k, v, log_f):
    T = q.shape[1]
    scale = HEAD_DIM ** -0.5
    c = jnp.cumsum(log_f, axis=1)
    c_keys = c.transpose(0, 2, 1)
    pos = jnp.arange(T)

    def block(args):
        q_b, c_b, t_b = args
        s = jnp.einsum('bqhd,bshd->bhqs', q_b, k, preferred_element_type=jnp.float32) * scale
        s = s + c_b.transpose(0, 2, 1)[..., None] - c_keys[:, :, None, :]
        p = masked_probs(s, pos[None, :] <= t_b[:, None])
        return jnp.einsum('bhqs,bshd->bqhd', p.astype(v.dtype), v)

    return from_blocks(lax.map(block, (to_blocks(q, Q_BLOCK), to_blocks(c, Q_BLOCK),
                                       pos.reshape(-1, Q_BLOCK))))


def hybrid_mixer(h, w_in, nsa_q_norm, nsa_k_norm, cmp_pos_emb, cmp_w1, cmp_w2, nsa_out_norm,
                 fox_q_norm, fox_k_norm, fox_forget_bias, fox_out_norm, w_out):
    B, T, _ = h.shape
    proj = h @ w_in
    q_n, kv_n, gate_n, fox_qkv, fox_f = jnp.split(proj, SPLITS, axis=-1)

    cos, sin = rope_tables(jnp.arange(T))
    q = q_n.reshape(B, T, N_KV_NSA, GQA_GROUP, HEAD_DIM)
    q = partial_rope(rms_norm(q, nsa_q_norm), cos, sin)
    kv = kv_n.reshape(B, T, N_NSA_BRANCHES, 2, N_KV_NSA, HEAD_DIM)
    gates = jax.nn.sigmoid(gate_n.astype(jnp.float32)).astype(h.dtype)
    gates = gates.reshape(B, T, N_KV_NSA, GQA_GROUP, N_NSA_BRANCHES)
    o_nsa = nsa_attention(q, kv[:, :, 0, 0], kv[:, :, 0, 1], kv[:, :, 1, 0], kv[:, :, 1, 1],
                          kv[:, :, 2, 0], kv[:, :, 2, 1], gates, nsa_k_norm,
                          cmp_pos_emb, cmp_w1, cmp_w2)
    o_nsa = rms_norm(o_nsa.reshape(B, T, NSA_WIDTH), nsa_out_norm)

    fqkv = fox_qkv.reshape(B, T, 3, N_HEADS_FOX, HEAD_DIM)
    fq = rms_norm(fqkv[:, :, 0], fox_q_norm)
    fk = rms_norm(fqkv[:, :, 1], fox_k_norm)
    log_f = jax.nn.log_sigmoid(fox_f.astype(jnp.float32) + fox_forget_bias.astype(jnp.float32))
    o_fox = forgetting_attention(fq, fk, fqkv[:, :, 2], log_f)
    o_fox = rms_norm(o_fox.reshape(B, T, FOX_WIDTH), fox_out_norm)

    return jnp.concatenate([o_nsa, o_fox], axis=-1) @ w_out


def setup_inputs(seed: int = 0) -> dict:
    key = jax.random.key(seed)
    ks = iter(jax.random.split(key, 32))

    def nrm(shape, scale):
        return scale * jax.random.normal(next(ks), shape, jnp.float32)

    def gain(shape):
        return 1.0 + 0.02 * jax.random.normal(next(ks), shape, jnp.float32)

    L = DEPTH
    return {
        "x": nrm((BATCH, SEQ, D_MODEL), 1.0),
        "ffn1_norm": gain((L, D_MODEL)),
        "ffn1_w_gate": nrm((L, D_MODEL, D_FF), D_MODEL ** -0.5),
        "ffn1_w_up": nrm((L, D_MODEL, D_FF), D_MODEL ** -0.5),
        "ffn1_w_down": nrm((L, D_FF, D_MODEL), D_FF ** -0.5),
        "mix_norm": gain((L, D_MODEL)),
        "w_in": nrm((L, D_MODEL, PROJ_COLS), D_MODEL ** -0.5),
        "nsa_q_norm": gain((L, HEAD_DIM)),
        "nsa_k_norm": gain((L, N_NSA_BRANCHES, HEAD_DIM)),
        "cmp_pos_emb": nrm((L, 2, CMP_BLOCK, HEAD_DIM), 0.1),
        "cmp_w1": nrm((L, 2, CMP_BLOCK * HEAD_DIM, CMP_HIDDEN), (CMP_BLOCK * HEAD_DIM) ** -0.5),
        "cmp_w2": nrm((L, 2, CMP_HIDDEN, HEAD_DIM), CMP_HIDDEN ** -0.5),
        "nsa_out_norm": gain((L, NSA_WIDTH)),
        "fox_q_norm": gain((L, HEAD_DIM)),
        "fox_k_norm": gain((L, HEAD_DIM)),
        "fox_forget_bias": jnp.linspace(1.0, 5.0, N_HEADS_FOX, dtype=jnp.float32)[None, :]
                           + nrm((L, N_HEADS_FOX), 0.1),
        "fox_out_norm": gain((L, FOX_WIDTH)),
        "w_out": nrm((L, MIX_WIDTH, D_MODEL), MIX_WIDTH ** -0.5),
        "ffn2_norm": gain((L, D_MODEL)),
        "ffn2_w_gate": nrm((L, D_MODEL, D_FF), D_MODEL ** -0.5),
        "ffn2_w_up": nrm((L, D_MODEL, D_FF), D_MODEL ** -0.5),
        "ffn2_w_down": nrm((L, D_FF, D_MODEL), D_FF ** -0.5),
    }


def reference(x, ffn1_norm, ffn1_w_gate, ffn1_w_up, ffn1_w_down, mix_norm, w_in, nsa_q_norm,
              nsa_k_norm, cmp_pos_emb, cmp_w1, cmp_w2, nsa_out_norm, fox_q_norm, fox_k_norm,
              fox_forget_bias, fox_out_norm, w_out, ffn2_norm, ffn2_w_gate, ffn2_w_up, ffn2_w_down):
    for i in range(DEPTH):
        x = x + 0.5 * swiglu(rms_norm(x, ffn1_norm[i]), ffn1_w_gate[i], ffn1_w_up[i], ffn1_w_down[i])
        x = x + hybrid_mixer(rms_norm(x, mix_norm[i]), w_in[i], nsa_q_norm[i], nsa_k_norm[i],
                             cmp_pos_emb[i], cmp_w1[i], cmp_w2[i], nsa_out_norm[i],
                             fox_q_norm[i], fox_k_norm[i], fox_forget_bias[i], fox_out_norm[i], w_out[i])
        x = x + 0.5 * swiglu(rms_norm(x, ffn2_norm[i]), ffn2_w_gate[i], ffn2_w_up[i], ffn2_w_down[i])
    return x
```

```cpp
#include <hip/hip_runtime.h>
#include <cstdio>
#include <cstdint>

#define GAS __attribute__((address_space(1)))
#define LAS __attribute__((address_space(3)))
typedef unsigned short bf16_t;
typedef short bf16x8 __attribute__((ext_vector_type(8)));
typedef short s16x4 __attribute__((ext_vector_type(4)));
typedef float f32x4 __attribute__((ext_vector_type(4)));
typedef float f32x2 __attribute__((ext_vector_type(2)));
typedef float f32x16 __attribute__((ext_vector_type(16)));
typedef unsigned u32x4 __attribute__((ext_vector_type(4)));
typedef unsigned u32x2 __attribute__((ext_vector_type(2)));

constexpr int NB = 16, T = 2048, DM = 2048, M = NB * T, NL = 4, HD = 128, DFF = 5632;
constexpr int LDP = 5632;
constexpr int PROJ_COLS = 5664, NWIN = 5888;
constexpr int C_KV = 1024, C_FQ = 2560, C_FK = 3584, C_FV = 4608;
constexpr int NCMP = 127;
constexpr float EPS = 1e-6f;
constexpr float LOG2E = 1.4426950408889634f;
constexpr float C2 = 0.08838834764831845f * 1.4426950408889634f;

constexpr size_t MiB = 1u << 20;
constexpr size_t WS_CTL = 0, CTL_ZERO_BYTES = 1 * MiB;
constexpr size_t WS_ROPE = 1 * MiB;
constexpr size_t WS_CUM = 2 * MiB;
constexpr size_t WS_GF = 3 * MiB;
constexpr size_t WS_KC = 7 * MiB;
constexpr size_t WS_VC = 8 * MiB;
constexpr size_t WS_CMPH = 9 * MiB;
constexpr size_t WS_WGU = 16 * MiB;
constexpr size_t WS_WD = 60 * MiB;
constexpr size_t WS_WIN = 82 * MiB;
constexpr size_t WS_WOUT = 105 * MiB;
constexpr size_t WS_WGU2 = 113 * MiB;
constexpr size_t WS_WD2 = 157 * MiB;
constexpr size_t WS_WC1 = 179 * MiB;
constexpr size_t WS_CMPA = 184 * MiB;
constexpr size_t WS_HN = 248 * MiB;
constexpr size_t WS_HID = 376 * MiB;
constexpr size_t WS_NSA0 = 728 * MiB, WS_NSA1 = 792 * MiB, WS_NSA2 = 856 * MiB;
constexpr size_t WS_END = 920 * MiB;
constexpr int CW_BAR = 4096;

constexpr int RING_BYTES = 131072;
constexpr int LDSCTL_OFF = RING_BYTES, MISC_OFF = LDSCTL_OFF + 320;
constexpr int LDS_BYTES = 147456;

namespace pg8 {
#define PG8_LAS __attribute__((address_space(3)))
constexpr int BM = 256, BK = 64, HALF = 128, HTB = HALF * BK * 2, STAGE_BYTES = 8 * HTB, NXCD = 8, WGM = 8;
__host__ __device__ __forceinline__ int lds_byte(int r, int c) { const int st = (r >> 4) * 2 + (c >> 5), rr = r & 15, cc = c & 31, ob = rr * 64 + cc * 2; return st * 1024 + (ob ^ (((ob >> 9) & 1) << 5)); }
__host__ __device__ __forceinline__ void stage_rc(int b, int& R, int& C) { const int st = b / 1024, sb = b % 1024, swz = sb ^ (((sb >> 9) & 1) << 5); R = (st >> 1) * 16 + swz / 64; C = (st & 1) * 32 + (swz % 64) / 2; }
__host__ __device__ __forceinline__ int perm32(int rho) { const int n = rho >> 4, i = rho & 15; return 8 * (i >> 2) + 4 * n + (i & 3); }
struct Unit { int pm, pn; };
struct Gemm { const bf16_t* A; const bf16_t* Bt; int M, N, K; };
struct StaticOrder {
    int nM, nN, nwg, G, c;
    __host__ __device__ void init(int M_, int N_, int G_, int c_) { nM = M_ / BM; nN = N_ / BM; nwg = nM * nN; G = G_; c = c_; }
    __host__ __device__ bool next(int i, Unit& u) const {
        const long L = (long)i * G + c; if (L >= nwg) return false;
        int wgid = (int)L; { const int q = nwg / NXCD, r = nwg % NXCD, xcd = wgid % NXCD, off = wgid / NXCD; wgid = (xcd < r ? xcd * (q + 1) : r * (q + 1) + (xcd - r) * q) + off; }
        const int nig = WGM * nN, gid = wgid / nig, fm = gid * WGM, gsz = (nM - fm) < WGM ? (nM - fm) : WGM;
        u.pm = fm + ((wgid % nig) % gsz); u.pn = (wgid % nig) / gsz; return true;
    }
    __device__ __forceinline__ void a_ready(const Unit&) const {}
    __device__ __forceinline__ void done(const Unit&) const {}
};
struct CmpOrder {
    int G, c;
    __device__ bool next(int i, Unit& u) const { const int L = i * G + c; if (L >= 32) return false; u.pm = L; u.pn = L >> 4; return true; }
    __device__ __forceinline__ void a_ready(const Unit&) const {}
    __device__ __forceinline__ void done(const Unit&) const {}
};
__device__ __forceinline__ unsigned cvt_pk_bf16(float lo, float hi) { unsigned r; asm volatile("v_cvt_pk_bf16_f32 %0, %1, %2" : "=v"(r) : "v"(lo), "v"(hi)); return r; }

__device__ __forceinline__ float silu_f(float g) { return g * __builtin_amdgcn_rcpf(1.0f + __builtin_amdgcn_exp2f(-g * LOG2E)); }
struct EpiSwiglu {
    static constexpr bool PERM = true, AFTER_DRAIN = false;
    bf16_t* O; int ldc;
    __device__ __forceinline__ void operator()(const f32x4 (&acc)[2][2][4][2], const Unit& u, int wr, int wc, int fr, int fq) const {
        const int row0 = u.pm * BM + wr * 64 + fr, col0 = u.pn * HALF + wc * 32 + 8 * fq;
#pragma unroll
        for (int ai = 0; ai < 2; ++ai)
#pragma unroll
            for (int m = 0; m < 4; ++m) { bf16_t* rowp = O + (size_t)(row0 + ai * HALF + m * 16) * ldc + col0;
                const f32x4 g0 = acc[ai][0][m][0], g1 = acc[ai][0][m][1], u0 = acc[ai][1][m][0], u1 = acc[ai][1][m][1];
                u32x4 w;
                w.x = cvt_pk_bf16(silu_f(g0[0]) * u0[0], silu_f(g0[1]) * u0[1]); w.y = cvt_pk_bf16(silu_f(g0[2]) * u0[2], silu_f(g0[3]) * u0[3]);
                w.z = cvt_pk_bf16(silu_f(g1[0]) * u1[0], silu_f(g1[1]) * u1[1]); w.w = cvt_pk_bf16(silu_f(g1[2]) * u1[2], silu_f(g1[3]) * u1[3]);
                *(u32x4*)rowp = w; }
    }
};
struct EpiResid {
    static constexpr bool PERM = false, AFTER_DRAIN = false;
    const float* base; float* out; int ldc; float scale;
    __device__ __forceinline__ void operator()(const f32x4 (&acc)[2][2][4][2], const Unit& u, int wr, int wc, int fr, int fq) const {
        const int row0 = u.pm * BM + wr * 64 + fr, col0 = u.pn * BM + wc * 32 + 4 * fq;
#pragma unroll
        for (int ai = 0; ai < 2; ++ai)
#pragma unroll
            for (int mp = 0; mp < 2; ++mp) {
                f32x4 bs[2][2][2];
#pragma unroll
                for (int mm = 0; mm < 2; ++mm) { const size_t off = (size_t)(row0 + ai * HALF + (2 * mp + mm) * 16) * ldc + col0;
#pragma unroll
                    for (int bj = 0; bj < 2; ++bj)
#pragma unroll
                        for (int n = 0; n < 2; ++n) bs[mm][bj][n] = *(const f32x4*)(base + off + bj * HALF + n * 16); }
                __builtin_amdgcn_sched_barrier(0);
#pragma unroll
                for (int mm = 0; mm < 2; ++mm) { const size_t off = (size_t)(row0 + ai * HALF + (2 * mp + mm) * 16) * ldc + col0;
#pragma unroll
                    for (int bj = 0; bj < 2; ++bj)
#pragma unroll
                        for (int n = 0; n < 2; ++n) *(f32x4*)(out + off + bj * HALF + n * 16) = bs[mm][bj][n] + acc[ai][bj][2 * mp + mm][n] * scale; }
                __builtin_amdgcn_sched_barrier(0);
            }
    }
};
struct EpiProj {
    static constexpr bool PERM = true, AFTER_DRAIN = false;
    bf16_t* O; int ldc; float* GF;
    __device__ __forceinline__ void operator()(const f32x4 (&acc)[2][2][4][2], const Unit& u, int wr, int wc, int fr, int fq) const {
        const int row0 = u.pm * BM + wr * 64 + fr;
        if (u.pn < 22) {
            const int col0 = u.pn * BM + wc * 32 + 8 * fq;
#pragma unroll
            for (int ai = 0; ai < 2; ++ai)
#pragma unroll
                for (int m = 0; m < 4; ++m) { bf16_t* rowp = O + (size_t)(row0 + ai * HALF + m * 16) * ldc + col0;
#pragma unroll
                    for (int bj = 0; bj < 2; ++bj) { const f32x4 v0 = acc[ai][bj][m][0], v1 = acc[ai][bj][m][1];
                        u32x4 w; w.x = cvt_pk_bf16(v0[0], v0[1]); w.y = cvt_pk_bf16(v0[2], v0[3]); w.z = cvt_pk_bf16(v1[0], v1[1]); w.w = cvt_pk_bf16(v1[2], v1[3]);
                        *(u32x4*)(rowp + bj * HALF) = w; } }
        } else if (wc == 0) {
#pragma unroll
            for (int ai = 0; ai < 2; ++ai)
#pragma unroll
                for (int m = 0; m < 4; ++m) { float* rowp = GF + (size_t)(row0 + ai * HALF + m * 16) * 32 + 8 * fq;
                    *(f32x4*)rowp = acc[ai][0][m][0]; *(f32x4*)(rowp + 4) = acc[ai][0][m][1]; }
        }
    }
};
__device__ __forceinline__ float gelu_tanh_f(float x) {
    const float u2 = 1.5957691216057308f * (x + 0.044715f * x * x * x);
    return x * __builtin_amdgcn_rcpf(1.0f + __builtin_amdgcn_exp2f(-u2 * LOG2E));
}
struct EpiGeluCmp {
    static constexpr bool PERM = true, AFTER_DRAIN = false;
    bf16_t* O;
    __device__ __forceinline__ void operator()(const f32x4 (&acc)[2][2][4][2], const Unit& u, int wr, int wc, int fr, int fq) const {
        const int row0 = u.pm * BM + wr * 64 + fr, col0 = wc * 32 + 8 * fq;
#pragma unroll
        for (int ai = 0; ai < 2; ++ai)
#pragma unroll
            for (int m = 0; m < 4; ++m) { bf16_t* rowp = O + (size_t)(row0 + ai * HALF + m * 16) * 256 + col0;
#pragma unroll
                for (int bj = 0; bj < 2; ++bj) { const f32x4 v0 = acc[ai][bj][m][0], v1 = acc[ai][bj][m][1];
                    u32x4 w; w.x = cvt_pk_bf16(gelu_tanh_f(v0[0]), gelu_tanh_f(v0[1])); w.y = cvt_pk_bf16(gelu_tanh_f(v0[2]), gelu_tanh_f(v0[3]));
                    w.z = cvt_pk_bf16(gelu_tanh_f(v1[0]), gelu_tanh_f(v1[1])); w.w = cvt_pk_bf16(gelu_tanh_f(v1[2]), gelu_tanh_f(v1[3]));
                    *(u32x4*)(rowp + bj * HALF) = w; } }
    }
};

template <class Epi, class Sched, bool ALIGN_EPI = false, bool SP2 = false>
__device__ __forceinline__ void gemm_phase(PG8_LAS unsigned char* lds, const Gemm g, const Sched& S, const Epi& E, const int tid) {
    const int wid = __builtin_amdgcn_readfirstlane(tid >> 6), lane = tid & 63, wr = wid >> 2, wc = wid & 3, fr = lane & 15, fq = lane >> 4;
    const int K = g.K, nt = K / BK;
    unsigned voffA[2], voffB[2];
#pragma unroll
    for (int i = 0; i < 2; ++i) { int R, C; stage_rc(tid * 16 + i * 8192, R, C); const int Rb = Epi::PERM ? ((R & ~31) + perm32(R & 31)) : R;
        voffA[i] = (unsigned)(R * K + C) * 2u; voffB[i] = (unsigned)(Rb * K + C) * 2u; }
    const size_t kstep = (size_t)(BK * 2);
    const size_t hstep = (size_t)HALF * K * 2;
    const size_t tstep = 2 * hstep;
    const unsigned ldsw = (unsigned)wid * 1024u;
    const int aoff = lds_byte(wr * 64 + fr, fq * 8), boff = lds_byte(wc * 32 + fr, fq * 8);
#define PG8_SA(b, h) (((b) * 2 + (h)) * HTB)
#define PG8_SB(b, h) ((4 + (b) * 2 + (h)) * HTB)
#define PG8_STAGE(bufoff, gbase, voff) do { _Pragma("unroll") for (int _i = 0; _i < 2; ++_i) \
        __builtin_amdgcn_global_load_lds((const unsigned*)((const char*)(gbase) + (voff)[_i]), (PG8_LAS unsigned*)(lds + (bufoff) + ldsw + _i * 8192), 16, 0, 0); } while (0)
#define PG8_LDA(dst, b, h) do { _Pragma("unroll") for (int m = 0; m < 4; ++m) _Pragma("unroll") for (int k = 0; k < 2; ++k) dst[m][k] = *(const PG8_LAS bf16x8*)(lds + PG8_SA(b, h) + aoff + m * 2048 + k * 1024); } while (0)
#define PG8_LDB(dst, b, h) do { _Pragma("unroll") for (int n = 0; n < 2; ++n) _Pragma("unroll") for (int k = 0; k < 2; ++k) dst[n][k] = *(const PG8_LAS bf16x8*)(lds + PG8_SB(b, h) + boff + n * 2048 + k * 1024); } while (0)
#define PG8_MMA(ai, bj, At, Bt) do { __builtin_amdgcn_s_setprio(1); _Pragma("unroll") for (int m = 0; m < 4; ++m) _Pragma("unroll") for (int n = 0; n < 2; ++n) _Pragma("unroll") for (int k = 0; k < 2; ++k) \
        acc[ai][bj][m][n] = __builtin_amdgcn_mfma_f32_16x16x32_bf16(Bt[n][k], At[m][k], acc[ai][bj][m][n], 0, 0, 0); __builtin_amdgcn_s_setprio(0); } while (0)
#define PG8_WAIT_V(n) asm volatile("s_waitcnt vmcnt(" #n ")" ::: "memory")
#define PG8_WAIT_L(n) asm volatile("s_waitcnt lgkmcnt(" #n ")" ::: "memory")
#define PG8_BAR __builtin_amdgcn_s_barrier()
#define PG8_SCHED __builtin_amdgcn_sched_barrier(0)
    Unit cur, nxt; int ui = 0;
    if (!S.next(0, cur)) return;
    f32x4 acc[2][2][4][2];
#pragma unroll
    for (int a = 0; a < 2; ++a)
#pragma unroll
        for (int b = 0; b < 2; ++b)
#pragma unroll
            for (int m = 0; m < 4; ++m)
#pragma unroll
                for (int n = 0; n < 2; ++n) acc[a][b][m][n] = (f32x4){0.f, 0.f, 0.f, 0.f};
    bf16x8 At[4][2], B0[2][2], B1[2][2];
    const char* cA = (const char*)g.A + (size_t)cur.pm * tstep; const char* cB = (const char*)g.Bt + (size_t)cur.pn * tstep;
    S.a_ready(cur);
    if constexpr (SP2) {
        PG8_STAGE(PG8_SB(0, 0), cB, voffB); PG8_STAGE(PG8_SB(0, 1), cB + hstep, voffB); PG8_STAGE(PG8_SA(0, 0), cA, voffA); PG8_STAGE(PG8_SA(0, 1), cA + hstep, voffA);
        if (wr == 1) PG8_BAR;
        PG8_WAIT_V(2); PG8_BAR;
        PG8_STAGE(PG8_SB(1, 0), cB + kstep, voffB); PG8_STAGE(PG8_SA(1, 0), cA + kstep, voffA); PG8_STAGE(PG8_SB(1, 1), cB + hstep + kstep, voffB);
        PG8_WAIT_V(6); PG8_BAR;
    } else {
        PG8_STAGE(PG8_SB(0, 0), cB, voffB); PG8_STAGE(PG8_SA(0, 0), cA, voffA); PG8_STAGE(PG8_SB(0, 1), cB + hstep, voffB); PG8_STAGE(PG8_SA(0, 1), cA + hstep, voffA);
        if (wr == 1) PG8_BAR;
        PG8_WAIT_V(4); PG8_BAR;
        PG8_STAGE(PG8_SB(1, 0), cB + kstep, voffB); PG8_STAGE(PG8_SA(1, 0), cA + kstep, voffA); PG8_STAGE(PG8_SB(1, 1), cB + hstep + kstep, voffB);
        PG8_WAIT_V(6); PG8_BAR;
    }
    for (;;) {
        const bool has_next = S.next(ui + 1, nxt);
        const char* nA = has_next ? (const char*)g.A + (size_t)nxt.pm * tstep : cA; const char* nB = has_next ? (const char*)g.Bt + (size_t)nxt.pn * tstep : cB;
        for (int t = 0; t < nt; t += 2) {
            const bool last = (t == nt - 2);
            const char* a1 = cA + (size_t)(t + 1) * kstep;
            const char* a2 = last ? nA : cA + (size_t)(t + 2) * kstep; const char* b2 = last ? nB : cB + (size_t)(t + 2) * kstep;
            const char* a3 = a2 + kstep; const char* b3 = b2 + kstep;
            if (last && has_next) S.a_ready(nxt);
            if constexpr (SP2) {
            PG8_LDB(B0, 0, 0); PG8_LDB(B1, 0, 1); PG8_SCHED; PG8_LDA(At, 0, 0); PG8_STAGE(PG8_SA(1, 1), a1 + hstep, voffA);
            PG8_WAIT_V(8); PG8_WAIT_L(0); PG8_BAR; PG8_MMA(0, 0, At, B0); PG8_MMA(0, 1, At, B1); PG8_BAR; PG8_SCHED;
            PG8_LDA(At, 0, 1); PG8_STAGE(PG8_SB(0, 0), b2, voffB); PG8_STAGE(PG8_SB(0, 1), b2 + hstep, voffB); PG8_STAGE(PG8_SA(0, 0), a2, voffA);
            PG8_WAIT_V(8); PG8_WAIT_L(0); PG8_BAR; PG8_MMA(1, 0, At, B0); PG8_MMA(1, 1, At, B1); PG8_BAR; PG8_SCHED;
            PG8_LDB(B0, 1, 0); PG8_LDB(B1, 1, 1); PG8_SCHED; PG8_LDA(At, 1, 0); PG8_STAGE(PG8_SA(0, 1), a2 + hstep, voffA);
            PG8_WAIT_V(8); PG8_WAIT_L(0); PG8_BAR; PG8_MMA(0, 0, At, B0); PG8_MMA(0, 1, At, B1); PG8_BAR; PG8_SCHED;
            PG8_LDA(At, 1, 1); PG8_STAGE(PG8_SB(1, 0), b3, voffB); PG8_STAGE(PG8_SB(1, 1), b3 + hstep, voffB); PG8_STAGE(PG8_SA(1, 0), a3, voffA);
            PG8_WAIT_V(8); PG8_WAIT_L(0); PG8_BAR; PG8_MMA(1, 0, At, B0); PG8_MMA(1, 1, At, B1); PG8_BAR; PG8_SCHED;
            } else {
            PG8_LDB(B0, 0, 0); PG8_SCHED; PG8_LDA(At, 0, 0); PG8_STAGE(PG8_SA(1, 1), a1 + hstep, voffA);
            PG8_WAIT_L(8); PG8_BAR; PG8_WAIT_L(0); PG8_MMA(0, 0, At, B0); PG8_BAR; PG8_SCHED;
            PG8_LDB(B1, 0, 1); PG8_STAGE(PG8_SB(0, 0), b2, voffB);
            PG8_BAR; PG8_WAIT_L(0); PG8_MMA(0, 1, At, B1); PG8_BAR;
            PG8_LDA(At, 0, 1); PG8_STAGE(PG8_SA(0, 0), a2, voffA);
            PG8_BAR; PG8_WAIT_L(0); PG8_MMA(1, 0, At, B0); PG8_BAR; PG8_SCHED;
            PG8_STAGE(PG8_SB(0, 1), b2 + hstep, voffB);
            PG8_WAIT_V(6); PG8_BAR; PG8_MMA(1, 1, At, B1); PG8_BAR;
            PG8_LDB(B0, 1, 0); PG8_SCHED; PG8_LDA(At, 1, 0); PG8_STAGE(PG8_SA(0, 1), a2 + hstep, voffA);
            PG8_WAIT_L(8); PG8_BAR; PG8_WAIT_L(0); PG8_MMA(0, 0, At, B0); PG8_BAR; PG8_SCHED;
            PG8_LDB(B1, 1, 1); PG8_STAGE(PG8_SB(1, 0), b3, voffB);
            PG8_BAR; PG8_WAIT_L(0); PG8_MMA(0, 1, At, B1); PG8_BAR;
            PG8_LDA(At, 1, 1); PG8_STAGE(PG8_SA(1, 0), a3, voffA);
            PG8_BAR; PG8_WAIT_L(0); PG8_MMA(1, 0, At, B0); PG8_BAR; PG8_SCHED;
            PG8_STAGE(PG8_SB(1, 1), b3 + hstep, voffB);
            PG8_WAIT_V(6); PG8_BAR; PG8_MMA(1, 1, At, B1); PG8_BAR;
            }
        }
        if constexpr (ALIGN_EPI) { if (wr == 0) PG8_BAR; }
        if constexpr (!Epi::AFTER_DRAIN) { E(acc, cur, wr, wc, fr, fq); S.done(cur); }
        if (!has_next) break;
#pragma unroll
        for (int a = 0; a < 2; ++a)
#pragma unroll
            for (int b = 0; b < 2; ++b)
#pragma unroll
                for (int m = 0; m < 4; ++m)
#pragma unroll
                    for (int n = 0; n < 2; ++n) acc[a][b][m][n] = (f32x4){0.f, 0.f, 0.f, 0.f};
        cur = nxt; cA = nA; cB = nB; ++ui;
        if constexpr (ALIGN_EPI) { if (wr == 1) PG8_BAR; }
    }
    PG8_WAIT_V(0);
    if constexpr (!ALIGN_EPI) { if (wr == 0) PG8_BAR; }
    PG8_BAR;
#undef PG8_SA
#undef PG8_SB
#undef PG8_STAGE
#undef PG8_LDA
#undef PG8_LDB
#undef PG8_MMA
#undef PG8_WAIT_V
#undef PG8_WAIT_L
#undef PG8_BAR
#undef PG8_SCHED
}
}

#define XB_TMO      128
#define XB_XCNT(j)  (256  + 64 * (j))
#define XB_XSUB(j)  (1280 + 64 * (j))
#define XB_XGEN(j)  (2304 + 64 * (j))
#define XB_TOP      3328
#define XB_TOPGEN   3392
#define XCD_BAR_WORDS 3456
#define XB_SPIN_CAP (1u << 18)
__device__ __forceinline__ unsigned xb_ld(unsigned* p)              { return __hip_atomic_load(p, __ATOMIC_RELAXED, __HIP_MEMORY_SCOPE_AGENT); }
__device__ __forceinline__ unsigned xb_add(unsigned* p, unsigned v) { return __hip_atomic_fetch_add(p, v, __ATOMIC_RELAXED, __HIP_MEMORY_SCOPE_AGENT); }
__device__ __forceinline__ unsigned xb_xcc_id() { return (unsigned)__builtin_amdgcn_s_getreg((3 << 11) | 20) & 0xFu; }
#define XB_SPIN(cond, bar) do { unsigned _sp = 0; while (cond) { __builtin_amdgcn_s_sleep(1); \
    if ((++_sp & 255u) == 0u) { if (xb_ld(&(bar)[XB_TMO])) break; if (_sp > XB_SPIN_CAP) { atomicAdd(&(bar)[XB_TMO], 1u); break; } } } } while (0)
struct XcdBarrier { unsigned* bar; unsigned x; volatile LAS unsigned* st; };
__device__ __forceinline__ XcdBarrier xcd_barrier_post(unsigned* bar, volatile LAS unsigned* st) {
    XcdBarrier b; b.bar = bar; b.x = xb_xcc_id(); b.st = st;
    if (threadIdx.x == 0) (void)xb_add(&bar[XB_XCNT(b.x)], 1u);
    return b;
}
__device__ __forceinline__ void xcd_barrier_complete(unsigned* bar, unsigned x, unsigned& nloc, unsigned& nx) {
    const unsigned G = gridDim.x * gridDim.y * gridDim.z;
    unsigned sum, cnt, mine, sp = 0u;
    for (;;) {
        sum = 0u; cnt = 0u; mine = 0u;
#pragma unroll
        for (unsigned j = 0; j < 16; ++j) { const unsigned c = xb_ld(&bar[XB_XCNT(j)]); sum += c; cnt += (c > 0u) ? 1u : 0u; mine = (j == x) ? c : mine; }
        if (sum == G) break;
        __builtin_amdgcn_s_sleep(1);
        if ((++sp & 255u) == 0u) { if (xb_ld(&bar[XB_TMO])) break; if (sp > XB_SPIN_CAP) { atomicAdd(&bar[XB_TMO], 1u); break; } }
    }
    nloc = mine > 0u ? mine : 1u; nx = cnt > 0u ? cnt : 1u;
}
__device__ __forceinline__ void xcd_barrier(const XcdBarrier& b) {
    asm volatile("s_waitcnt vmcnt(0)" ::: "memory");
    __syncthreads();
    if (threadIdx.x == 0) {
        unsigned* bar = b.bar;
        __builtin_amdgcn_s_waitcnt(0);
        unsigned nloc = b.st[0], nx = b.st[1];
        if (nloc == 0u) { xcd_barrier_complete(bar, b.x, nloc, nx); b.st[0] = nloc; b.st[1] = nx; }
        const unsigned old = xb_add(&bar[XB_XSUB(b.x)], 1u);
        const unsigned gen = old / nloc;
        if (old + 1u == (gen + 1u) * nloc) {
            __builtin_amdgcn_fence(__ATOMIC_RELEASE, "agent");
            asm volatile("s_waitcnt vmcnt(0)" ::: "memory");
            const unsigned og = xb_add(&bar[XB_TOP], 1u);
            const unsigned tg = og / nx;
            if (og + 1u == (tg + 1u) * nx) xb_add(&bar[XB_TOPGEN], 1u);
            else XB_SPIN(xb_ld(&bar[XB_TOPGEN]) == tg, bar);
            __builtin_amdgcn_fence(__ATOMIC_ACQUIRE, "agent");
            xb_add(&bar[XB_XGEN(b.x)], 1u);
            asm volatile("s_waitcnt vmcnt(0)" ::: "memory");
        } else {
            XB_SPIN(xb_ld(&bar[XB_XGEN(b.x)]) == gen, bar);
            __builtin_amdgcn_fence(__ATOMIC_ACQUIRE, "agent");
            asm volatile("s_waitcnt vmcnt(0)" ::: "memory");
        }
    }
    __syncthreads();
}

#define LDS_WAIT() asm volatile("s_waitcnt lgkmcnt(0)" ::: "memory")
#define SBAR() __builtin_amdgcn_sched_barrier(0)
__device__ __forceinline__ float wave_sum(float v) {
#pragma unroll
    for (int o = 1; o < 64; o <<= 1) v += __shfl_xor(v, o);
    return v;
}
__device__ __forceinline__ unsigned cvtpk(float lo, float hi) { unsigned r; asm volatile("v_cvt_pk_bf16_f32 %0, %1, %2" : "=v"(r) : "v"(lo), "v"(hi)); return r; }
__device__ __forceinline__ float bf_lo(unsigned w) { return __uint_as_float(w << 16); }
__device__ __forceinline__ float bf_hi(unsigned w) { return __uint_as_float(w & 0xffff0000u); }

struct Frame {
    unsigned char* lds; LAS unsigned char* ldsl;
    int tid, lane, wave, vcu, G, gw, NGW;
};
__device__ __forceinline__ unsigned long long karg(int i) {
    const __attribute__((address_space(4))) unsigned char* kp = (const __attribute__((address_space(4))) unsigned char*)__builtin_amdgcn_kernarg_segment_ptr();
    return *(const __attribute__((address_space(4))) unsigned long long volatile*)(kp + 8 * i);
}
__device__ __forceinline__ const float* arg_in(int i) { return (const float*)(const GAS float*)karg(i); }
__device__ __forceinline__ float* arg_out() { return (float*)(GAS float*)karg(22); }
__device__ __forceinline__ unsigned char* arg_ws() { return (unsigned char*)(GAS unsigned char*)karg(23); }
#define RELAUNDER() do { int t_ = threadIdx.x; asm volatile("" : "+v"(t_)); F.tid = t_; F.lane = t_ & 63; F.wave = __builtin_amdgcn_readfirstlane(t_ >> 6); F.gw = F.vcu * 8 + F.wave; } while (0)

template <class RowMap>
__device__ __forceinline__ void transpose_item(const float* W, int K, int N, bf16_t* WT, RowMap rm, LAS float* scr, int item, int lane) {
    const int nblk = N / 32, kb = item / nblk, nb = item % nblk, k0 = 64 * kb, n0 = 32 * nb;
#pragma unroll 8
    for (int i = 0; i < 32; ++i) { const int kk = 2 * i + (lane >> 5); scr[kk * 33 + (lane & 31)] = W[(size_t)(k0 + kk) * N + n0 + (lane & 31)]; }
    LDS_WAIT(); asm volatile("" ::: "memory");
    const int c = lane & 7;
#pragma unroll
    for (int j = 0; j < 4; ++j) { const int n = (lane >> 3) + 8 * j; const LAS float* s = scr + (8 * c) * 33 + n;
        u32x4 o; o.x = cvtpk(s[0 * 33], s[1 * 33]); o.y = cvtpk(s[2 * 33], s[3 * 33]); o.z = cvtpk(s[4 * 33], s[5 * 33]); o.w = cvtpk(s[6 * 33], s[7 * 33]);
        *(u32x4*)(WT + (size_t)rm(n0 + n) * K + k0 + 8 * c) = o; }
    LDS_WAIT(); asm volatile("" ::: "memory");
}
struct RmId { int off; __device__ int operator()(int n) const { return off + n; } };
struct RmGU { int up; __device__ int operator()(int n) const { return 256 * (n >> 7) + up * 128 + (n & 127); } };
struct RmWin { __device__ int operator()(int n) const { return n < 2560 ? n : (n < 2584 ? 5632 + (n - 2560) : (n < 5656 ? n - 24 : n)); } };

__device__ __forceinline__ void rms_row(const float* xrow, const float* g, bf16_t* orow, int lane) {
    const f32x4* xr = (const f32x4*)xrow + lane; f32x4 v[8]; float s = 0.f;
#pragma unroll
    for (int j = 0; j < 8; ++j) { v[j] = xr[64 * j]; s += (v[j].x * v[j].x + v[j].y * v[j].y) + (v[j].z * v[j].z + v[j].w * v[j].w); }
    const float r = 1.0f / sqrtf(wave_sum(s) * (1.0f / DM) + EPS);
    const f32x4* gr = (const f32x4*)g + lane; u32x2* o8 = (u32x2*)orow + lane;
#pragma unroll
    for (int j = 0; j < 8; ++j) { const f32x4 gg = gr[64 * j]; u32x2 w; w.x = cvtpk(v[j].x * r * gg.x, v[j].y * r * gg.y); w.y = cvtpk(v[j].z * r * gg.z, v[j].w * r * gg.w); o8[64 * j] = w; }
}

__device__ __forceinline__ float rope_inv(int i) {
    constexpr float tab[16] = {1.000000000e+00f, 4.403665960e-01f, 1.939227432e-01f, 8.539710194e-02f, 3.760603070e-02f, 1.656043902e-02f, 7.292664610e-03f, 3.211445874e-03f, 1.414213562e-03f, 6.227723788e-04f, 2.742481884e-04f, 1.207697351e-04f, 5.318296098e-05f, 2.341999971e-05f, 1.031338616e-05f, 4.541670478e-06f};
    float v = tab[0];
#pragma unroll
    for (int k = 1; k < 16; ++k) v = (i == k) ? tab[k] : v;
    return v;
}
__device__ __forceinline__ void phase_convert(Frame& F, int L) {
    LAS float* scr = (LAS float*)(F.ldsl + F.wave * 16384);
    unsigned char* ws = arg_ws();
    constexpr int I_G = (DM / 64) * (DFF / 32);
    constexpr int I_D = (DFF / 64) * (DM / 32);
    constexpr int I_IN = (DM / 64) * (PROJ_COLS / 32);
    constexpr int I_O = (DM / 64) * (DM / 32);
    constexpr int I_C = (4096 / 64) * (256 / 32);
    constexpr int NITEMS = 6 * I_G + I_IN + I_O + 2 * I_C;
    static_assert(I_G == I_D, "items");
    const float* wg1 = arg_in(2) + (size_t)L * DM * DFF; const float* wu1 = arg_in(3) + (size_t)L * DM * DFF; const float* wd1 = arg_in(4) + (size_t)L * DFF * DM;
    const float* wg2 = arg_in(19) + (size_t)L * DM * DFF; const float* wu2 = arg_in(20) + (size_t)L * DM * DFF; const float* wd2 = arg_in(21) + (size_t)L * DFF * DM;
    const float* win = arg_in(6) + (size_t)L * DM * PROJ_COLS; const float* wout = arg_in(17) + (size_t)L * DM * DM;
    const float* wc1 = arg_in(10) + (size_t)L * 2 * 4096 * 256;
    for (int it = F.gw; it < NITEMS; it += F.NGW) {
        int r = it;
        if (r < I_G) { transpose_item(wg1, DM, DFF, (bf16_t*)(ws + WS_WGU), RmGU{0}, scr, r, F.lane); continue; } r -= I_G;
        if (r < I_G) { transpose_item(wu1, DM, DFF, (bf16_t*)(ws + WS_WGU), RmGU{1}, scr, r, F.lane); continue; } r -= I_G;
        if (r < I_D) { transpose_item(wd1, DFF, DM, (bf16_t*)(ws + WS_WD), RmId{0}, scr, r, F.lane); continue; } r -= I_D;
        if (r < I_G) { transpose_item(wg2, DM, DFF, (bf16_t*)(ws + WS_WGU2), RmGU{0}, scr, r, F.lane); continue; } r -= I_G;
        if (r < I_G) { transpose_item(wu2, DM, DFF, (bf16_t*)(ws + WS_WGU2), RmGU{1}, scr, r, F.lane); continue; } r -= I_G;
        if (r < I_D) { transpose_item(wd2, DFF, DM, (bf16_t*)(ws + WS_WD2), RmId{0}, scr, r, F.lane); continue; } r -= I_D;
        if (r < I_IN) { transpose_item(win, DM, PROJ_COLS, (bf16_t*)(ws + WS_WIN), RmWin{}, scr, r, F.lane); continue; } r -= I_IN;
        if (r < I_O) { transpose_item(wout, DM, DM, (bf16_t*)(ws + WS_WOUT), RmId{0}, scr, r, F.lane); continue; } r -= I_O;
        if (r < I_C) { transpose_item(wc1, 4096, 256, (bf16_t*)(ws + WS_WC1), RmId{0}, scr, r, F.lane); continue; } r -= I_C;
        transpose_item(wc1 + 4096 * 256, 4096, 256, (bf16_t*)(ws + WS_WC1), RmId{256}, scr, r, F.lane);
    }
    if (L == 0) {
        float* rc = (float*)(ws + WS_ROPE); float* rs = rc + T * 16;
        for (int idx = blockIdx.x * 512 + F.tid; idx < T * 16; idx += F.G * 512) { const int t = idx >> 4, i = idx & 15;
            const float ang = (float)t * rope_inv(i); rc[idx] = cosf(ang); rs[idx] = sinf(ang); }
    }
}
__device__ __forceinline__ void phase_norm(Frame& F, const float* x, const float* g, bf16_t* o) {
    for (int m = F.gw; m < M; m += F.NGW) rms_row(x + (size_t)m * DM, g, o + (size_t)m * DM, F.lane);
}

__device__ __forceinline__ float log_sigmoid_f(float x) { return x >= 0.f ? -log1pf(expf(-x)) : x - log1pf(expf(x)); }
__device__ __forceinline__ void phase_prep(Frame& F, int L) {
    unsigned char* ws = arg_ws();
    bf16_t* HID = (bf16_t*)(ws + WS_HID); float* GF = (float*)(ws + WS_GF);
    const float* rc = (const float*)(ws + WS_ROPE); const float* rs = rc + T * 16;
    const int lane = F.lane, sub = lane >> 4, l16 = lane & 15;
    if (F.gw < NB * 8) {
        const int b = F.gw >> 3, h = F.gw & 7; const float fb = arg_in(15)[L * 8 + h];
        const float* src = GF + ((size_t)b * T + lane * 32) * 32 + 24 + h;
        float s = 0.f;
        for (int i = 0; i < 32; ++i) s += log_sigmoid_f(src[(size_t)i * 32] + fb);
        float inc = s;
#pragma unroll
        for (int o = 1; o < 64; o <<= 1) { const float tt = __shfl_up(inc, o); if (lane >= o) inc += tt; }
        float run = inc - s;
        float* dst = (float*)(ws + WS_CUM) + ((size_t)(b * 8 + h)) * T + lane * 32;
        for (int i = 0; i < 32; ++i) { run += log_sigmoid_f(src[(size_t)i * 32] + fb); dst[i] = run; }
    }
    {
        bf16_t* CA = (bf16_t*)(ws + WS_CMPA);
        for (int r = F.gw; r < 2 * 4064; r += F.NGW) {
            const int which = r >= 4064 ? 1 : 0, rr = r - which * 4064, h = rr & 1, bc = rr >> 1, b = bc / NCMP, c = bc - b * NCMP;
            const bf16_t* src = HID + ((size_t)b * T + 16 * c) * LDP + C_KV + which * 256 + h * 128 + l16 * 8;
            const float* pe = arg_in(9) + ((size_t)(L * 2 + which) * 32) * 128 + l16 * 8;
            bf16_t* dst = CA + ((size_t)which * 4096 + rr) * 4096 + l16 * 8;
#pragma unroll
            for (int it = 0; it < 8; ++it) { const int l = 4 * it + sub;
                const u32x4 w = *(const u32x4*)(src + (size_t)l * LDP); const f32x4 p0 = *(const f32x4*)(pe + l * 128), p1 = *(const f32x4*)(pe + l * 128 + 4);
                u32x4 o; o.x = cvtpk(bf_lo(w.x) + p0.x, bf_hi(w.x) + p0.y); o.y = cvtpk(bf_lo(w.y) + p0.z, bf_hi(w.y) + p0.w);
                o.z = cvtpk(bf_lo(w.z) + p1.x, bf_hi(w.z) + p1.y); o.w = cvtpk(bf_lo(w.w) + p1.z, bf_hi(w.w) + p1.w);
                *(u32x4*)(dst + l * 128) = o; }
        }
    }
    const float* gq = arg_in(7) + L * 128; const float* gk1 = arg_in(8) + (L * 3 + 1) * 128; const float* gk2 = arg_in(8) + (L * 3 + 2) * 128;
    const float* gfq = arg_in(13) + L * 128; const float* gfk = arg_in(14) + L * 128;
    for (int m = F.gw; m < M; m += F.NGW) {
        const int t = m & (T - 1);
        bf16_t* prow = HID + (size_t)m * LDP;
#pragma unroll
        for (int it = 0; it < 7; ++it) {
            int col; const float* gp;
            if (it < 2) { col = (4 * it + sub) * 128; gp = gq; }
            else if (it == 2) { col = C_KV + (sub < 2 ? 512 + sub * 128 : 1024 + (sub - 2) * 128); gp = sub < 2 ? gk1 : gk2; }
            else if (it < 5) { col = C_FQ + (4 * (it - 3) + sub) * 128; gp = gfq; }
            else { col = C_FK + (4 * (it - 5) + sub) * 128; gp = gfk; }
            bf16_t* p = prow + col + l16 * 8;
            const u32x4 w = *(const u32x4*)p;
            float x[8] = {bf_lo(w.x), bf_hi(w.x), bf_lo(w.y), bf_hi(w.y), bf_lo(w.z), bf_hi(w.z), bf_lo(w.w), bf_hi(w.w)};
            float ss = 0.f;
#pragma unroll
            for (int e = 0; e < 8; ++e) ss += x[e] * x[e];
            ss += __shfl_xor(ss, 1); ss += __shfl_xor(ss, 2); ss += __shfl_xor(ss, 4); ss += __shfl_xor(ss, 8);
            const float r = 1.0f / sqrtf(ss * (1.0f / 128.f) + EPS);
            const f32x4 g0 = *(const f32x4*)(gp + l16 * 8), g1 = *(const f32x4*)(gp + l16 * 8 + 4);
            x[0] *= r * g0.x; x[1] *= r * g0.y; x[2] *= r * g0.z; x[3] *= r * g0.w; x[4] *= r * g1.x; x[5] *= r * g1.y; x[6] *= r * g1.z; x[7] *= r * g1.w;
            if (it <= 2) {
                const int fi = (l16 & 1) * 8;
                const f32x4 c0 = *(const f32x4*)(rc + t * 16 + fi), c1 = *(const f32x4*)(rc + t * 16 + fi + 4);
                const f32x4 s0 = *(const f32x4*)(rs + t * 16 + fi), s1 = *(const f32x4*)(rs + t * 16 + fi + 4);
                const float cc[8] = {c0.x, c0.y, c0.z, c0.w, c1.x, c1.y, c1.z, c1.w}, sn[8] = {s0.x, s0.y, s0.z, s0.w, s1.x, s1.y, s1.z, s1.w};
#pragma unroll
                for (int e = 0; e < 8; ++e) { const float other = __shfl_xor(x[e], 2);
                    const float ro = (l16 & 2) ? (x[e] * cc[e] + other * sn[e]) : (x[e] * cc[e] - other * sn[e]);
                    if (l16 < 4) x[e] = ro; }
            }
            u32x4 o; o.x = cvtpk(x[0], x[1]); o.y = cvtpk(x[2], x[3]); o.z = cvtpk(x[4], x[5]); o.w = cvtpk(x[6], x[7]);
            *(u32x4*)p = o;
        }
        if (lane < 24) { float* gp2 = GF + (size_t)m * 32 + lane; const float v = *gp2; *gp2 = 1.0f / (1.0f + expf(-v)); }
    }
}

__device__ __forceinline__ void phase_cmp2(Frame& F, int L) {
    unsigned char* ws = arg_ws(); const int lane = F.lane;
    const bf16_t* CH = (const bf16_t*)(ws + WS_CMPH);
    const float* rc = (const float*)(ws + WS_ROPE); const float* rs = rc + T * 16;
    const float* gk0 = arg_in(8) + (L * 3 + 0) * 128;
    for (int it = F.gw; it < 2032 + 64; it += F.NGW) {
        if (it >= 2032) {
            const int z = it - 2032, which = z >> 5, bh = z & 31;
            bf16_t* dst = (bf16_t*)(ws + (which ? WS_VC : WS_KC)) + ((size_t)bh * 128 + 127) * 128;
            *(unsigned*)(dst + 2 * lane) = 0u; continue;
        }
        const int r0 = it * 4, which = r0 >= 4064 ? 1 : 0;
        const float* w2 = arg_in(11) + (size_t)(L * 2 + which) * 256 * 128;
        float hv[4][4];
#pragma unroll
        for (int q = 0; q < 4; ++q) { const int rr = r0 - which * 4064 + q; const u32x2 w = *(const u32x2*)(CH + ((size_t)which * 4096 + rr) * 256 + 4 * lane);
            hv[q][0] = bf_lo(w.x); hv[q][1] = bf_hi(w.x); hv[q][2] = bf_lo(w.y); hv[q][3] = bf_hi(w.y); }
        float a[4][2] = {};
#pragma unroll 4
        for (int kk = 0; kk < 64; ++kk) {
#pragma unroll
            for (int j = 0; j < 4; ++j) { const f32x2 wv = *(const f32x2*)(w2 + (size_t)(kk * 4 + j) * 128 + 2 * lane);
#pragma unroll
                for (int q = 0; q < 4; ++q) { const float hk = __shfl(hv[q][j], kk); a[q][0] += hk * wv.x; a[q][1] += hk * wv.y; } }
        }
#pragma unroll
        for (int q = 0; q < 4; ++q) { const int rr = r0 - which * 4064 + q, h = rr & 1, bc = rr >> 1, b = bc / NCMP, c = bc - b * NCMP;
            float y0 = a[q][0], y1 = a[q][1];
            if (which == 0) {
                const float ss = wave_sum(y0 * y0 + y1 * y1); const float r = 1.0f / sqrtf(ss * (1.0f / 128.f) + EPS);
                const f32x2 g = *(const f32x2*)(gk0 + 2 * lane); y0 *= r * g.x; y1 *= r * g.y;
                const int pos = 16 * c + 31; const int fi = 2 * (lane & 7);
                const f32x2 cc = *(const f32x2*)(rc + pos * 16 + fi), sn = *(const f32x2*)(rs + pos * 16 + fi);
                const float o0 = __shfl_xor(y0, 8), o1 = __shfl_xor(y1, 8);
                if (lane < 8) { y0 = y0 * cc.x - o0 * sn.x; y1 = y1 * cc.y - o1 * sn.y; }
                else if (lane < 16) { y0 = y0 * cc.x + o0 * sn.x; y1 = y1 * cc.y + o1 * sn.y; }
            }
            bf16_t* dst = (bf16_t*)(ws + (which ? WS_VC : WS_KC)) + ((size_t)(b * 2 + h) * 128 + c) * 128;
            *(unsigned*)(dst + 2 * lane) = cvtpk(y0, y1);
        }
    }
}

__device__ __forceinline__ void unpack8(const u32x4 w, float* x) { x[0] = bf_lo(w.x); x[1] = bf_hi(w.x); x[2] = bf_lo(w.y); x[3] = bf_hi(w.y); x[4] = bf_lo(w.z); x[5] = bf_hi(w.z); x[6] = bf_lo(w.w); x[7] = bf_hi(w.w); }
__device__ __forceinline__ void phase_outnorm(Frame& F, int L) {
    unsigned char* ws = arg_ws();
    bf16_t* HN = (bf16_t*)(ws + WS_HN); const int lane = F.lane;
    const bf16_t* N0 = (const bf16_t*)(ws + WS_NSA0); const bf16_t* N1 = (const bf16_t*)(ws + WS_NSA1); const bf16_t* N2 = (const bf16_t*)(ws + WS_NSA2);
    const float* gn = arg_in(12) + L * 1024; const float* gf = arg_in(16) + L * 1024;
    for (int m = F.gw; m < M; m += F.NGW) {
        u32x4* row = (u32x4*)(HN + (size_t)m * DM) + lane;
        float x[4][8]; float sa = 0.f, sb = 0.f;
#pragma unroll
        for (int j = 0; j < 4; ++j) {
            if (j < 2) { float y0[8], y1[8], y2[8]; const size_t off = (size_t)m * 1024 + (size_t)(lane + 64 * j) * 8;
                unpack8(*(const u32x4*)(N0 + off), y0); unpack8(*(const u32x4*)(N1 + off), y1); unpack8(*(const u32x4*)(N2 + off), y2);
#pragma unroll
                for (int e = 0; e < 8; ++e) x[j][e] = y0[e] + y1[e] + y2[e]; }
            else unpack8(row[64 * j], x[j]);
            float s = 0.f;
#pragma unroll
            for (int e = 0; e < 8; ++e) s += x[j][e] * x[j][e];
            if (j < 2) sa += s; else sb += s; }
        const float ra = 1.0f / sqrtf(wave_sum(sa) * (1.0f / 1024.f) + EPS), rb = 1.0f / sqrtf(wave_sum(sb) * (1.0f / 1024.f) + EPS);
#pragma unroll
        for (int j = 0; j < 4; ++j) { const float* g = (j < 2 ? gn : gf) + ((lane + 64 * j) & 127) * 8; const float r = j < 2 ? ra : rb;
            const f32x4 g0 = *(const f32x4*)g, g1 = *(const f32x4*)(g + 4);
            u32x4 o; o.x = cvtpk(x[j][0] * r * g0.x, x[j][1] * r * g0.y); o.y = cvtpk(x[j][2] * r * g0.z, x[j][3] * r * g0.w);
            o.z = cvtpk(x[j][4] * r * g1.x, x[j][5] * r * g1.y); o.w = cvtpk(x[j][6] * r * g1.z, x[j][7] * r * g1.w);
            row[64 * j] = o; }
    }
}

namespace att {
constexpr int SHM_V = 16384, SHM_K = 16384;
constexpr int OFF_V = 0, OFF_K = 2 * SHM_V, OFF_WS = 65536, OFF_BIAS = OFF_WS + 2048, OFF_PG = 69632, OFF_SC = OFF_PG + 32768, OFF_SEL = OFF_SC + 8192, OFF_UNI = OFF_SEL + 256;
typedef LAS char* lptr;
#define KSWZ(row, colB) ((row) * 256 + ((colB) ^ (((row) & 7) << 4)))
__device__ __forceinline__ int v_st(int k, int c) { const int kk = (k & ~0xC) | ((k & 4) << 1) | ((k & 8) >> 1); return ((kk >> 3) * 4 + (c >> 5)) * 512 + ((kk & 7) * 32 + (c & 31)) * 2; }
__device__ __forceinline__ int v_rd_base(int lane) { return ((lane & 3) << 3) | (((lane >> 2) & 3) << 6) | (((lane >> 4) & 1) << 5) | (((lane >> 5) & 1) << 8); }
constexpr int v_rd_off(int d0, int ks, int half) { return d0 * 512 + ks * 4096 + half * 2048; }
__device__ __forceinline__ int crow(int r, int hi) { return (r & 3) + 8 * (r >> 2) + 4 * hi; }

template <int KB>
__device__ __forceinline__ void qkt(f32x16& p0, f32x16& p1, lptr lds, int r32, int hi, const bf16x8* qr) {
    p0 = f32x16{}; p1 = f32x16{};
    lptr kb[4];
#pragma unroll
    for (int dd = 0; dd < 4; ++dd) kb[dd] = lds + OFF_K + KB * SHM_K + KSWZ(r32, (dd * 16 + hi * 8) * 2);
#pragma unroll
    for (int d0 = 0; d0 < 8; ++d0) { lptr a = kb[d0 & 3] + (d0 >> 2) * 128;
        bf16x8 b0 = *reinterpret_cast<const LAS bf16x8*>(a);
        bf16x8 b1 = *reinterpret_cast<const LAS bf16x8*>(a + 32 * 256);
        p0 = __builtin_amdgcn_mfma_f32_32x32x16_bf16(b0, qr[d0], p0, 0, 0, 0);
        p1 = __builtin_amdgcn_mfma_f32_32x32x16_bf16(b1, qr[d0], p1, 0, 0, 0); }
}
template <int VB>
__device__ __forceinline__ void pv_tile(f32x16* o, int vb0, bf16x8 pa0, bf16x8 pa1, bf16x8 pa2, bf16x8 pa3) {
#define TRRD(dst, off) asm volatile("ds_read_b64_tr_b16 %0, %1 offset:%2" : "=&v"(dst) : "v"(vb0), "i"(off) : "memory")
#define PV_D0(d0) do { s16x4 l0, l1, l2, l3, h0, h1, h2, h3; constexpr int b_ = VB * SHM_V + v_rd_off(d0, 0, 0); \
        TRRD(l0, b_); TRRD(h0, b_ + 2048); TRRD(l1, b_ + 4096); TRRD(h1, b_ + 6144); TRRD(l2, b_ + 8192); TRRD(h2, b_ + 10240); TRRD(l3, b_ + 12288); TRRD(h3, b_ + 14336); \
        asm volatile("s_waitcnt lgkmcnt(0)" ::: "memory"); SBAR(); \
        o[d0] = __builtin_amdgcn_mfma_f32_32x32x16_bf16(pa0, (bf16x8){l0[0], l0[1], l0[2], l0[3], h0[0], h0[1], h0[2], h0[3]}, o[d0], 0, 0, 0);   \
        o[d0] = __builtin_amdgcn_mfma_f32_32x32x16_bf16(pa1, (bf16x8){l1[0], l1[1], l1[2], l1[3], h1[0], h1[1], h1[2], h1[3]}, o[d0], 0, 0, 0);   \
        o[d0] = __builtin_amdgcn_mfma_f32_32x32x16_bf16(pa2, (bf16x8){l2[0], l2[1], l2[2], l2[3], h2[0], h2[1], h2[2], h2[3]}, o[d0], 0, 0, 0);   \
        o[d0] = __builtin_amdgcn_mfma_f32_32x32x16_bf16(pa3, (bf16x8){l3[0], l3[1], l3[2], l3[3], h3[0], h3[1], h3[2], h3[3]}, o[d0], 0, 0, 0); } while (0)
    PV_D0(0); PV_D0(1); PV_D0(2); PV_D0(3);
#undef PV_D0
#undef TRRD
}
__device__ __forceinline__ float xhalf_max(float x) { auto rr = __builtin_amdgcn_permlane32_swap(__float_as_uint(x), __float_as_uint(x), false, false); return fmaxf(__uint_as_float(rr[0]), __uint_as_float(rr[1])); }
__device__ __forceinline__ float xhalf_sum(float x) { auto rr = __builtin_amdgcn_permlane32_swap(__float_as_uint(x), __float_as_uint(x), false, false); return __uint_as_float(rr[0]) + __uint_as_float(rr[1]); }
#define PK4(P, B_, OUT) do { unsigned xa0_ = cvtpk(P[B_+0], P[B_+1]), xa1_ = cvtpk(P[B_+2], P[B_+3]);                          \
        unsigned xb0_ = cvtpk(P[B_+4], P[B_+5]), xb1_ = cvtpk(P[B_+6], P[B_+7]);                                             \
        auto xr0_ = __builtin_amdgcn_permlane32_swap(xa0_, xb0_, false, false); auto xr1_ = __builtin_amdgcn_permlane32_swap(xa1_, xb1_, false, false); \
        u32x4 xw_ = {xr0_[0], xr1_[0], xr0_[1], xr1_[1]}; OUT = *reinterpret_cast<bf16x8*>(&xw_); } while (0)
__device__ __forceinline__ void scale_rows(f32x16* o, LAS float* tab, float v, int r32, int hi) {
    if (hi == 0) tab[r32] = v;
    asm volatile("s_waitcnt lgkmcnt(0)" ::: "memory");
#pragma unroll
    for (int g4 = 0; g4 < 4; ++g4) { const f32x4 f = *(const LAS f32x4*)(tab + 8 * g4 + 4 * hi);
#pragma unroll
        for (int e = 0; e < 4; ++e)
#pragma unroll
            for (int d = 0; d < 4; ++d) o[d][4 * g4 + e] *= f[e]; }
    asm volatile("s_waitcnt lgkmcnt(0)" ::: "memory");
}
__device__ __forceinline__ void softmax_pv(f32x16& p0, f32x16& p1, f32x16* o, float& m, float& l, int vb0, LAS float* tab, int r32, int hi) {
    float pmax = p0[0];
#pragma unroll
    for (int r = 1; r < 16; ++r) pmax = fmaxf(pmax, p0[r]);
#pragma unroll
    for (int r = 0; r < 16; ++r) pmax = fmaxf(pmax, p1[r]);
    pmax = xhalf_max(pmax);
    const float mn = fmaxf(m, pmax);
    if (__any(mn > m)) {
        const float alpha = __builtin_amdgcn_exp2f(m - mn);
        l *= alpha; m = mn;
        scale_rows(o, tab, alpha, r32, hi);
    }
    float ps = 0.f;
#pragma unroll
    for (int r = 0; r < 16; ++r) { p0[r] = __builtin_amdgcn_exp2f(p0[r] - m); ps += p0[r]; }
#pragma unroll
    for (int r = 0; r < 16; ++r) { p1[r] = __builtin_amdgcn_exp2f(p1[r] - m); ps += p1[r]; }
    l += xhalf_sum(ps);
    bf16x8 pa0, pa1, pa2, pa3;
    PK4(p0, 0, pa0); PK4(p0, 8, pa1); PK4(p1, 0, pa2); PK4(p1, 8, pa3);
    SBAR();
    pv_tile<0>(o, vb0, pa0, pa1, pa2, pa3);
}
struct Stg { bf16x8 k0, k1, v0, v1; };
__device__ __forceinline__ void stg_load(Stg& s, const bf16_t* Kp, const bf16_t* Vp, size_t stride, int sr, int sc) {
    s.k0 = *(const bf16x8*)(Kp + (size_t)sr * stride + sc); s.k1 = *(const bf16x8*)(Kp + (size_t)(32 + sr) * stride + sc);
    s.v0 = *(const bf16x8*)(Vp + (size_t)sr * stride + sc); s.v1 = *(const bf16x8*)(Vp + (size_t)(32 + sr) * stride + sc);
}
__device__ __forceinline__ void stg_write(const Stg& s, lptr lds, int kbuf, int vbuf, int kws, int vst0, int vst1) {
    *(LAS bf16x8*)(lds + OFF_K + kbuf * SHM_K + kws) = s.k0; *(LAS bf16x8*)(lds + OFF_K + kbuf * SHM_K + kws + 32 * 256) = s.k1;
    *(LAS bf16x8*)(lds + OFF_V + vbuf * SHM_V + vst0) = s.v0; *(LAS bf16x8*)(lds + OFF_V + vbuf * SHM_V + vst1) = s.v1;
}
#define O_STORE(o, ftab, ROWPTR) do { _Pragma("unroll") for (int r = 0; r < 16; ++r) { const int rr_ = crow(r, hi); bf16_t* rp_ = ROWPTR(rr_); const float f_ = (ftab)[rr_]; \
        _Pragma("unroll") for (int d0 = 0; d0 < 4; ++d0) { const float v_ = o[d0][r] * f_; const float vn_ = __shfl_xor(v_, 1); \
            if ((r32 & 1) == 0) *(unsigned*)(rp_ + d0 * 32 + r32) = cvtpk(v_, vn_); } } } while (0)
struct Lanes { int tid, wid, lane, r32, hi, sr, sc, kws, vst0, vst1, vb0; };
__device__ __forceinline__ Lanes mk_lanes(const Frame& F) {
    Lanes a; a.tid = F.tid; a.wid = F.wave; a.lane = F.lane; a.r32 = a.lane & 31; a.hi = a.lane >> 5;
    a.sr = a.tid >> 4; a.sc = (a.tid & 15) * 8; a.kws = KSWZ(a.sr, a.sc * 2); a.vst0 = v_st(a.sr, a.sc); a.vst1 = v_st(32 + a.sr, a.sc);
    a.vb0 = OFF_V + v_rd_base(a.lane); return a;
}
}

__device__ __forceinline__ void fox_block(Frame& F, int b, int h, int qb) {
    using namespace att;
    RELAUNDER();
    lptr lds = (lptr)F.ldsl; unsigned char* ws = arg_ws();
    const bf16_t* HID = (const bf16_t*)(ws + WS_HID); bf16_t* HN = (bf16_t*)(ws + WS_HN);
    const Lanes A = mk_lanes(F); const int tid = A.tid, wid = A.wid, r32 = A.r32, hi = A.hi;
    LAS float* tab = (LAS float*)(lds + OFF_WS) + wid * 64; LAS float* biasL = (LAS float*)(lds + OFF_BIAS);
    const int tok0 = qb * 256 + wid * 32, t = tok0 + r32;
    const float* cum = (const float*)(ws + WS_CUM) + (size_t)(b * 8 + h) * T;
    const float ct2 = cum[t] * LOG2E;
    bf16x8 qr[8];
    { const bf16_t* qp = HID + ((size_t)b * T + t) * LDP + C_FQ + h * 128 + hi * 8;
#pragma unroll
      for (int d0 = 0; d0 < 8; ++d0) qr[d0] = *(const bf16x8*)(qp + d0 * 16); }
    const bf16_t* Kb = HID + (size_t)b * T * LDP + C_FK + h * 128; const bf16_t* Vb = HID + (size_t)b * T * LDP + C_FV + h * 128;
    const int ntiles = 4 * qb + 4;
    f32x16 o[4] = {}; float m = -1e30f, l = 0.f;
    Stg st; stg_load(st, Kb, Vb, LDP, A.sr, A.sc);
    for (int j = 0; j < ntiles; ++j) {
        __syncthreads();
        stg_write(st, lds, 0, 0, A.kws, A.vst0, A.vst1);
        if (tid < 64) biasL[tid] = -cum[64 * j + tid] * LOG2E;
        __syncthreads();
        if (j + 1 < ntiles) stg_load(st, Kb + (size_t)(64 * (j + 1)) * LDP, Vb + (size_t)(64 * (j + 1)) * LDP, LDP, A.sr, A.sc);
        if (64 * j <= tok0 + 31) {
            f32x16 p0, p1; qkt<0>(p0, p1, lds, r32, hi, qr);
#pragma unroll
            for (int g4 = 0; g4 < 4; ++g4) { const f32x4 ba = *(const LAS f32x4*)(biasL + 8 * g4 + 4 * hi), bb = *(const LAS f32x4*)(biasL + 32 + 8 * g4 + 4 * hi);
#pragma unroll
                for (int e = 0; e < 4; ++e) { p0[4 * g4 + e] = fmaf(p0[4 * g4 + e], C2, ct2 + ba[e]); p1[4 * g4 + e] = fmaf(p1[4 * g4 + e], C2, ct2 + bb[e]); } }
            if (64 * j + 63 > tok0) { const int dq = t - 64 * j - 4 * hi; const float NEG = -__builtin_inff();
#pragma unroll
                for (int r = 0; r < 16; ++r) { const int c = (r & 3) + 8 * (r >> 2); if (c > dq) p0[r] = NEG; if (c + 32 > dq) p1[r] = NEG; } }
            softmax_pv(p0, p1, o, m, l, A.vb0, tab, r32, hi);
        }
    }
    if (hi == 0) tab[32 + r32] = 1.0f / l;
    asm volatile("s_waitcnt lgkmcnt(0)" ::: "memory");
    bf16_t* Ob = HN + ((size_t)b * T + tok0) * DM + 1024 + h * 128;
#define FOX_ROWPTR(rr) (Ob + (size_t)(rr) * DM)
    O_STORE(o, tab + 32, FOX_ROWPTR);
#undef FOX_ROWPTR
    asm volatile("s_waitcnt lgkmcnt(0)" ::: "memory");
}

#define NSA_ROWPTR(rr) (Ob + (size_t)((rr) >> 2) * 1024 + ((rr) & 3) * 128)
__device__ __forceinline__ void nsa_cmp_select(Frame& F, int b, int kvh, int jq) {
    using namespace att;
    RELAUNDER();
    lptr lds = (lptr)F.ldsl; unsigned char* ws = arg_ws();
    const bf16_t* HID = (const bf16_t*)(ws + WS_HID); const float* GF = (const float*)(ws + WS_GF);
    const Lanes A = mk_lanes(F); const int tid = A.tid, wid = A.wid, lane = A.lane, r32 = A.r32, hi = A.hi;
    LAS float* tab = (LAS float*)(lds + OFF_WS) + wid * 64;
    LAS float* PgL = (LAS float*)(lds + OFF_PG); LAS float* SC = (LAS float*)(lds + OFF_SC); LAS unsigned* SEL = (LAS unsigned*)(lds + OFF_SEL); LAS unsigned* UNI = (LAS unsigned*)(lds + OFF_UNI);
    const int tl = 8 * wid + (r32 >> 2), g = r32 & 3, t = 64 * jq + tl, hq = kvh * 4 + g;
    const size_t mrow = (size_t)b * T + t;
    const float NEG = -__builtin_inff();
    bf16x8 qr[8];
    { const bf16_t* qp = HID + mrow * LDP + hq * 128 + hi * 8;
#pragma unroll
      for (int d0 = 0; d0 < 8; ++d0) qr[d0] = *(const bf16x8*)(qp + d0 * 16); }
    const float gt0 = GF[mrow * 32 + hq * 3 + 0];
    const bf16_t* KC = (const bf16_t*)(ws + WS_KC) + (size_t)(b * 2 + kvh) * 128 * 128; const bf16_t* VC = (const bf16_t*)(ws + WS_VC) + (size_t)(b * 2 + kvh) * 128 * 128;
    const bool two = jq >= 16;
    { Stg s0; stg_load(s0, KC, VC, 128, A.sr, A.sc);
      __syncthreads();
      stg_write(s0, lds, 0, 0, A.kws, A.vst0, A.vst1);
      if (two) { Stg s1; stg_load(s1, KC + 64 * 128, VC + 64 * 128, 128, A.sr, A.sc); stg_write(s1, lds, 1, 1, A.kws, A.vst0, A.vst1); }
      if (tid == 0) *UNI = 0u;
      __syncthreads(); }
    f32x16 a0, a1, b0, b1;
    qkt<0>(a0, a1, lds, r32, hi, qr);
    if (two) qkt<1>(b0, b1, lds, r32, hi, qr);
    else {
#pragma unroll
        for (int r = 0; r < 16; ++r) { b0[r] = NEG; b1[r] = NEG; } }
    const int cmax = (t - 31) >> 4; float mx = -1e30f;
#pragma unroll
    for (int r = 0; r < 16; ++r) { const int c = crow(r, hi);
        a0[r] = (c <= cmax) ? a0[r] * C2 : NEG; a1[r] = (c + 32 <= cmax) ? a1[r] * C2 : NEG; b0[r] = (c + 64 <= cmax) ? b0[r] * C2 : NEG; b1[r] = (c + 96 <= cmax) ? b1[r] * C2 : NEG;
        mx = fmaxf(mx, fmaxf(fmaxf(a0[r], a1[r]), fmaxf(b0[r], b1[r]))); }
    mx = xhalf_max(mx);
    float ps = 0.f;
#pragma unroll
    for (int r = 0; r < 16; ++r) { a0[r] = __builtin_amdgcn_exp2f(a0[r] - mx); a1[r] = __builtin_amdgcn_exp2f(a1[r] - mx); b0[r] = __builtin_amdgcn_exp2f(b0[r] - mx); b1[r] = __builtin_amdgcn_exp2f(b1[r] - mx);
        ps += (a0[r] + a1[r]) + (b0[r] + b1[r]); }
    ps = xhalf_sum(ps);
    const float inv = ps > 0.f ? 1.0f / ps : 0.f;
#pragma unroll
    for (int r = 0; r < 16; ++r) { a0[r] *= inv; a1[r] *= inv; b0[r] *= inv; b1[r] *= inv; }
#define QSUM(x) ({ float y_ = (x); y_ += __int_as_float(__builtin_amdgcn_update_dpp(0, __float_as_int(y_), 0xB1, 0xf, 0xf, false)); y_ += __int_as_float(__builtin_amdgcn_update_dpp(0, __float_as_int(y_), 0x4E, 0xf, 0xf, false)); y_; })
#pragma unroll
    for (int g4 = 0; g4 < 4; ++g4) {
        f32x4 va, vb, vc, vd;
#pragma unroll
        for (int e = 0; e < 4; ++e) { va[e] = QSUM(a0[4 * g4 + e]); vb[e] = QSUM(a1[4 * g4 + e]); vc[e] = QSUM(b0[4 * g4 + e]); vd[e] = QSUM(b1[4 * g4 + e]); }
        if (g == 0) { LAS float* pr = PgL + tl * 128 + 8 * g4 + 4 * hi; *(LAS f32x4*)pr = va; *(LAS f32x4*)(pr + 32) = vb; *(LAS f32x4*)(pr + 64) = vc; *(LAS f32x4*)(pr + 96) = vd; }
    }
#undef QSUM
    f32x16 o[4] = {};
    { bf16x8 pa0, pa1, pa2, pa3; PK4(a0, 0, pa0); PK4(a0, 8, pa1); PK4(a1, 0, pa2); PK4(a1, 8, pa3); SBAR(); pv_tile<0>(o, A.vb0, pa0, pa1, pa2, pa3); }
    if (two) { bf16x8 pa0, pa1, pa2, pa3; PK4(b0, 0, pa0); PK4(b0, 8, pa1); PK4(b1, 0, pa2); PK4(b1, 8, pa3); SBAR(); pv_tile<1>(o, A.vb0, pa0, pa1, pa2, pa3); }
    if (hi == 0) tab[32 + r32] = gt0;
    asm volatile("s_waitcnt lgkmcnt(0)" ::: "memory");
    { bf16_t* Ob = (bf16_t*)(ws + WS_NSA0) + ((size_t)b * T + 64 * jq + 8 * wid) * 1024 + kvh * 512;
      O_STORE(o, tab + 32, NSA_ROWPTR); }
    asm volatile("s_waitcnt lgkmcnt(0)" ::: "memory");
    __syncthreads();
#pragma unroll
    for (int i = 0; i < 4; ++i) { const int tok = (tid >> 5) + 16 * i, j = tid & 31; const LAS float* pr = PgL + tok * 128;
        float imp = pr[4 * j] + pr[4 * j + 1] + pr[4 * j + 2] + pr[4 * j + 3]; if (j > 0) imp += pr[4 * j - 1];
        const float scv = (j == 0 || j == jq || j == jq - 1) ? 1e9f : (j <= jq ? imp : -1e30f);
        SC[tok * 32 + j] = scv; }
    __syncthreads();
    unsigned uni_w = 0u;
#pragma unroll
    for (int i = 0; i < 4; ++i) { const int tok = (tid >> 5) + 16 * i, j = tid & 31; const float my = SC[tok * 32 + j]; int cnt = 0;
#pragma unroll
        for (int q = 0; q < 8; ++q) { const f32x4 v = *(const LAS f32x4*)(SC + tok * 32 + 4 * q);
#pragma unroll
            for (int e = 0; e < 4; ++e) { const int jj = 4 * q + e; cnt += (v[e] > my || (v[e] == my && jj < j)) ? 1 : 0; } }
        const unsigned long long bal = __ballot(cnt < 8);
        if ((lane & 31) == 0) SEL[tok] = (unsigned)(bal >> (lane & 32));
        uni_w |= (unsigned)bal | (unsigned)(bal >> 32); }
    if (lane == 0) atomicOr((unsigned*)UNI, uni_w);
    __syncthreads();
}
template <int MODE>
__device__ __forceinline__ void nsa_branch(Frame& F, int b, int kvh, int jq) {
    using namespace att;
    RELAUNDER();
    lptr lds = (lptr)F.ldsl; unsigned char* ws = arg_ws();
    const bf16_t* HID = (const bf16_t*)(ws + WS_HID); const float* GF = (const float*)(ws + WS_GF);
    const Lanes A = mk_lanes(F); const int wid = A.wid, r32 = A.r32, hi = A.hi;
    LAS float* tab = (LAS float*)(lds + OFF_WS) + wid * 64;
    LAS unsigned* SEL = (LAS unsigned*)(lds + OFF_SEL); LAS unsigned* UNI = (LAS unsigned*)(lds + OFF_UNI);
    const int tl = 8 * wid + (r32 >> 2), g = r32 & 3, t = 64 * jq + tl, hq = kvh * 4 + g;
    const size_t mrow = (size_t)b * T + t;
    const float NEG = -__builtin_inff();
    bf16x8 qr[8];
    { const bf16_t* qp = HID + mrow * LDP + hq * 128 + hi * 8;
#pragma unroll
      for (int d0 = 0; d0 < 8; ++d0) qr[d0] = *(const bf16x8*)(qp + d0 * 16); }
    const float gt = GF[mrow * 32 + hq * 3 + MODE];
    const bf16_t* Kb = HID + (size_t)b * T * LDP + C_KV + MODE * 512 + kvh * 128; const bf16_t* Vb = Kb + 256;
    unsigned U, Uw = 0xFFFFFFFFu, selm = 0xFFFFFFFFu;
    if (MODE == 1) {
        const unsigned causal = (jq == 31) ? 0xFFFFFFFFu : ((2u << jq) - 1u);
        selm = SEL[tl] & causal;
        U = (unsigned)__builtin_amdgcn_readfirstlane((int)(*UNI & causal));
        unsigned uw = selm; uw |= __shfl_xor(uw, 4); uw |= __shfl_xor(uw, 8); uw |= __shfl_xor(uw, 16); uw |= __shfl_xor(uw, 32);
        Uw = (unsigned)__builtin_amdgcn_readfirstlane((int)uw);
    } else {
        const int jlo = jq >= 8 ? jq - 8 : 0;
        U = (jq == 31 ? 0xFFFFFFFFu : ((2u << jq) - 1u)) & ~((1u << jlo) - 1u);
    }
    f32x16 o[4] = {}; float m = -1e30f, l = 0.f;
    unsigned rem = U; int j = __builtin_ctz(rem); rem &= rem - 1u;
    Stg st; stg_load(st, Kb + (size_t)(64 * j) * LDP, Vb + (size_t)(64 * j) * LDP, LDP, A.sr, A.sc);
    for (;;) {
        __syncthreads();
        stg_write(st, lds, 0, 0, A.kws, A.vst0, A.vst1);
        __syncthreads();
        int jn = -1; if (rem) { jn = __builtin_ctz(rem); rem &= rem - 1u; stg_load(st, Kb + (size_t)(64 * jn) * LDP, Vb + (size_t)(64 * jn) * LDP, LDP, A.sr, A.sc); }
        if ((Uw >> j) & 1u) {
            f32x16 p0, p1; qkt<0>(p0, p1, lds, r32, hi, qr);
            const bool rowsel = (MODE == 1) ? (((selm >> j) & 1u) != 0u) : true;
            const int dhi = (j == jq) ? (tl - 4 * hi) : 1000;
            const int dlo = (MODE == 2 && j == jq - 8) ? (tl - 4 * hi) : -1000;
#pragma unroll
            for (int r = 0; r < 16; ++r) { const int c = (r & 3) + 8 * (r >> 2);
                p0[r] = (rowsel && c <= dhi && c > dlo) ? p0[r] * C2 : NEG; p1[r] = (rowsel && c + 32 <= dhi && c + 32 > dlo) ? p1[r] * C2 : NEG; }
            softmax_pv(p0, p1, o, m, l, A.vb0, tab, r32, hi);
        }
        if (jn < 0) break;
        j = jn;
    }
    if (hi == 0) tab[32 + r32] = gt / l;
    asm volatile("s_waitcnt lgkmcnt(0)" ::: "memory");
    { bf16_t* Ob = (bf16_t*)(ws + (MODE == 1 ? WS_NSA1 : WS_NSA2)) + ((size_t)b * T + 64 * jq + 8 * wid) * 1024 + kvh * 512;
      O_STORE(o, tab + 32, NSA_ROWPTR); }
    asm volatile("s_waitcnt lgkmcnt(0)" ::: "memory");
}
#undef NSA_ROWPTR

__device__ __forceinline__ void phase_attn(Frame& F) {
    for (int it = F.vcu; it < 512; it += F.G) { const int b = it >> 5, h = (it >> 2) & 7, p = it & 3;
#if !defined(NO_FOX)
        for (int half = 0; half < 2; ++half) fox_block(F, b, h, half ? p : 7 - p);
#endif
    }
    for (int rd = 0; rd * F.G < 1024; ++rd) { const int i = rd * F.G + ((rd & 1) ? (F.G - 1 - F.vcu) : F.vcu); if (i >= 1024) continue;
        const int jq = 31 - (i >> 5), rem = i & 31, b = rem >> 1, kvh = rem & 1;
#if !defined(NO_NSA)
        nsa_cmp_select(F, b, kvh, jq);
        nsa_branch<1>(F, b, kvh, jq);
        nsa_branch<2>(F, b, kvh, jq);
#endif
    }
}

struct Args { const float* in[22]; float* out; unsigned char* ws; };
#define GRID_BAR() do { XcdBarrier bar_; bar_.bar = (unsigned*)(arg_ws() + WS_CTL) + CW_BAR; bar_.x = xb_xcc_id(); bar_.st = (volatile LAS unsigned*)(F.ldsl + MISC_OFF) + 8; xcd_barrier(bar_); RELAUNDER(); } while (0)
__global__ void __launch_bounds__(512, 2) mega_fwd(Args args) {
    extern __shared__ __attribute__((aligned(16))) unsigned char lds[];
    (void)args;
    Frame F;
    F.lds = lds; F.ldsl = (LAS unsigned char*)lds;
    F.tid = threadIdx.x; F.lane = F.tid & 63; F.wave = __builtin_amdgcn_readfirstlane(F.tid >> 6);
    F.G = gridDim.x; { const int bx = blockIdx.x; F.vcu = (F.G % 8 == 0) ? (bx % 8) * (F.G / 8) + bx / 8 : bx; }
    F.gw = F.vcu * 8 + F.wave; F.NGW = F.G * 8;
    for (int u = F.tid; u < (LDS_BYTES - LDSCTL_OFF) / 4; u += 512) ((LAS unsigned*)(F.ldsl + LDSCTL_OFF))[u] = 0u;
    __syncthreads();
    (void)xcd_barrier_post((unsigned*)(arg_ws() + WS_CTL) + CW_BAR, (volatile LAS unsigned*)(F.ldsl + MISC_OFF) + 8);
    for (int L = 0; L < NL; ++L) {
        for (int sb = 0; sb < 3; ++sb) {
            if (sb != 1) {
                const int first = (L == 0 && sb == 0);
#if !defined(NO_CONV)
                if (sb == 0) phase_convert(F, L);
#endif
                { const float* xin = first ? arg_in(0) : arg_out(); const float* g = (sb == 0 ? arg_in(1) : arg_in(18)) + L * DM;
                  phase_norm(F, xin, g, (bf16_t*)(arg_ws() + WS_HN)); }
                GRID_BAR();
#if !defined(NO_GB)
                { unsigned char* ws = arg_ws();
                  pg8::Gemm g{(const bf16_t*)(ws + WS_HN), (const bf16_t*)(ws + (sb == 0 ? WS_WGU : WS_WGU2)), M, 2 * DFF, DM}; pg8::StaticOrder S; S.init(M, 2 * DFF, F.G, (int)blockIdx.x);
                  pg8::EpiSwiglu E{(bf16_t*)(ws + WS_HID), DFF}; pg8::gemm_phase<pg8::EpiSwiglu, pg8::StaticOrder, true, true>(F.ldsl, g, S, E, F.tid); }
#endif
                GRID_BAR();
#if !defined(NO_GC)
                { unsigned char* ws = arg_ws(); const float* xin = first ? arg_in(0) : arg_out();
                  pg8::Gemm g{(const bf16_t*)(ws + WS_HID), (const bf16_t*)(ws + (sb == 0 ? WS_WD : WS_WD2)), M, DM, DFF}; pg8::StaticOrder S; S.init(M, DM, F.G, (int)blockIdx.x);
                  pg8::EpiResid E{xin, arg_out(), DM, 0.5f}; pg8::gemm_phase<pg8::EpiResid, pg8::StaticOrder, true, true>(F.ldsl, g, S, E, F.tid); }
#endif
                GRID_BAR();
            } else {
                phase_norm(F, arg_out(), arg_in(5) + L * DM, (bf16_t*)(arg_ws() + WS_HN));
                GRID_BAR();
#if !defined(NO_GE)
                { unsigned char* ws = arg_ws();
                  pg8::Gemm g{(const bf16_t*)(ws + WS_HN), (const bf16_t*)(ws + WS_WIN), M, NWIN, DM}; pg8::StaticOrder S; S.init(M, NWIN, F.G, (int)blockIdx.x);
                  pg8::EpiProj E{(bf16_t*)(ws + WS_HID), LDP, (float*)(ws + WS_GF)}; pg8::gemm_phase<pg8::EpiProj, pg8::StaticOrder, true, true>(F.ldsl, g, S, E, F.tid); }
#endif
                GRID_BAR();
#if !defined(NO_PREP)
                phase_prep(F, L);
#endif
                GRID_BAR();
#if !defined(NO_GG)
                { unsigned char* ws = arg_ws();
                  pg8::Gemm g{(const bf16_t*)(ws + WS_CMPA), (const bf16_t*)(ws + WS_WC1), 8192, 512, 4096}; pg8::CmpOrder S{F.G, (int)blockIdx.x};
                  pg8::EpiGeluCmp E{(bf16_t*)(ws + WS_CMPH)}; pg8::gemm_phase<pg8::EpiGeluCmp, pg8::CmpOrder, true, true>(F.ldsl, g, S, E, F.tid); }
#endif
                GRID_BAR();
#if !defined(NO_CMP2)
                phase_cmp2(F, L);
#endif
                GRID_BAR();
#if !defined(NO_ATTN)
                phase_attn(F);
#endif
                GRID_BAR();
#if !defined(NO_ONORM)
                phase_outnorm(F, L);
#endif
                GRID_BAR();
#if !defined(NO_GK)
                { unsigned char* ws = arg_ws();
                  pg8::Gemm g{(const bf16_t*)(ws + WS_HN), (const bf16_t*)(ws + WS_WOUT), M, DM, DM}; pg8::StaticOrder S; S.init(M, DM, F.G, (int)blockIdx.x);
                  pg8::EpiResid E{arg_out(), arg_out(), DM, 1.0f}; pg8::gemm_phase<pg8::EpiResid, pg8::StaticOrder, true, true>(F.ldsl, g, S, E, F.tid); }
#endif
                GRID_BAR();
            }
        }
    }
}

extern "C" void kernel_launch(void* const* d_in, const int* in_sizes, int n_in, void* d_out, int out_size, void* d_ws, size_t ws_size, hipStream_t stream) {
    static int grid = 0;
    if (grid == 0) {
        if (n_in != 22 || out_size != M * DM || ws_size < WS_END) { fprintf(stderr, "kernel_launch: unexpected shapes (n_in %d out %d ws %zu)\n", n_in, out_size, ws_size); grid = -1; return; }
        int dev = 0, cus = 0, per_cu = 0;
        if (hipGetDevice(&dev) != hipSuccess || hipDeviceGetAttribute(&cus, hipDeviceAttributeMultiprocessorCount, dev) != hipSuccess) { grid = -1; return; }
        if (hipFuncSetAttribute((const void*)mega_fwd, hipFuncAttributeMaxDynamicSharedMemorySize, LDS_BYTES) != hipSuccess) { fprintf(stderr, "kernel_launch: hipFuncSetAttribute failed\n"); grid = -1; return; }
        if (hipOccupancyMaxActiveBlocksPerMultiprocessor(&per_cu, (const void*)mega_fwd, 512, LDS_BYTES) != hipSuccess || per_cu < 1) fprintf(stderr, "kernel_launch: occupancy query reports %d\n", per_cu);
        (void)hipGetLastError();
        grid = cus;
    }
    if (grid < 0) return;
    (void)in_sizes;
    if (hipMemsetAsync((char*)d_ws + WS_CTL, 0, CTL_ZERO_BYTES, stream) != hipSuccess) return;
    Args a{};
    for (int i = 0; i < 22; ++i) a.in[i] = (const float*)d_in[i];
    a.out = (float*)d_out; a.ws = (unsigned char*)d_ws;
    hipLaunchKernelGGL(mega_fwd, dim3(grid), dim3(512), LDS_BYTES, stream, a);
}
```

```cpp
#include <hip/hip_runtime.h>
#include <cstdio>
#include <cstdint>

#ifndef PROBE_MASK
#define PROBE_MASK 0
#endif
#ifndef PROBE_K
#define PROBE_K 1
#endif
#define GAS __attribute__((address_space(1)))
#define LAS __attribute__((address_space(3)))
typedef unsigned short bf16_t;
typedef short bf16x8 __attribute__((ext_vector_type(8)));
typedef short s16x4 __attribute__((ext_vector_type(4)));
typedef float f32x4 __attribute__((ext_vector_type(4)));
typedef float f32x2 __attribute__((ext_vector_type(2)));
typedef float f32x16 __attribute__((ext_vector_type(16)));
typedef unsigned u32x4 __attribute__((ext_vector_type(4)));
typedef unsigned u32x2 __attribute__((ext_vector_type(2)));

constexpr int NB = 16, T = 2048, DM = 2048, M = NB * T, NL = 4, HD = 128, DFF = 5632;
constexpr int LDP = 5632;
constexpr int PROJ_COLS = 5664, NWIN = 5888;
constexpr int C_KV = 1024, C_FQ = 2560, C_FK = 3584, C_FV = 4608;
constexpr int NCMP = 127;
constexpr float EPS = 1e-6f;
constexpr float RS_SCALE = 16777216.0f, RS_INV = 1.0f / 16777216.0f / 2048.0f;
typedef unsigned long long u64_t;
constexpr float LOG2E = 1.4426950408889634f;
constexpr float C2 = 0.08838834764831845f * 1.4426950408889634f;

constexpr size_t MiB = 1u << 20;
constexpr size_t WS_CTL = 0, CTL_ZERO_BYTES = 1 * MiB;
constexpr size_t WS_ROPE = 1 * MiB;
constexpr size_t WS_CUM = 2 * MiB;
constexpr size_t WS_GF = 3 * MiB;
constexpr size_t WS_KC = 7 * MiB;
constexpr size_t WS_VC = 8 * MiB;
constexpr size_t WS_CMPH = 9 * MiB;
constexpr size_t WS_WGU = 16 * MiB;
constexpr size_t WS_WD = 60 * MiB;
constexpr size_t WS_WIN = 82 * MiB;
constexpr size_t WS_WOUT = 105 * MiB;
constexpr size_t WS_WGU2 = 113 * MiB;
constexpr size_t WS_WD2 = 157 * MiB;
constexpr size_t WS_WC1 = 179 * MiB;
constexpr size_t WS_LF = 183 * MiB;
constexpr size_t WS_CMPA = 184 * MiB;
constexpr size_t WS_HN = 248 * MiB;
constexpr size_t WS_HID = 376 * MiB;
constexpr size_t WS_NSA0 = 728 * MiB, WS_NSA1 = 792 * MiB, WS_NSA2 = 856 * MiB;
constexpr size_t WS_XB = 920 * MiB;
constexpr size_t WS_RS = 13 * MiB, RS_BYTES = (size_t)NL * 3 * M * 8;
constexpr size_t WSET = 1032 * MiB;
constexpr size_t WS_PS = 1216 * MiB;
constexpr size_t WS_END = 1216 * MiB + 48 * MiB;
constexpr int CW_BAR = 4096;

constexpr int RING_BYTES = 131072;
constexpr int LDSCTL_OFF = RING_BYTES, MISC_OFF = LDSCTL_OFF + 320;
constexpr int RL_OFF = LDSCTL_OFF + 1024;
constexpr int LDS_BYTES = 147456;

__device__ __forceinline__ unsigned long long karg(int i) {
    const __attribute__((address_space(4))) unsigned char* kp = (const __attribute__((address_space(4))) unsigned char*)__builtin_amdgcn_kernarg_segment_ptr();
    return *(const __attribute__((address_space(4))) unsigned long long volatile*)(kp + 8 * i);
}
__device__ __forceinline__ const float* arg_in(int i) { return (const float*)(const GAS float*)karg(i); }
__device__ __forceinline__ float* arg_out() { return (float*)(GAS float*)karg(22); }
__device__ __forceinline__ unsigned char* arg_ws() { return (unsigned char*)(GAS unsigned char*)karg(23); }
namespace pg8 {
#define PG8_LAS __attribute__((address_space(3)))
constexpr int BM = 256, BK = 64, HALF = 128, HTB = HALF * BK * 2, STAGE_BYTES = 8 * HTB, NXCD = 8, WGM = 8;
__host__ __device__ __forceinline__ int lds_byte(int r, int c) { const int st = (r >> 4) * 2 + (c >> 5), rr = r & 15, cc = c & 31, ob = rr * 64 + cc * 2; return st * 1024 + (ob ^ (((ob >> 9) & 1) << 5)); }
__host__ __device__ __forceinline__ void stage_rc(int b, int& R, int& C) { const int st = b / 1024, sb = b % 1024, swz = sb ^ (((sb >> 9) & 1) << 5); R = (st >> 1) * 16 + swz / 64; C = (st & 1) * 32 + (swz % 64) / 2; }
__host__ __device__ __forceinline__ int perm32(int rho) { const int n = rho >> 4, i = rho & 15; return 8 * (i >> 2) + 4 * n + (i & 3); }
struct Unit { int pm, pn; };
struct Gemm { const bf16_t* A; const bf16_t* Bt; int M, N, K; };
struct StaticOrder {
    int nM, nN, nwg, G, c, rev, wgm;
    __host__ __device__ void init(int M_, int N_, int G_, int c_) { nM = M_ / BM; nN = N_ / BM; nwg = nM * nN; G = G_; c = c_; rev = 0; wgm = WGM; }
    __host__ __device__ bool next(int i, Unit& u) const {
        const long L = (long)i * G + c; if (L >= nwg) return false;
        int wgid = (int)L; { const int q = nwg / NXCD, r = nwg % NXCD, xcd = wgid % NXCD, off = wgid / NXCD; wgid = (xcd < r ? xcd * (q + 1) : r * (q + 1) + (xcd - r) * q) + off; }
        const int nig = wgm * nN, gid = wgid / nig, fm = gid * wgm, gsz = (nM - fm) < wgm ? (nM - fm) : wgm;
        u.pm = fm + ((wgid % nig) % gsz); u.pn = (wgid % nig) / gsz; if (rev) u.pm = nM - 1 - u.pm; return true;
    }
    __device__ __forceinline__ void a_ready(const Unit&) const {}
    __device__ __forceinline__ void done(const Unit&) const {}
};
struct CmpOrder {
    int G, c;
    __device__ bool next(int i, Unit& u) const { const int L = i * G + c; if (L >= 32) return false; u.pm = L; u.pn = L >> 4; return true; }
    __device__ __forceinline__ void a_ready(const Unit&) const {}
    __device__ __forceinline__ void done(const Unit&) const {}
};
typedef float cvf32x2_t __attribute__((ext_vector_type(2)));
typedef __bf16 cvbf16x2_t __attribute__((ext_vector_type(2)));
__device__ __forceinline__ unsigned cvt_pk_bf16(float lo, float hi) { const cvf32x2_t v = {lo, hi}; const cvbf16x2_t b = __builtin_convertvector(v, cvbf16x2_t); return __builtin_bit_cast(unsigned, b); }

__device__ __forceinline__ float silu_f(float g) { return g * __builtin_amdgcn_rcpf(1.0f + __builtin_amdgcn_exp2f(-g * LOG2E)); }
struct EpiSwiglu {
    static constexpr bool PERM = true, AFTER_DRAIN = false;
    bf16_t* O; int ldc; const float* rs; PG8_LAS float* rl; mutable int cpm;
    __device__ __forceinline__ void operator()(const f32x4 (&acc)[2][2][4][2], const Unit& u, int wr, int wc, int fr, int fq) const {
        const int row0 = u.pm * BM + wr * 64 + fr, col0 = u.pn * HALF + wc * 32 + 8 * fq;
        if (u.pm != cpm) {
            const int t = (wr * 4 + wc) * 64 + fq * 16 + fr;
            if (t < 256) { const f32x4* pp = (const f32x4*)(rs + (size_t)(u.pm * BM + t) * 32); float sq = 0.f;
_Pragma("unroll") for (int i = 0; i < 8; ++i) { const f32x4 v = pp[i]; sq += (v[0] + v[1]) + (v[2] + v[3]); }
                rl[t] = 1.0f / sqrtf(sq * (1.0f / DM) + EPS); }
            cpm = u.pm;
            asm volatile("s_waitcnt lgkmcnt(0)" ::: "memory"); __builtin_amdgcn_s_barrier(); asm volatile("" ::: "memory");
        }
#pragma unroll
        for (int ai = 0; ai < 2; ++ai)
#pragma unroll
            for (int m = 0; m < 4; ++m) { bf16_t* rowp = O + (size_t)(row0 + ai * HALF + m * 16) * ldc + col0;
                const float r = rl[wr * 64 + fr + ai * HALF + m * 16];
                const f32x4 g0 = acc[ai][0][m][0] * r, g1 = acc[ai][0][m][1] * r, u0 = acc[ai][1][m][0] * r, u1 = acc[ai][1][m][1] * r;
                u32x4 w;
                w.x = cvt_pk_bf16(silu_f(g0[0]) * u0[0], silu_f(g0[1]) * u0[1]); w.y = cvt_pk_bf16(silu_f(g0[2]) * u0[2], silu_f(g0[3]) * u0[3]);
                w.z = cvt_pk_bf16(silu_f(g1[0]) * u1[0], silu_f(g1[1]) * u1[1]); w.w = cvt_pk_bf16(silu_f(g1[2]) * u1[2], silu_f(g1[3]) * u1[3]);
                __builtin_nontemporal_store(w, (u32x4*)rowp); }
    }
};
struct EpiResid {
    static constexpr bool PERM = true, AFTER_DRAIN = false;
    float scale; int final_out; int rs_idx;
    __device__ __forceinline__ void operator()(const f32x4 (&acc)[2][2][4][2], const Unit& u, int wr, int wc, int fr, int fq) const {
        const int row0 = u.pm * BM + wr * 64 + fr, col0 = u.pn * BM + wc * 32 + 8 * fq;
        constexpr int ldc = DM;
        bf16_t* xb = (bf16_t*)(arg_ws() + WS_XB); float* out = arg_out();
        float* ps = (float*)(arg_ws() + WS_PS) + (size_t)rs_idx * M * 32 + u.pn * 4 + wc;
#pragma unroll
        for (int ai = 0; ai < 2; ++ai) {
            u32x4 bs[4][2];
#pragma unroll
            for (int m = 0; m < 4; ++m) { const size_t off = (size_t)(row0 + ai * HALF + m * 16) * ldc + col0;
#pragma unroll
                for (int bj = 0; bj < 2; ++bj) bs[m][bj] = *(const u32x4*)(xb + off + bj * HALF); }
            __builtin_amdgcn_sched_barrier(0);
#pragma unroll
            for (int m = 0; m < 4; ++m) { const int row = row0 + ai * HALF + m * 16; const size_t off = (size_t)row * ldc + col0; float ss = 0.f;
#pragma unroll
                for (int bj = 0; bj < 2; ++bj) { const u32x4 b = bs[m][bj]; u32x4 w;
#pragma unroll
                    for (int n = 0; n < 2; ++n) { const f32x4 a = acc[ai][bj][m][n]; const unsigned bx = n ? b.z : b.x, by = n ? b.w : b.y;
                        const f32x4 v = {__uint_as_float(bx << 16) + a[0] * scale, __uint_as_float(bx & 0xffff0000u) + a[1] * scale, __uint_as_float(by << 16) + a[2] * scale, __uint_as_float(by & 0xffff0000u) + a[3] * scale};
                        if (final_out) *(f32x4*)(out + off + bj * HALF + 4 * n) = v;
                        else { const unsigned p0 = cvt_pk_bf16(v[0], v[1]), p1 = cvt_pk_bf16(v[2], v[3]); if (n) { w.z = p0; w.w = p1; } else { w.x = p0; w.y = p1; }
                            ss += (v[0] * v[0] + v[1] * v[1]) + (v[2] * v[2] + v[3] * v[3]); } }
                    if (!final_out) *(u32x4*)(xb + off + bj * HALF) = w; }
                if (!final_out) { ss += __shfl_xor(ss, 16); ss += __shfl_xor(ss, 32); if (fq == 0) ps[(size_t)row * 32] = ss; } }
            __builtin_amdgcn_sched_barrier(0);
        }
    }
};
struct EpiProj {
    static constexpr bool PERM = true, AFTER_DRAIN = false;
    bf16_t* O; int ldc; float* GF; const float* rs; PG8_LAS float* rl; mutable int cpm;
    __device__ __forceinline__ void operator()(const f32x4 (&acc)[2][2][4][2], const Unit& u, int wr, int wc, int fr, int fq) const {
        const int row0 = u.pm * BM + wr * 64 + fr;
        if (u.pm != cpm) {
            const int t = (wr * 4 + wc) * 64 + fq * 16 + fr;
            if (t < 256) { const f32x4* pp = (const f32x4*)(rs + (size_t)(u.pm * BM + t) * 32); float sq = 0.f;
_Pragma("unroll") for (int i = 0; i < 8; ++i) { const f32x4 v = pp[i]; sq += (v[0] + v[1]) + (v[2] + v[3]); }
                rl[t] = 1.0f / sqrtf(sq * (1.0f / DM) + EPS); }
            cpm = u.pm;
            asm volatile("s_waitcnt lgkmcnt(0)" ::: "memory"); __builtin_amdgcn_s_barrier(); asm volatile("" ::: "memory");
        }
        float rr[2][4];
#pragma unroll
        for (int ai = 0; ai < 2; ++ai)
#pragma unroll
            for (int m = 0; m < 4; ++m) rr[ai][m] = rl[wr * 64 + fr + ai * HALF + m * 16];
        if (u.pn < 22) {
            const int col0 = u.pn * BM + wc * 32 + 8 * fq;
#pragma unroll
            for (int ai = 0; ai < 2; ++ai)
#pragma unroll
                for (int m = 0; m < 4; ++m) { bf16_t* rowp = O + (size_t)(row0 + ai * HALF + m * 16) * ldc + col0; const float r = rr[ai][m];
#pragma unroll
                    for (int bj = 0; bj < 2; ++bj) { const f32x4 v0 = acc[ai][bj][m][0] * r, v1 = acc[ai][bj][m][1] * r;
                        u32x4 w; w.x = cvt_pk_bf16(v0[0], v0[1]); w.y = cvt_pk_bf16(v0[2], v0[3]); w.z = cvt_pk_bf16(v1[0], v1[1]); w.w = cvt_pk_bf16(v1[2], v1[3]);
                        *(u32x4*)(rowp + bj * HALF) = w; } }
        } else if (wc == 0) {
#pragma unroll
            for (int ai = 0; ai < 2; ++ai)
#pragma unroll
                for (int m = 0; m < 4; ++m) { float* rowp = GF + (size_t)(row0 + ai * HALF + m * 16) * 32 + 8 * fq; const float r = rr[ai][m];
                    *(f32x4*)rowp = acc[ai][0][m][0] * r; *(f32x4*)(rowp + 4) = acc[ai][0][m][1] * r; }
        }
    }
};
__device__ __forceinline__ float gelu_tanh_f(float x) {
    const float u2 = 1.5957691216057308f * (x + 0.044715f * x * x * x);
    return x * __builtin_amdgcn_rcpf(1.0f + __builtin_amdgcn_exp2f(-u2 * LOG2E));
}
struct EpiGeluCmp {
    static constexpr bool PERM = true, AFTER_DRAIN = false;
    bf16_t* O;
    __device__ __forceinline__ void operator()(const f32x4 (&acc)[2][2][4][2], const Unit& u, int wr, int wc, int fr, int fq) const {
        const int row0 = u.pm * BM + wr * 64 + fr, col0 = wc * 32 + 8 * fq;
#pragma unroll
        for (int ai = 0; ai < 2; ++ai)
#pragma unroll
            for (int m = 0; m < 4; ++m) { bf16_t* rowp = O + (size_t)(row0 + ai * HALF + m * 16) * 256 + col0;
#pragma unroll
                for (int bj = 0; bj < 2; ++bj) { const f32x4 v0 = acc[ai][bj][m][0], v1 = acc[ai][bj][m][1];
                    u32x4 w; w.x = cvt_pk_bf16(gelu_tanh_f(v0[0]), gelu_tanh_f(v0[1])); w.y = cvt_pk_bf16(gelu_tanh_f(v0[2]), gelu_tanh_f(v0[3]));
                    w.z = cvt_pk_bf16(gelu_tanh_f(v1[0]), gelu_tanh_f(v1[1])); w.w = cvt_pk_bf16(gelu_tanh_f(v1[2]), gelu_tanh_f(v1[3]));
                    *(u32x4*)(rowp + bj * HALF) = w; } }
    }
};

template <class Epi, class Sched, bool ALIGN_EPI = false, bool SP2 = false>
__device__ __forceinline__ void gemm_phase(PG8_LAS unsigned char* lds, const Gemm g, const Sched& S, const Epi& E, const int tid) {
    const int wid = __builtin_amdgcn_readfirstlane(tid >> 6), lane = tid & 63, wr = wid >> 2, wc = wid & 3, fr = lane & 15, fq = lane >> 4;
    const int K = g.K, nt = K / BK;
    unsigned voffA[2], voffB[2];
#pragma unroll
    for (int i = 0; i < 2; ++i) { int R, C; stage_rc(tid * 16 + i * 8192, R, C); const int Rb = Epi::PERM ? ((R & ~31) + perm32(R & 31)) : R;
        voffA[i] = (unsigned)(R * K + C) * 2u; voffB[i] = (unsigned)(Rb * K + C) * 2u; }
    const size_t kstep = (size_t)(BK * 2);
    const size_t hstep = (size_t)HALF * K * 2;
    const size_t tstep = 2 * hstep;
    const unsigned ldsw = (unsigned)wid * 1024u;
    const int aoff = lds_byte(wr * 64 + fr, fq * 8), boff = lds_byte(wc * 32 + fr, fq * 8);
#define PG8_SA(b, h) (((b) * 2 + (h)) * HTB)
#define PG8_SB(b, h) ((4 + (b) * 2 + (h)) * HTB)
#define PG8_STAGE(bufoff, gbase, voff) do { _Pragma("unroll") for (int _i = 0; _i < 2; ++_i) \
        __builtin_amdgcn_global_load_lds((const unsigned*)((const char*)(gbase) + (voff)[_i]), (PG8_LAS unsigned*)(lds + (bufoff) + ldsw + _i * 8192), 16, 0, 0); } while (0)
#define PG8_LDA(dst, b, h) do { _Pragma("unroll") for (int m = 0; m < 4; ++m) _Pragma("unroll") for (int k = 0; k < 2; ++k) dst[m][k] = *(const PG8_LAS bf16x8*)(lds + PG8_SA(b, h) + aoff + m * 2048 + k * 1024); } while (0)
#define PG8_LDB(dst, b, h) do { _Pragma("unroll") for (int n = 0; n < 2; ++n) _Pragma("unroll") for (int k = 0; k < 2; ++k) dst[n][k] = *(const PG8_LAS bf16x8*)(lds + PG8_SB(b, h) + boff + n * 2048 + k * 1024); } while (0)
#define PG8_MMA(ai, bj, At, Bt) do { __builtin_amdgcn_s_setprio(1); _Pragma("unroll") for (int m = 0; m < 4; ++m) _Pragma("unroll") for (int n = 0; n < 2; ++n) _Pragma("unroll") for (int k = 0; k < 2; ++k) \
        acc[ai][bj][m][n] = __builtin_amdgcn_mfma_f32_16x16x32_bf16(Bt[n][k], At[m][k], acc[ai][bj][m][n], 0, 0, 0); __builtin_amdgcn_s_setprio(0); } while (0)
#define PG8_WAIT_V(n) asm volatile("s_waitcnt vmcnt(" #n ")" ::: "memory")
#define PG8_WAIT_L(n) asm volatile("s_waitcnt lgkmcnt(" #n ")" ::: "memory")
#define PG8_BAR __builtin_amdgcn_s_barrier()
#define PG8_SCHED __builtin_amdgcn_sched_barrier(0)
    Unit cur, nxt; int ui = 0;
    if (!S.next(0, cur)) return;
    f32x4 acc[2][2][4][2];
#pragma unroll
    for (int a = 0; a < 2; ++a)
#pragma unroll
        for (int b = 0; b < 2; ++b)
#pragma unroll
            for (int m = 0; m < 4; ++m)
#pragma unroll
                for (int n = 0; n < 2; ++n) acc[a][b][m][n] = (f32x4){0.f, 0.f, 0.f, 0.f};
    bf16x8 At[4][2], B0[2][2], B1[2][2];
    const char* cA = (const char*)g.A + (size_t)cur.pm * tstep; const char* cB = (const char*)g.Bt + (size_t)cur.pn * tstep;
    S.a_ready(cur);
    if constexpr (SP2) {
        PG8_STAGE(PG8_SB(0, 0), cB, voffB); PG8_STAGE(PG8_SB(0, 1), cB + hstep, voffB); PG8_STAGE(PG8_SA(0, 0), cA, voffA); PG8_STAGE(PG8_SA(0, 1), cA + hstep, voffA);
        if (wr == 1) PG8_BAR;
        PG8_WAIT_V(2); PG8_BAR;
        PG8_STAGE(PG8_SB(1, 0), cB + kstep, voffB); PG8_STAGE(PG8_SA(1, 0), cA + kstep, voffA); PG8_STAGE(PG8_SB(1, 1), cB + hstep + kstep, voffB);
        PG8_WAIT_V(6); PG8_BAR;
    } else {
        PG8_STAGE(PG8_SB(0, 0), cB, voffB); PG8_STAGE(PG8_SA(0, 0), cA, voffA); PG8_STAGE(PG8_SB(0, 1), cB + hstep, voffB); PG8_STAGE(PG8_SA(0, 1), cA + hstep, voffA);
        if (wr == 1) PG8_BAR;
        PG8_WAIT_V(4); PG8_BAR;
        PG8_STAGE(PG8_SB(1, 0), cB + kstep, voffB); PG8_STAGE(PG8_SA(1, 0), cA + kstep, voffA); PG8_STAGE(PG8_SB(1, 1), cB + hstep + kstep, voffB);
        PG8_WAIT_V(6); PG8_BAR;
    }
    for (;;) {
        const bool has_next = S.next(ui + 1, nxt);
        const char* nA = has_next ? (const char*)g.A + (size_t)nxt.pm * tstep : cA; const char* nB = has_next ? (const char*)g.Bt + (size_t)nxt.pn * tstep : cB;
        for (int t = 0; t < nt; t += 2) {
            const bool last = (t == nt - 2);
            const char* a1 = cA + (size_t)(t + 1) * kstep;
            const char* a2 = last ? nA : cA + (size_t)(t + 2) * kstep; const char* b2 = last ? nB : cB + (size_t)(t + 2) * kstep;
            const char* a3 = a2 + kstep; const char* b3 = b2 + kstep;
            if (last && has_next) S.a_ready(nxt);
            if constexpr (SP2) {
            PG8_LDB(B0, 0, 0); PG8_LDB(B1, 0, 1); PG8_SCHED; PG8_LDA(At, 0, 0); PG8_STAGE(PG8_SA(1, 1), a1 + hstep, voffA);
            PG8_WAIT_V(8); PG8_WAIT_L(0); PG8_BAR; PG8_MMA(0, 0, At, B0); PG8_MMA(0, 1, At, B1); PG8_BAR; PG8_SCHED;
            PG8_LDA(At, 0, 1); PG8_STAGE(PG8_SB(0, 0), b2, voffB); PG8_STAGE(PG8_SB(0, 1), b2 + hstep, voffB); PG8_STAGE(PG8_SA(0, 0), a2, voffA);
            PG8_WAIT_V(8); PG8_WAIT_L(0); PG8_BAR; PG8_MMA(1, 0, At, B0); PG8_MMA(1, 1, At, B1); PG8_BAR; PG8_SCHED;
            PG8_LDB(B0, 1, 0); PG8_LDB(B1, 1, 1); PG8_SCHED; PG8_LDA(At, 1, 0); PG8_STAGE(PG8_SA(0, 1), a2 + hstep, voffA);
            PG8_WAIT_V(8); PG8_WAIT_L(0); PG8_BAR; PG8_MMA(0, 0, At, B0); PG8_MMA(0, 1, At, B1); PG8_BAR; PG8_SCHED;
            PG8_LDA(At, 1, 1); PG8_STAGE(PG8_SB(1, 0), b3, voffB); PG8_STAGE(PG8_SB(1, 1), b3 + hstep, voffB); PG8_STAGE(PG8_SA(1, 0), a3, voffA);
            PG8_WAIT_V(8); PG8_WAIT_L(0); PG8_BAR; PG8_MMA(1, 0, At, B0); PG8_MMA(1, 1, At, B1); PG8_BAR; PG8_SCHED;
            } else {
            PG8_LDB(B0, 0, 0); PG8_SCHED; PG8_LDA(At, 0, 0); PG8_STAGE(PG8_SA(1, 1), a1 + hstep, voffA);
            PG8_WAIT_L(8); PG8_BAR; PG8_WAIT_L(0); PG8_MMA(0, 0, At, B0); PG8_BAR; PG8_SCHED;
            PG8_LDB(B1, 0, 1); PG8_STAGE(PG8_SB(0, 0), b2, voffB);
            PG8_BAR; PG8_WAIT_L(0); PG8_MMA(0, 1, At, B1); PG8_BAR;
            PG8_LDA(At, 0, 1); PG8_STAGE(PG8_SA(0, 0), a2, voffA);
            PG8_BAR; PG8_WAIT_L(0); PG8_MMA(1, 0, At, B0); PG8_BAR; PG8_SCHED;
            PG8_STAGE(PG8_SB(0, 1), b2 + hstep, voffB);
            PG8_WAIT_V(6); PG8_BAR; PG8_MMA(1, 1, At, B1); PG8_BAR;
            PG8_LDB(B0, 1, 0); PG8_SCHED; PG8_LDA(At, 1, 0); PG8_STAGE(PG8_SA(0, 1), a2 + hstep, voffA);
            PG8_WAIT_L(8); PG8_BAR; PG8_WAIT_L(0); PG8_MMA(0, 0, At, B0); PG8_BAR; PG8_SCHED;
            PG8_LDB(B1, 1, 1); PG8_STAGE(PG8_SB(1, 0), b3, voffB);
            PG8_BAR; PG8_WAIT_L(0); PG8_MMA(0, 1, At, B1); PG8_BAR;
            PG8_LDA(At, 1, 1); PG8_STAGE(PG8_SA(1, 0), a3, voffA);
            PG8_BAR; PG8_WAIT_L(0); PG8_MMA(1, 0, At, B0); PG8_BAR; PG8_SCHED;
            PG8_STAGE(PG8_SB(1, 1), b3 + hstep, voffB);
            PG8_WAIT_V(6); PG8_BAR; PG8_MMA(1, 1, At, B1); PG8_BAR;
            }
        }
        if constexpr (ALIGN_EPI) { if (wr == 0) PG8_BAR; }
        if constexpr (!Epi::AFTER_DRAIN) { E(acc, cur, wr, wc, fr, fq); S.done(cur); }
        if (!has_next) break;
#pragma unroll
        for (int a = 0; a < 2; ++a)
#pragma unroll
            for (int b = 0; b < 2; ++b)
#pragma unroll
                for (int m = 0; m < 4; ++m)
#pragma unroll
                    for (int n = 0; n < 2; ++n) acc[a][b][m][n] = (f32x4){0.f, 0.f, 0.f, 0.f};
        cur = nxt; cA = nA; cB = nB; ++ui;
        if constexpr (ALIGN_EPI) { if (wr == 1) PG8_BAR; }
    }
    PG8_WAIT_V(0);
    if constexpr (!ALIGN_EPI) { if (wr == 0) PG8_BAR; }
    PG8_BAR;
#undef PG8_SA
#undef PG8_SB
#undef PG8_STAGE
#undef PG8_LDA
#undef PG8_LDB
#undef PG8_MMA
#undef PG8_WAIT_V
#undef PG8_WAIT_L
#undef PG8_BAR
#undef PG8_SCHED
}
}

#define XB_TMO      128
#define XB_XCNT(j)  (256  + 64 * (j))
#define XB_XSUB(j)  (1280 + 64 * (j))
#define XB_XGEN(j)  (2304 + 64 * (j))
#define XB_TOP      3328
#define XB_TOPGEN   3392
#define XCD_BAR_WORDS 3456
#define XB_SPIN_CAP (1u << 18)
__device__ __forceinline__ unsigned xb_ld(unsigned* p)              { return __hip_atomic_load(p, __ATOMIC_RELAXED, __HIP_MEMORY_SCOPE_AGENT); }
__device__ __forceinline__ unsigned xb_add(unsigned* p, unsigned v) { return __hip_atomic_fetch_add(p, v, __ATOMIC_RELAXED, __HIP_MEMORY_SCOPE_AGENT); }
__device__ __forceinline__ unsigned xb_xcc_id() { return (unsigned)__builtin_amdgcn_s_getreg((3 << 11) | 20) & 0xFu; }
#define XB_SPIN(cond, bar) do { unsigned _sp = 0; while (cond) { __builtin_amdgcn_s_sleep(1); \
    if ((++_sp & 255u) == 0u) { if (xb_ld(&(bar)[XB_TMO])) break; if (_sp > XB_SPIN_CAP) { atomicAdd(&(bar)[XB_TMO], 1u); break; } } } } while (0)
struct XcdBarrier { unsigned* bar; unsigned x; volatile LAS unsigned* st; };
__device__ __forceinline__ XcdBarrier xcd_barrier_post(unsigned* bar, volatile LAS unsigned* st) {
    XcdBarrier b; b.bar = bar; b.x = xb_xcc_id(); b.st = st;
    if (threadIdx.x == 0) (void)xb_add(&bar[XB_XCNT(b.x)], 1u);
    return b;
}
__device__ __forceinline__ void xcd_barrier_complete(unsigned* bar, unsigned x, unsigned& nloc, unsigned& nx) {
    const unsigned G = gridDim.x * gridDim.y * gridDim.z;
    unsigned sum, cnt, mine, sp = 0u;
    for (;;) {
        sum = 0u; cnt = 0u; mine = 0u;
#pragma unroll
        for (unsigned j = 0; j < 16; ++j) { const unsigned c = xb_ld(&bar[XB_XCNT(j)]); sum += c; cnt += (c > 0u) ? 1u : 0u; mine = (j == x) ? c : mine; }
        if (sum == G) break;
        __builtin_amdgcn_s_sleep(1);
        if ((++sp & 255u) == 0u) { if (xb_ld(&bar[XB_TMO])) break; if (sp > XB_SPIN_CAP) { atomicAdd(&bar[XB_TMO], 1u); break; } }
    }
    nloc = mine > 0u ? mine : 1u; nx = cnt > 0u ? cnt : 1u;
}
__device__ __forceinline__ void xcd_barrier(const XcdBarrier& b) {
    asm volatile("s_waitcnt vmcnt(0)" ::: "memory");
    __syncthreads();
    if (threadIdx.x == 0) {
        unsigned* bar = b.bar;
        __builtin_amdgcn_s_waitcnt(0);
        unsigned nloc = b.st[0], nx = b.st[1];
        if (nloc == 0u) { xcd_barrier_complete(bar, b.x, nloc, nx); b.st[0] = nloc; b.st[1] = nx; }
        const unsigned old = xb_add(&bar[XB_XSUB(b.x)], 1u);
        const unsigned gen = old / nloc;
        if (old + 1u == (gen + 1u) * nloc) {
            __builtin_amdgcn_fence(__ATOMIC_RELEASE, "agent");
            asm volatile("s_waitcnt vmcnt(0)" ::: "memory");
            const unsigned og = xb_add(&bar[XB_TOP], 1u);
            const unsigned tg = og / nx;
            if (og + 1u == (tg + 1u) * nx) xb_add(&bar[XB_TOPGEN], 1u);
            else XB_SPIN(xb_ld(&bar[XB_TOPGEN]) == tg, bar);
            __builtin_amdgcn_fence(__ATOMIC_ACQUIRE, "agent");
            xb_add(&bar[XB_XGEN(b.x)], 1u);
            asm volatile("s_waitcnt vmcnt(0)" ::: "memory");
        } else {
            XB_SPIN(xb_ld(&bar[XB_XGEN(b.x)]) == gen, bar);
            __builtin_amdgcn_fence(__ATOMIC_ACQUIRE, "agent");
            asm volatile("s_waitcnt vmcnt(0)" ::: "memory");
        }
    }
    __syncthreads();
}

#define LDS_WAIT() asm volatile("s_waitcnt lgkmcnt(0)" ::: "memory")
#define SBAR() __builtin_amdgcn_sched_barrier(0)
__device__ __forceinline__ float wave_sum(float v) {
#pragma unroll
    for (int o = 1; o < 64; o <<= 1) v += __shfl_xor(v, o);
    return v;
}
__device__ __forceinline__ unsigned cvtpk(float lo, float hi) { return pg8::cvt_pk_bf16(lo, hi); }
__device__ __forceinline__ float bf_lo(unsigned w) { return __uint_as_float(w << 16); }
__device__ __forceinline__ float bf_hi(unsigned w) { return __uint_as_float(w & 0xffff0000u); }

struct Frame {
    unsigned char* lds; LAS unsigned char* ldsl;
    int tid, lane, wave, vcu, G, gw, NGW;
};
#if PROBE_MASK
#define STAMP(type) do { if (blockIdx.x == 0 && F.tid == 0) { const unsigned long long now_ = __builtin_amdgcn_s_memrealtime(); volatile LAS unsigned long long* pa_ = (volatile LAS unsigned long long*)(F.ldsl + MISC_OFF + 64); pa_[type] += now_ - pa_[15]; pa_[15] = now_; } } while (0)
#else
#define STAMP(type) do { } while (0)
#endif
#define RELAUNDER() do { int t_ = threadIdx.x; asm volatile("" : "+v"(t_)); F.tid = t_; F.lane = t_ & 63; F.wave = __builtin_amdgcn_readfirstlane(t_ >> 6); F.gw = F.vcu * 8 + F.wave; } while (0)

struct CvItem { const float* src; bf16_t* dst; const float* gain; int K, N, kind, k0, n0; };
__device__ __forceinline__ int cv_rowmap(int kind, int n) {
    if (kind == 1 || kind == 2) return 256 * (n >> 7) + (kind - 1) * 128 + (n & 127);
    if (kind == 3) return n < 2560 ? n : (n < 2584 ? 5632 + (n - 2560) : (n < 5656 ? n - 24 : n));
    if (kind == 4) return 256 + n;
    return n;
}
__device__ __forceinline__ void cv_load(const CvItem& c, float (&v)[32], int lane) {
    const float* p = c.src + (size_t)(c.k0 + (lane >> 5)) * c.N + c.n0 + (lane & 31);
#pragma unroll
    for (int i = 0; i < 32; ++i) v[i] = __builtin_nontemporal_load(p + (size_t)(2 * i) * c.N);
}
__device__ __forceinline__ void cv_store(const CvItem& c, const float (&v)[32], LAS float* scr, int lane) {
#pragma unroll
    for (int i = 0; i < 32; ++i) scr[(2 * i + (lane >> 5)) * 33 + (lane & 31)] = v[i];
    LDS_WAIT(); asm volatile("" ::: "memory");
    const int cc = lane & 7;
    f32x4 ga = {1.f, 1.f, 1.f, 1.f}, gb = ga;
    if (c.gain) { ga = *(const f32x4*)(c.gain + c.k0 + 8 * cc); gb = *(const f32x4*)(c.gain + c.k0 + 8 * cc + 4); }
#pragma unroll
    for (int j = 0; j < 4; ++j) { const int n = (lane >> 3) + 8 * j; const LAS float* s = scr + (8 * cc) * 33 + n;
        u32x4 o; o.x = cvtpk(s[0 * 33] * ga.x, s[1 * 33] * ga.y); o.y = cvtpk(s[2 * 33] * ga.z, s[3 * 33] * ga.w); o.z = cvtpk(s[4 * 33] * gb.x, s[5 * 33] * gb.y); o.w = cvtpk(s[6 * 33] * gb.z, s[7 * 33] * gb.w);
        __builtin_nontemporal_store(o, (u32x4*)(c.dst + (size_t)cv_rowmap(c.kind, c.n0 + n) * c.K + c.k0 + 8 * cc)); }
    LDS_WAIT(); asm volatile("" ::: "memory");
}
__device__ __forceinline__ void prenorm_row(const float* xrow, const float* g, bf16_t* orow, float* rs, int lane) {
    const f32x4* xr = (const f32x4*)xrow + lane; f32x4 v[8]; float s = 0.f;
#pragma unroll
    for (int j = 0; j < 8; ++j) { v[j] = xr[64 * j]; s += (v[j].x * v[j].x + v[j].y * v[j].y) + (v[j].z * v[j].z + v[j].w * v[j].w); }
    s = wave_sum(s);
    (void)g; u32x2* o8 = (u32x2*)orow + lane;
#pragma unroll
    for (int j = 0; j < 8; ++j) { u32x2 w; w.x = cvtpk(v[j].x, v[j].y); w.y = cvtpk(v[j].z, v[j].w); o8[64 * j] = w; }
    if (lane < 32) rs[lane] = lane == 0 ? s : 0.f;
}
__device__ __forceinline__ float rope_inv(int i) {
    constexpr float tab[16] = {1.000000000e+00f, 4.403665960e-01f, 1.939227432e-01f, 8.539710194e-02f, 3.760603070e-02f, 1.656043902e-02f, 7.292664610e-03f, 3.211445874e-03f, 1.414213562e-03f, 6.227723788e-04f, 2.742481884e-04f, 1.207697351e-04f, 5.318296098e-05f, 2.341999971e-05f, 1.031338616e-05f, 4.541670478e-06f};
    float v = tab[0];
#pragma unroll
    for (int k = 1; k < 16; ++k) v = (i == k) ? tab[k] : v;
    return v;
}
__device__ __forceinline__ CvItem cv_decode(int it, int L) {
    const size_t wset = (size_t)(L & 1) * WSET;
    constexpr int I_G = (DM / 64) * (DFF / 32);
    constexpr int I_IN = (DM / 64) * (PROJ_COLS / 32);
    constexpr int I_O = (DM / 64) * (DM / 32);
    constexpr int I_C = (4096 / 64) * (256 / 32);
    unsigned char* ws = arg_ws() + wset; CvItem c; int r = it;
    if (r < 6 * I_G) { const int w = r / I_G; r -= w * I_G; const int ffn = w / 3, part = w % 3;
        c.gain = nullptr;
        if (part < 2) { c.src = arg_in((ffn ? 19 : 2) + part) + (size_t)L * DM * DFF; c.dst = (bf16_t*)(ws + (ffn ? WS_WGU2 : WS_WGU)); c.K = DM; c.N = DFF; c.kind = 1 + part; c.gain = arg_in(ffn ? 18 : 1) + L * DM; }
        else { c.src = arg_in(ffn ? 21 : 4) + (size_t)L * DFF * DM; c.dst = (bf16_t*)(ws + (ffn ? WS_WD2 : WS_WD)); c.K = DFF; c.N = DM; c.kind = 0; } }
    else { r -= 6 * I_G; c.gain = nullptr;
        if (r < I_IN) { c.src = arg_in(6) + (size_t)L * DM * PROJ_COLS; c.dst = (bf16_t*)(ws + WS_WIN); c.K = DM; c.N = PROJ_COLS; c.kind = 3; c.gain = arg_in(5) + L * DM; }
        else { r -= I_IN;
            if (r < I_O) { c.src = arg_in(17) + (size_t)L * DM * DM; c.dst = (bf16_t*)(ws + WS_WOUT); c.K = DM; c.N = DM; c.kind = 0; c.gain = (r / (DM / 32)) * 64 < 1024 ? arg_in(12) + L * 1024 : arg_in(16) + L * 1024 - 1024; }
            else { r -= I_O; const int which = r / I_C; r -= which * I_C;
                c.src = arg_in(10) + ((size_t)L * 2 + which) * 4096 * 256; c.dst = (bf16_t*)(ws + WS_WC1); c.K = 4096; c.N = 256; c.kind = which ? 4 : 0; } } }
    const int nblk = c.N / 32, kb = r / nblk, nb = r - kb * nblk; c.k0 = 64 * kb; c.n0 = 32 * nb;
    return c;
}
__device__ __forceinline__ void phase_convert(Frame& F, int L, int gw, int ngw) {
    LAS float* scr = (LAS float*)(F.ldsl + F.wave * 16384);
    constexpr int NITEMS = 6 * 5632 + 5664 + 2048 + 2 * 512;
    int it = gw;
    if (it < NITEMS) {
        CvItem c = cv_decode(it, L); float va[32]; cv_load(c, va, F.lane);
        for (;;) {
            const int nx = it + ngw; const bool has = nx < NITEMS; CvItem cn = c; float vb[32];
            if (has) { cn = cv_decode(nx, L); cv_load(cn, vb, F.lane); }
            cv_store(c, va, scr, F.lane);
            if (!has) break;
            c = cn; it = nx;
#pragma unroll
            for (int i = 0; i < 32; ++i) va[i] = vb[i];
        }
    }
    if (L == 0) {
        float* rc = (float*)(arg_ws() + WS_ROPE); float* rs = rc + T * 16;
        for (int idx = blockIdx.x * 512 + F.tid; idx < T * 16; idx += F.G * 512) { const int t = idx >> 4, i = idx & 15;
            const float ang = (float)t * rope_inv(i); rc[idx] = cosf(ang); rs[idx] = sinf(ang); }
    }
}
__device__ __forceinline__ void phase_prenorm(Frame& F, const float* x, const float* g, bf16_t* o, float* rs) {
    for (int m = F.gw; m < M; m += F.NGW) prenorm_row(x + (size_t)m * DM, g, o + (size_t)m * DM, rs + (size_t)m * 32, F.lane);
}

__device__ __forceinline__ float log_sigmoid_f(float x) { return x >= 0.f ? -log1pf(expf(-x)) : x - log1pf(expf(x)); }
__device__ __forceinline__ void phase_prep(Frame& F, int L) {
    unsigned char* ws = arg_ws();
    bf16_t* HID = (bf16_t*)(ws + WS_HID); float* GF = (float*)(ws + WS_GF);
    const float* rc = (const float*)(ws + WS_ROPE); const float* rs = rc + T * 16; float* LF = (float*)(ws + WS_LF);
    const int lane = F.lane, sub = lane >> 4, l16 = lane & 15;
    {
        bf16_t* CA = (bf16_t*)(ws + WS_CMPA);
        for (int r = F.gw; r < 2 * 4064; r += F.NGW) {
            const int which = r >= 4064 ? 1 : 0, rr = r - which * 4064, h = rr & 1, bc = rr >> 1, b = bc / NCMP, c = bc - b * NCMP;
            const bf16_t* src = HID + ((size_t)b * T + 16 * c) * LDP + C_KV + which * 256 + h * 128 + l16 * 8;
            const float* pe = arg_in(9) + ((size_t)(L * 2 + which) * 32) * 128 + l16 * 8;
            bf16_t* dst = CA + ((size_t)which * 4096 + rr) * 4096 + l16 * 8;
#pragma unroll
            for (int it = 0; it < 8; ++it) { const int l = 4 * it + sub;
                const u32x4 w = *(const u32x4*)(src + (size_t)l * LDP); const f32x4 p0 = *(const f32x4*)(pe + l * 128), p1 = *(const f32x4*)(pe + l * 128 + 4);
                u32x4 o; o.x = cvtpk(bf_lo(w.x) + p0.x, bf_hi(w.x) + p0.y); o.y = cvtpk(bf_lo(w.y) + p0.z, bf_hi(w.y) + p0.w);
                o.z = cvtpk(bf_lo(w.z) + p1.x, bf_hi(w.z) + p1.y); o.w = cvtpk(bf_lo(w.w) + p1.z, bf_hi(w.w) + p1.w);
                *(u32x4*)(dst + l * 128) = o; }
        }
    }
    const float* gk1 = arg_in(8) + (L * 3 + 1) * 128; const float* gk2 = arg_in(8) + (L * 3 + 2) * 128; const float* gfk = arg_in(14) + L * 128;
    int col[3]; const float* gp[3];
    col[0] = C_KV + (sub < 2 ? 512 + sub * 128 : 1024 + (sub - 2) * 128) + l16 * 8; gp[0] = sub < 2 ? gk1 : gk2;
    col[1] = C_FK + sub * 128 + l16 * 8; gp[1] = gfk; col[2] = C_FK + (4 + sub) * 128 + l16 * 8; gp[2] = gfk;
    const float fbias = (lane >= 24 && lane < 32) ? arg_in(15)[L * 8 + lane - 24] : 0.f;
    u32x4 wa[3], wb[3]; float gfa = 0.f, gfb = 0.f;
    int m = F.gw;
    if (m < M) {
#pragma unroll
        for (int it = 0; it < 3; ++it) wa[it] = *(const u32x4*)(HID + (size_t)m * LDP + col[it]);
        if (lane < 32) gfa = GF[(size_t)m * 32 + lane];
    }
    if (m + F.NGW < M) {
#pragma unroll
        for (int it = 0; it < 3; ++it) wb[it] = *(const u32x4*)(HID + (size_t)(m + F.NGW) * LDP + col[it]);
        if (lane < 32) gfb = GF[(size_t)(m + F.NGW) * 32 + lane];
    }
    while (m < M) {
        const int mn = m + F.NGW, mn2 = mn + F.NGW; u32x4 wc[3]; float gfc = 0.f;
        if (mn2 < M) {
#pragma unroll
            for (int it = 0; it < 3; ++it) wc[it] = *(const u32x4*)(HID + (size_t)mn2 * LDP + col[it]);
            if (lane < 32) gfc = GF[(size_t)mn2 * 32 + lane];
        }
        __builtin_amdgcn_sched_barrier(0);
        const int t = m & (T - 1);
        bf16_t* prow = HID + (size_t)m * LDP;
#pragma unroll
        for (int it = 0; it < 3; ++it) {
            const u32x4 w = wa[it];
            float x[8] = {bf_lo(w.x), bf_hi(w.x), bf_lo(w.y), bf_hi(w.y), bf_lo(w.z), bf_hi(w.z), bf_lo(w.w), bf_hi(w.w)};
            float ss = 0.f;
#pragma unroll
            for (int e = 0; e < 8; ++e) ss += x[e] * x[e];
            ss += __shfl_xor(ss, 1); ss += __shfl_xor(ss, 2); ss += __shfl_xor(ss, 4); ss += __shfl_xor(ss, 8);
            const float r = 1.0f / sqrtf(ss * (1.0f / 128.f) + EPS);
            const f32x4 g0 = *(const f32x4*)(gp[it] + l16 * 8), g1 = *(const f32x4*)(gp[it] + l16 * 8 + 4);
            x[0] *= r * g0.x; x[1] *= r * g0.y; x[2] *= r * g0.z; x[3] *= r * g0.w; x[4] *= r * g1.x; x[5] *= r * g1.y; x[6] *= r * g1.z; x[7] *= r * g1.w;
            if (it == 0) {
                const int fi = (l16 & 1) * 8;
                const f32x4 c0 = *(const f32x4*)(rc + t * 16 + fi), c1 = *(const f32x4*)(rc + t * 16 + fi + 4);
                const f32x4 s0 = *(const f32x4*)(rs + t * 16 + fi), s1 = *(const f32x4*)(rs + t * 16 + fi + 4);
                const float cc[8] = {c0.x, c0.y, c0.z, c0.w, c1.x, c1.y, c1.z, c1.w}, sn[8] = {s0.x, s0.y, s0.z, s0.w, s1.x, s1.y, s1.z, s1.w};
#pragma unroll
                for (int e = 0; e < 8; ++e) { const float other = __shfl_xor(x[e], 2);
                    const float ro = (l16 & 2) ? (x[e] * cc[e] + other * sn[e]) : (x[e] * cc[e] - other * sn[e]);
                    if (l16 < 4) x[e] = ro; }
            }
            u32x4 o; o.x = cvtpk(x[0], x[1]); o.y = cvtpk(x[2], x[3]); o.z = cvtpk(x[4], x[5]); o.w = cvtpk(x[6], x[7]);
            *(u32x4*)(prow + col[it]) = o;
        }
        if (lane < 24) GF[(size_t)m * 32 + lane] = 1.0f / (1.0f + expf(-gfa));
        else if (lane < 32) LF[((size_t)(m >> 11) * 8 + (lane - 24)) * T + t] = log_sigmoid_f(gfa + fbias);
#pragma unroll
        for (int it = 0; it < 3; ++it) { wa[it] = wb[it]; wb[it] = wc[it]; }
        gfa = gfb; gfb = gfc; m = mn;
    }
}

__device__ __forceinline__ void phase_scan(Frame& F) {
    if (blockIdx.x < 32) return;
    const int sw = ((int)blockIdx.x - 32) * 8 + F.wave; if (sw >= NB * 8) return;
    const int lane = F.lane;
    const f32x4* src = (const f32x4*)((const float*)(arg_ws() + WS_LF) + (size_t)sw * T + lane * 32);
    f32x4 v[8]; float s = 0.f;
#pragma unroll
    for (int i = 0; i < 8; ++i) { v[i] = src[i]; s += (v[i].x + v[i].y) + (v[i].z + v[i].w); }
    float inc = s;
#pragma unroll
    for (int o = 1; o < 64; o <<= 1) { const float tt = __shfl_up(inc, o); if (lane >= o) inc += tt; }
    float run = inc - s;
    f32x4* dst = (f32x4*)((float*)(arg_ws() + WS_CUM) + (size_t)sw * T + lane * 32);
#pragma unroll
    for (int i = 0; i < 8; ++i) { f32x4 o; run += v[i].x; o.x = run; run += v[i].y; o.y = run; run += v[i].z; o.z = run; run += v[i].w; o.w = run; dst[i] = o; }
}

__device__ __forceinline__ void phase_cmp2(Frame& F, int L) {
    unsigned char* ws = arg_ws(); const int lane = F.lane;
    const bf16_t* CH = (const bf16_t*)(ws + WS_CMPH);
    const float* rc = (const float*)(ws + WS_ROPE); const float* rs = rc + T * 16;
    const float* gk0 = arg_in(8) + (L * 3 + 0) * 128;
    for (int it = F.gw; it < 2032 + 64; it += F.NGW) {
        if (it >= 2032) {
            const int z = it - 2032, which = z >> 5, bh = z & 31;
            bf16_t* dst = (bf16_t*)(ws + (which ? WS_VC : WS_KC)) + ((size_t)bh * 128 + 127) * 128;
            *(unsigned*)(dst + 2 * lane) = 0u; continue;
        }
        const int r0 = it * 4, which = r0 >= 4064 ? 1 : 0;
        const float* w2 = arg_in(11) + (size_t)(L * 2 + which) * 256 * 128;
        LAS float* hs = (LAS float*)(F.ldsl + F.wave * 16384);
#pragma unroll
        for (int q = 0; q < 4; ++q) { const int rr = r0 - which * 4064 + q; const u32x2 w = *(const u32x2*)(CH + ((size_t)which * 4096 + rr) * 256 + 4 * lane);
            *(LAS f32x4*)(hs + q * 256 + 4 * lane) = (f32x4){bf_lo(w.x), bf_hi(w.x), bf_lo(w.y), bf_hi(w.y)}; }
        asm volatile("s_waitcnt lgkmcnt(0)" ::: "memory");
        float a[4][2] = {};
#pragma unroll 8
        for (int kk = 0; kk < 64; ++kk) {
            f32x4 hq[4];
#pragma unroll
            for (int q = 0; q < 4; ++q) hq[q] = *(const LAS f32x4*)(hs + q * 256 + 4 * kk);
#pragma unroll
            for (int j = 0; j < 4; ++j) { const f32x2 wv = *(const f32x2*)(w2 + (size_t)(kk * 4 + j) * 128 + 2 * lane);
#pragma unroll
                for (int q = 0; q < 4; ++q) { a[q][0] += hq[q][j] * wv.x; a[q][1] += hq[q][j] * wv.y; } }
        }
        asm volatile("s_waitcnt lgkmcnt(0)" ::: "memory");
#pragma unroll
        for (int q = 0; q < 4; ++q) { const int rr = r0 - which * 4064 + q, h = rr & 1, bc = rr >> 1, b = bc / NCMP, c = bc - b * NCMP;
            float y0 = a[q][0], y1 = a[q][1];
            if (which == 0) {
                const float ss = wave_sum(y0 * y0 + y1 * y1); const float r = 1.0f / sqrtf(ss * (1.0f / 128.f) + EPS);
                const f32x2 g = *(const f32x2*)(gk0 + 2 * lane); y0 *= r * g.x; y1 *= r * g.y;
                const int pos = 16 * c + 31; const int fi = 2 * (lane & 7);
                const f32x2 cc = *(const f32x2*)(rc + pos * 16 + fi), sn = *(const f32x2*)(rs + pos * 16 + fi);
                const float o0 = __shfl_xor(y0, 8), o1 = __shfl_xor(y1, 8);
                if (lane < 8) { y0 = y0 * cc.x - o0 * sn.x; y1 = y1 * cc.y - o1 * sn.y; }
                else if (lane < 16) { y0 = y0 * cc.x + o0 * sn.x; y1 = y1 * cc.y + o1 * sn.y; }
            }
            bf16_t* dst = (bf16_t*)(ws + (which ? WS_VC : WS_KC)) + ((size_t)(b * 2 + h) * 128 + c) * 128;
            *(unsigned*)(dst + 2 * lane) = cvtpk(y0, y1);
        }
    }
}

__device__ __forceinline__ void unpack8(const u32x4 w, float* x) { x[0] = bf_lo(w.x); x[1] = bf_hi(w.x); x[2] = bf_lo(w.y); x[3] = bf_hi(w.y); x[4] = bf_lo(w.z); x[5] = bf_hi(w.z); x[6] = bf_lo(w.w); x[7] = bf_hi(w.w); }
__device__ __forceinline__ void phase_outnorm(Frame& F, int L) {
    (void)L;
    unsigned char* ws = arg_ws();
    bf16_t* HN = (bf16_t*)(ws + WS_HN); const int lane = F.lane;
    const bf16_t* N0 = (const bf16_t*)(ws + WS_NSA0); const bf16_t* N1 = (const bf16_t*)(ws + WS_NSA1); const bf16_t* N2 = (const bf16_t*)(ws + WS_NSA2);
    u32x4 wa[8];
    int m = F.gw;
#define ONORM_LOAD(w, mm) do { const size_t off_ = (size_t)(mm) * 1024 + (size_t)lane * 8; \
        w[0] = *(const u32x4*)(N0 + off_); w[1] = *(const u32x4*)(N1 + off_); w[2] = *(const u32x4*)(N2 + off_); \
        w[3] = *(const u32x4*)(N0 + off_ + 512); w[4] = *(const u32x4*)(N1 + off_ + 512); w[5] = *(const u32x4*)(N2 + off_ + 512); \
        w[6] = ((const u32x4*)(HN + (size_t)(mm) * DM))[lane + 128]; w[7] = ((const u32x4*)(HN + (size_t)(mm) * DM))[lane + 192]; } while (0)
    if (m < M) ONORM_LOAD(wa, m);
    while (m < M) {
        const int mn = m + F.NGW; u32x4 wb[8];
        if (mn < M) ONORM_LOAD(wb, mn);
        __builtin_amdgcn_sched_barrier(0);
        float x[4][8]; float sa = 0.f, sb = 0.f;
#pragma unroll
        for (int j = 0; j < 4; ++j) {
            if (j < 2) { float y0[8], y1[8], y2[8]; unpack8(wa[3 * j], y0); unpack8(wa[3 * j + 1], y1); unpack8(wa[3 * j + 2], y2);
#pragma unroll
                for (int e = 0; e < 8; ++e) x[j][e] = y0[e] + y1[e] + y2[e]; }
            else unpack8(wa[4 + j], x[j]);
            float s = 0.f;
#pragma unroll
            for (int e = 0; e < 8; ++e) s += x[j][e] * x[j][e];
            if (j < 2) sa += s; else sb += s; }
        const float ra = 1.0f / sqrtf(wave_sum(sa) * (1.0f / 1024.f) + EPS), rb = 1.0f / sqrtf(wave_sum(sb) * (1.0f / 1024.f) + EPS);
        u32x4* row = (u32x4*)(HN + (size_t)m * DM) + lane;
#pragma unroll
        for (int j = 0; j < 4; ++j) { const float r = j < 2 ? ra : rb;
            u32x4 o; o.x = cvtpk(x[j][0] * r, x[j][1] * r); o.y = cvtpk(x[j][2] * r, x[j][3] * r); o.z = cvtpk(x[j][4] * r, x[j][5] * r); o.w = cvtpk(x[j][6] * r, x[j][7] * r);
            row[64 * j] = o; }
#pragma unroll
        for (int i = 0; i < 8; ++i) wa[i] = wb[i];
        m = mn;
    }
#undef ONORM_LOAD
}

namespace att {
constexpr int SHM_V = 16384, SHM_K = 16384;
constexpr int OFF_V = 0, OFF_K = 3 * SHM_V, OFF_WS = 81920, OFF_BIAS = OFF_WS + 2048, OFF_PG = 86016, OFF_SC = OFF_PG + 32768, OFF_SEL = OFF_SC + 8192, OFF_UNI = OFF_SEL + 256;
static_assert(OFF_UNI + 16 <= 131072, "attention LDS map");
typedef LAS char* lptr;
#define KSWZ(row, colB) ((row) * 256 + ((colB) ^ (((row) & 7) << 4)))
__device__ __forceinline__ int v_st(int k, int c) { const int kk = (k & ~0xC) | ((k & 4) << 1) | ((k & 8) >> 1); return ((kk >> 3) * 4 + (c >> 5)) * 512 + ((kk & 7) * 32 + (c & 31)) * 2; }
__device__ __forceinline__ int v_rd_base(int lane) { return ((lane & 3) << 3) | (((lane >> 2) & 3) << 6) | (((lane >> 4) & 1) << 5) | (((lane >> 5) & 1) << 8); }
constexpr int v_rd_off(int d0, int ks, int half) { return d0 * 512 + ks * 4096 + half * 2048; }
__device__ __forceinline__ int crow(int r, int hi) { return (r & 3) + 8 * (r >> 2) + 4 * hi; }

__device__ __forceinline__ void qkt(f32x16& p0, f32x16& p1, lptr lds, int kbuf, int r32, int hi, const bf16x8* qr) {
    p0 = f32x16{}; p1 = f32x16{};
    lptr kb[4];
#pragma unroll
    for (int dd = 0; dd < 4; ++dd) kb[dd] = lds + OFF_K + kbuf * SHM_K + KSWZ(r32, (dd * 16 + hi * 8) * 2);
    bf16x8 ka[3], kc[3];
    ka[0] = *reinterpret_cast<const LAS bf16x8*>(kb[0]); kc[0] = *reinterpret_cast<const LAS bf16x8*>(kb[0] + 32 * 256);
    ka[1] = *reinterpret_cast<const LAS bf16x8*>(kb[1]); kc[1] = *reinterpret_cast<const LAS bf16x8*>(kb[1] + 32 * 256);
#pragma unroll
    for (int d0 = 0; d0 < 8; ++d0) {
        if (d0 + 2 < 8) { lptr a = kb[(d0 + 2) & 3] + ((d0 + 2) >> 2) * 128; ka[(d0 + 2) % 3] = *reinterpret_cast<const LAS bf16x8*>(a); kc[(d0 + 2) % 3] = *reinterpret_cast<const LAS bf16x8*>(a + 32 * 256); }
        p0 = __builtin_amdgcn_mfma_f32_32x32x16_bf16(ka[d0 % 3], qr[d0], p0, 0, 0, 0);
        p1 = __builtin_amdgcn_mfma_f32_32x32x16_bf16(kc[d0 % 3], qr[d0], p1, 0, 0, 0); }
}
template <int VB>
__device__ __forceinline__ void pv_tile(f32x16* o, int vb0, bf16x8 pa0, bf16x8 pa1, bf16x8 pa2, bf16x8 pa3) {
#define TRRD(dst, off) asm volatile("ds_read_b64_tr_b16 %0, %1 offset:%2" : "=&v"(dst) : "v"(vb0), "i"(off) : "memory")
#define PV_D0(d0) do { s16x4 l0, l1, l2, l3, h0, h1, h2, h3; constexpr int b_ = VB * SHM_V + v_rd_off(d0, 0, 0); \
        TRRD(l0, b_); TRRD(h0, b_ + 2048); TRRD(l1, b_ + 4096); TRRD(h1, b_ + 6144); TRRD(l2, b_ + 8192); TRRD(h2, b_ + 10240); TRRD(l3, b_ + 12288); TRRD(h3, b_ + 14336); \
        asm volatile("s_waitcnt lgkmcnt(0)" ::: "memory"); SBAR(); \
        o[d0] = __builtin_amdgcn_mfma_f32_32x32x16_bf16(pa0, (bf16x8){l0[0], l0[1], l0[2], l0[3], h0[0], h0[1], h0[2], h0[3]}, o[d0], 0, 0, 0);   \
        o[d0] = __builtin_amdgcn_mfma_f32_32x32x16_bf16(pa1, (bf16x8){l1[0], l1[1], l1[2], l1[3], h1[0], h1[1], h1[2], h1[3]}, o[d0], 0, 0, 0);   \
        o[d0] = __builtin_amdgcn_mfma_f32_32x32x16_bf16(pa2, (bf16x8){l2[0], l2[1], l2[2], l2[3], h2[0], h2[1], h2[2], h2[3]}, o[d0], 0, 0, 0);   \
        o[d0] = __builtin_amdgcn_mfma_f32_32x32x16_bf16(pa3, (bf16x8){l3[0], l3[1], l3[2], l3[3], h3[0], h3[1], h3[2], h3[3]}, o[d0], 0, 0, 0); } while (0)
    PV_D0(0); PV_D0(1); PV_D0(2); PV_D0(3);
#undef PV_D0
#undef TRRD
}
__device__ __forceinline__ float xhalf_max(float x) { auto rr = __builtin_amdgcn_permlane32_swap(__float_as_uint(x), __float_as_uint(x), false, false); return fmaxf(__uint_as_float(rr[0]), __uint_as_float(rr[1])); }
__device__ __forceinline__ float xhalf_sum(float x) { auto rr = __builtin_amdgcn_permlane32_swap(__float_as_uint(x), __float_as_uint(x), false, false); return __uint_as_float(rr[0]) + __uint_as_float(rr[1]); }
#define PK4(P, B_, OUT) do { unsigned xa0_ = cvtpk(P[B_+0], P[B_+1]), xa1_ = cvtpk(P[B_+2], P[B_+3]);                          \
        unsigned xb0_ = cvtpk(P[B_+4], P[B_+5]), xb1_ = cvtpk(P[B_+6], P[B_+7]);                                             \
        auto xr0_ = __builtin_amdgcn_permlane32_swap(xa0_, xb0_, false, false); auto xr1_ = __builtin_amdgcn_permlane32_swap(xa1_, xb1_, false, false); \
        u32x4 xw_ = {xr0_[0], xr1_[0], xr0_[1], xr1_[1]}; OUT = *reinterpret_cast<bf16x8*>(&xw_); } while (0)
__device__ __forceinline__ void scale_rows(f32x16* o, LAS float* tab, float v, int r32, int hi) {
    if (hi == 0) tab[r32] = v;
    asm volatile("s_waitcnt lgkmcnt(0)" ::: "memory");
#pragma unroll
    for (int g4 = 0; g4 < 4; ++g4) { const f32x4 f = *(const LAS f32x4*)(tab + 8 * g4 + 4 * hi);
#pragma unroll
        for (int e = 0; e < 4; ++e)
#pragma unroll
            for (int d = 0; d < 4; ++d) o[d][4 * g4 + e] *= f[e]; }
    asm volatile("s_waitcnt lgkmcnt(0)" ::: "memory");
}
__device__ __forceinline__ void softmax_pv(f32x16& p0, f32x16& p1, f32x16* o, float& m, float& l, int vb0, LAS float* tab, int r32, int hi) {
    float pmax = p0[0];
#pragma unroll
    for (int r = 1; r < 16; ++r) pmax = fmaxf(pmax, p0[r]);
#pragma unroll
    for (int r = 0; r < 16; ++r) pmax = fmaxf(pmax, p1[r]);
    pmax = xhalf_max(pmax);
    const float mn = fmaxf(m, pmax);
    if (__any(mn > m)) {
        const float alpha = __builtin_amdgcn_exp2f(m - mn);
        l *= alpha; m = mn;
        scale_rows(o, tab, alpha, r32, hi);
    }
    float ps = 0.f;
#pragma unroll
    for (int r = 0; r < 16; ++r) { p0[r] = __builtin_amdgcn_exp2f(p0[r] - m); ps += p0[r]; }
#pragma unroll
    for (int r = 0; r < 16; ++r) { p1[r] = __builtin_amdgcn_exp2f(p1[r] - m); ps += p1[r]; }
    l += xhalf_sum(ps);
    bf16x8 pa0, pa1, pa2, pa3;
    PK4(p0, 0, pa0); PK4(p0, 8, pa1); PK4(p1, 0, pa2); PK4(p1, 8, pa3);
    SBAR();
    pv_tile<0>(o, vb0, pa0, pa1, pa2, pa3);
}
__device__ __forceinline__ void expsum_pv(f32x16& p0, f32x16& p1, f32x16* o, float& lp, int vb0) {
    float ps = 0.f;
#pragma unroll
    for (int r = 0; r < 16; ++r) { p0[r] = __builtin_amdgcn_exp2f(p0[r]); ps += p0[r]; }
#pragma unroll
    for (int r = 0; r < 16; ++r) { p1[r] = __builtin_amdgcn_exp2f(p1[r]); ps += p1[r]; }
    lp += ps;
    bf16x8 pa0, pa1, pa2, pa3;
    PK4(p0, 0, pa0); PK4(p0, 8, pa1); PK4(p1, 0, pa2); PK4(p1, 8, pa3);
    SBAR();
    pv_tile<0>(o, vb0, pa0, pa1, pa2, pa3);
}
__device__ __forceinline__ float qrow_norm(const bf16x8* qr) {
    float ss = 0.f;
#pragma unroll
    for (int d0 = 0; d0 < 8; ++d0) { const u32x4 w = *reinterpret_cast<const u32x4*>(&qr[d0]);
        ss += (bf_lo(w.x) * bf_lo(w.x) + bf_hi(w.x) * bf_hi(w.x)) + (bf_lo(w.y) * bf_lo(w.y) + bf_hi(w.y) * bf_hi(w.y)) + (bf_lo(w.z) * bf_lo(w.z) + bf_hi(w.z) * bf_hi(w.z)) + (bf_lo(w.w) * bf_lo(w.w) + bf_hi(w.w) * bf_hi(w.w)); }
    return sqrtf(xhalf_sum(ss));
}
template <bool ROPE>
__device__ __forceinline__ void load_q_norm(bf16x8* qr, const bf16_t* qp, const float* g, int hi, int t, const float* rc, const float* rs) {
    float x[8][8]; float ss = 0.f;
#pragma unroll
    for (int d0 = 0; d0 < 8; ++d0) { const u32x4 w = *(const u32x4*)(qp + d0 * 16);
        x[d0][0] = bf_lo(w.x); x[d0][1] = bf_hi(w.x); x[d0][2] = bf_lo(w.y); x[d0][3] = bf_hi(w.y); x[d0][4] = bf_lo(w.z); x[d0][5] = bf_hi(w.z); x[d0][6] = bf_lo(w.w); x[d0][7] = bf_hi(w.w);
#pragma unroll
        for (int j = 0; j < 8; ++j) ss += x[d0][j] * x[d0][j]; }
    ss = xhalf_sum(ss);
    const float r = 1.0f / sqrtf(ss * (1.0f / 128.f) + EPS);
#pragma unroll
    for (int d0 = 0; d0 < 8; ++d0) { const f32x4 ga = *(const f32x4*)(g + d0 * 16 + hi * 8), gb = *(const f32x4*)(g + d0 * 16 + hi * 8 + 4);
        x[d0][0] *= r * ga.x; x[d0][1] *= r * ga.y; x[d0][2] *= r * ga.z; x[d0][3] *= r * ga.w; x[d0][4] *= r * gb.x; x[d0][5] *= r * gb.y; x[d0][6] *= r * gb.z; x[d0][7] *= r * gb.w; }
    if (ROPE) {
        const f32x4 c0 = *(const f32x4*)(rc + t * 16 + hi * 8), c1 = *(const f32x4*)(rc + t * 16 + hi * 8 + 4), s0 = *(const f32x4*)(rs + t * 16 + hi * 8), s1 = *(const f32x4*)(rs + t * 16 + hi * 8 + 4);
        const float cc[8] = {c0.x, c0.y, c0.z, c0.w, c1.x, c1.y, c1.z, c1.w}, sn[8] = {s0.x, s0.y, s0.z, s0.w, s1.x, s1.y, s1.z, s1.w};
#pragma unroll
        for (int j = 0; j < 8; ++j) { const float x1 = x[0][j], x2 = x[1][j]; x[0][j] = x1 * cc[j] - x2 * sn[j]; x[1][j] = x2 * cc[j] + x1 * sn[j]; }
    }
#pragma unroll
    for (int d0 = 0; d0 < 8; ++d0) { u32x4 w; w.x = cvtpk(x[d0][0], x[d0][1]); w.y = cvtpk(x[d0][2], x[d0][3]); w.z = cvtpk(x[d0][4], x[d0][5]); w.w = cvtpk(x[d0][6], x[d0][7]);
        qr[d0] = *reinterpret_cast<bf16x8*>(&w); }
}
struct Stg { bf16x8 k0, k1, v0, v1; };
__device__ __forceinline__ void stg_load(Stg& s, const bf16_t* Kp, const bf16_t* Vp, size_t stride, int sr, int sc) {
    s.k0 = *(const bf16x8*)(Kp + (size_t)sr * stride + sc); s.k1 = *(const bf16x8*)(Kp + (size_t)(32 + sr) * stride + sc);
    s.v0 = *(const bf16x8*)(Vp + (size_t)sr * stride + sc); s.v1 = *(const bf16x8*)(Vp + (size_t)(32 + sr) * stride + sc);
}
__device__ __forceinline__ void stg_write(const Stg& s, lptr lds, int kbuf, int vbuf, int kws, int vst0, int vst1) {
    *(LAS bf16x8*)(lds + OFF_K + kbuf * SHM_K + kws) = s.k0; *(LAS bf16x8*)(lds + OFF_K + kbuf * SHM_K + kws + 32 * 256) = s.k1;
    *(LAS bf16x8*)(lds + OFF_V + vbuf * SHM_V + vst0) = s.v0; *(LAS bf16x8*)(lds + OFF_V + vbuf * SHM_V + vst1) = s.v1;
}
struct Dma { int k[2], v[2]; };
__device__ __forceinline__ Dma dma_offs(int wid, int lane, int stride) {
    Dma d;
#pragma unroll
    for (int i = 0; i < 2; ++i) { const int q = wid + 8 * i;
        { const int r = 4 * q + (lane >> 4), p = lane & 15; d.k[i] = r * stride + ((p ^ (r & 7)) << 3); }
        { const int st = 2 * q + (lane >> 5), kk = (st >> 2) * 8 + ((lane & 31) >> 2), c = (st & 3) * 32 + (lane & 3) * 8;
          const int k = (kk & ~0xC) | ((kk & 4) << 1) | ((kk & 8) >> 1); d.v[i] = k * stride + c; } }
    return d;
}
__device__ __forceinline__ void dma_tile2(const Dma& d, const bf16_t* Kp, const bf16_t* Vp, lptr lds, int kbuf, int vbuf, int wid) {
#pragma unroll
    for (int i = 0; i < 2; ++i) {
        __builtin_amdgcn_global_load_lds((const unsigned*)(Kp + d.k[i]), (LAS unsigned*)(lds + OFF_K + kbuf * SHM_K + (wid + 8 * i) * 1024), 16, 0, 0);
        __builtin_amdgcn_global_load_lds((const unsigned*)(Vp + d.v[i]), (LAS unsigned*)(lds + OFF_V + vbuf * SHM_V + (wid + 8 * i) * 1024), 16, 0, 0); }
}
__device__ __forceinline__ void dma_tile(const Dma& d, const bf16_t* Kp, const bf16_t* Vp, lptr lds, int buf, int wid) {
#pragma unroll
    for (int i = 0; i < 2; ++i) {
        __builtin_amdgcn_global_load_lds((const unsigned*)(Kp + d.k[i]), (LAS unsigned*)(lds + OFF_K + buf * SHM_K + (wid + 8 * i) * 1024), 16, 0, 0);
        __builtin_amdgcn_global_load_lds((const unsigned*)(Vp + d.v[i]), (LAS unsigned*)(lds + OFF_V + buf * SHM_V + (wid + 8 * i) * 1024), 16, 0, 0); }
}
#define DMA_WAIT() asm volatile("s_waitcnt vmcnt(0)" ::: "memory")
#define O_STORE(o, ftab, ROWPTR) do { _Pragma("unroll") for (int r = 0; r < 16; ++r) { const int rr_ = crow(r, hi); bf16_t* rp_ = ROWPTR(rr_); const float f_ = (ftab)[rr_]; \
        _Pragma("unroll") for (int d0 = 0; d0 < 4; ++d0) { const float v_ = o[d0][r] * f_; const float vn_ = __shfl_xor(v_, 1); \
            if ((r32 & 1) == 0) *(unsigned*)(rp_ + d0 * 32 + r32) = cvtpk(v_, vn_); } } } while (0)
struct Lanes { int tid, wid, lane, r32, hi, sr, sc, kws, vst0, vst1, vb0; };
__device__ __forceinline__ Lanes mk_lanes(const Frame& F) {
    Lanes a; a.tid = F.tid; a.wid = F.wave; a.lane = F.lane; a.r32 = a.lane & 31; a.hi = a.lane >> 5;
    a.sr = a.tid >> 4; a.sc = (a.tid & 15) * 8; a.kws = KSWZ(a.sr, a.sc * 2); a.vst0 = v_st(a.sr, a.sc); a.vst1 = v_st(32 + a.sr, a.sc);
    a.vb0 = OFF_V + v_rd_base(a.lane); return a;
}
}

__device__ __forceinline__ void fox_block(Frame& F, int L, int b, int h, int qb) {
    using namespace att;
    RELAUNDER();
    lptr lds = (lptr)F.ldsl; unsigned char* ws = arg_ws();
    const bf16_t* HID = (const bf16_t*)(ws + WS_HID); bf16_t* HN = (bf16_t*)(ws + WS_HN);
    const Lanes A = mk_lanes(F); const int tid = A.tid, wid = A.wid, r32 = A.r32, hi = A.hi;
    LAS float* tab = (LAS float*)(lds + OFF_WS) + wid * 64; LAS float* biasL = (LAS float*)(lds + OFF_BIAS);
    const int tok0 = qb * 256 + wid * 32, t = tok0 + r32;
    const float* cum = (const float*)(ws + WS_CUM) + (size_t)(b * 8 + h) * T;
    bf16x8 qr[8];
    const bf16_t* Kb = HID + (size_t)b * T * LDP + C_FK + h * 128; const bf16_t* Vb = HID + (size_t)b * T * LDP + C_FV + h * 128;
    const int ntiles = 4 * qb + 4;
    f32x16 o[4] = {}; float l = 0.f;
    const Dma D = dma_offs(wid, A.lane, LDP);
    const float NEG = -__builtin_inff();
#define FOX_TRANSFORM(P0, P1, J, SLOT) do { const LAS float* bl_ = biasL + (SLOT) * 64; \
        _Pragma("unroll") for (int g4 = 0; g4 < 4; ++g4) { const f32x4 ba = *(const LAS f32x4*)(bl_ + 8 * g4 + 4 * hi), bb = *(const LAS f32x4*)(bl_ + 32 + 8 * g4 + 4 * hi); \
            _Pragma("unroll") for (int e = 0; e < 4; ++e) { P0[4 * g4 + e] = fmaf(P0[4 * g4 + e], C2, ct2 + ba[e]); P1[4 * g4 + e] = fmaf(P1[4 * g4 + e], C2, ct2 + bb[e]); } } \
        if (64 * (J) + 63 > tok0) { const int dq_ = t - 64 * (J) - 4 * hi; \
            _Pragma("unroll") for (int r = 0; r < 16; ++r) { const int c = (r & 3) + 8 * (r >> 2); if (c > dq_) P0[r] = NEG; if (c + 32 > dq_) P1[r] = NEG; } } } while (0)
    float cb0 = 0.f, cb1 = 0.f;
    if (tid < 64) { cb0 = cum[tid]; cb1 = cum[64 + tid]; }
    __syncthreads();
    dma_tile2(D, Kb, Vb, lds, 0, 0, wid);
    dma_tile2(D, Kb + (size_t)64 * LDP, Vb + (size_t)64 * LDP, lds, 1, 1, wid);
    load_q_norm<false>(qr, HID + ((size_t)b * T + t) * LDP + C_FQ + h * 128 + hi * 8, arg_in(13) + L * 128, hi, t, nullptr, nullptr);
    const float ct2 = cum[t] * LOG2E - C2 * 12.0f * qrow_norm(qr);
    if (tid < 64) { biasL[tid] = -cb0 * LOG2E; biasL[64 + tid] = -cb1 * LOG2E; }
    asm volatile("s_waitcnt vmcnt(4)" ::: "memory"); __syncthreads();
    f32x16 pA0, pA1;
    { qkt(pA0, pA1, lds, 0, r32, hi, qr); FOX_TRANSFORM(pA0, pA1, 0, 0);
      DMA_WAIT(); __syncthreads(); }
    int vs = 1;
    for (int j = 1; j < ntiles; ++j) {
        const int vn = vs == 2 ? 0 : vs + 1, vp = vs == 0 ? 2 : vs - 1;
        if (j + 1 < ntiles) { dma_tile2(D, Kb + (size_t)(64 * (j + 1)) * LDP, Vb + (size_t)(64 * (j + 1)) * LDP, lds, (j + 1) & 1, vn, wid); if (tid < 64) biasL[vn * 64 + tid] = -cum[64 * (j + 1) + tid] * LOG2E; }
        f32x16 pB0, pB1;
        qkt(pB0, pB1, lds, j & 1, r32, hi, qr);
        float ps = 0.f;
#pragma unroll
        for (int r = 0; r < 16; ++r) { pA0[r] = __builtin_amdgcn_exp2f(pA0[r]); ps += pA0[r]; }
#pragma unroll
        for (int r = 0; r < 16; ++r) { pA1[r] = __builtin_amdgcn_exp2f(pA1[r]); ps += pA1[r]; }
        l += ps;
        bf16x8 pa0, pa1, pa2, pa3;
        PK4(pA0, 0, pa0); PK4(pA0, 8, pa1); PK4(pA1, 0, pa2); PK4(pA1, 8, pa3);
        pv_tile<0>(o, A.vb0 + vp * SHM_V, pa0, pa1, pa2, pa3);
        FOX_TRANSFORM(pB0, pB1, j, vs);
        pA0 = pB0; pA1 = pB1;
        DMA_WAIT(); __syncthreads();
        vs = vn;
    }
    {
        const int vp = vs == 0 ? 2 : vs - 1;
        float ps = 0.f;
#pragma unroll
        for (int r = 0; r < 16; ++r) { pA0[r] = __builtin_amdgcn_exp2f(pA0[r]); ps += pA0[r]; }
#pragma unroll
        for (int r = 0; r < 16; ++r) { pA1[r] = __builtin_amdgcn_exp2f(pA1[r]); ps += pA1[r]; }
        l += ps;
        bf16x8 pa0, pa1, pa2, pa3;
        PK4(pA0, 0, pa0); PK4(pA0, 8, pa1); PK4(pA1, 0, pa2); PK4(pA1, 8, pa3);
        SBAR();
        pv_tile<0>(o, A.vb0 + vp * SHM_V, pa0, pa1, pa2, pa3);
    }
#undef FOX_TRANSFORM
    l = xhalf_sum(l);
    if (hi == 0) tab[32 + r32] = 1.0f / l;
    asm volatile("s_waitcnt lgkmcnt(0)" ::: "memory");
    bf16_t* Ob = HN + ((size_t)b * T + tok0) * DM + 1024 + h * 128;
#define FOX_ROWPTR(rr) (Ob + (size_t)(rr) * DM)
    O_STORE(o, tab + 32, FOX_ROWPTR);
#undef FOX_ROWPTR
    asm volatile("s_waitcnt lgkmcnt(0)" ::: "memory");
}

#define NSA_ROWPTR(rr) (Ob + (size_t)((rr) >> 2) * 1024 + ((rr) & 3) * 128)
__device__ __forceinline__ void nsa_cmp_select(Frame& F, int L, int b, int kvh, int jq, const bf16x8* qr) {
    using namespace att;
    (void)L; RELAUNDER();
    lptr lds = (lptr)F.ldsl; unsigned char* ws = arg_ws();
    const bf16_t* HID = (const bf16_t*)(ws + WS_HID); const float* GF = (const float*)(ws + WS_GF);
    const Lanes A = mk_lanes(F); const int tid = A.tid, wid = A.wid, lane = A.lane, r32 = A.r32, hi = A.hi;
    LAS float* tab = (LAS float*)(lds + OFF_WS) + wid * 64;
    LAS float* PgL = (LAS float*)(lds + OFF_PG); LAS float* SC = (LAS float*)(lds + OFF_SC); LAS unsigned* SEL = (LAS unsigned*)(lds + OFF_SEL); LAS unsigned* UNI = (LAS unsigned*)(lds + OFF_UNI);
    const int tl = 8 * wid + (r32 >> 2), g = r32 & 3, t = 64 * jq + tl, hq = kvh * 4 + g;
    const size_t mrow = (size_t)b * T + t;
    const float NEG = -__builtin_inff();

    const float gt0 = GF[mrow * 32 + hq * 3 + 0];
    const bf16_t* KC = (const bf16_t*)(ws + WS_KC) + (size_t)(b * 2 + kvh) * 128 * 128; const bf16_t* VC = (const bf16_t*)(ws + WS_VC) + (size_t)(b * 2 + kvh) * 128 * 128;
    const bool two = jq >= 16;
    { Stg s0; stg_load(s0, KC, VC, 128, A.sr, A.sc);
      __syncthreads();
      stg_write(s0, lds, 0, 0, A.kws, A.vst0, A.vst1);
      if (two) { Stg s1; stg_load(s1, KC + 64 * 128, VC + 64 * 128, 128, A.sr, A.sc); stg_write(s1, lds, 1, 1, A.kws, A.vst0, A.vst1); }
      if (tid == 0) *UNI = 0u;
      __syncthreads(); }
    f32x16 a0, a1, b0, b1;
    qkt(a0, a1, lds, 0, r32, hi, qr);
    if (two) qkt(b0, b1, lds, 1, r32, hi, qr);
    else {
#pragma unroll
        for (int r = 0; r < 16; ++r) { b0[r] = NEG; b1[r] = NEG; } }
    const int cmax = (t - 31) >> 4; float mx = -1e30f;
#pragma unroll
    for (int r = 0; r < 16; ++r) { const int c = crow(r, hi);
        a0[r] = (c <= cmax) ? a0[r] * C2 : NEG; a1[r] = (c + 32 <= cmax) ? a1[r] * C2 : NEG; b0[r] = (c + 64 <= cmax) ? b0[r] * C2 : NEG; b1[r] = (c + 96 <= cmax) ? b1[r] * C2 : NEG;
        mx = fmaxf(mx, fmaxf(fmaxf(a0[r], a1[r]), fmaxf(b0[r], b1[r]))); }
    mx = xhalf_max(mx);
    float ps = 0.f;
#pragma unroll
    for (int r = 0; r < 16; ++r) { a0[r] = __builtin_amdgcn_exp2f(a0[r] - mx); a1[r] = __builtin_amdgcn_exp2f(a1[r] - mx); b0[r] = __builtin_amdgcn_exp2f(b0[r] - mx); b1[r] = __builtin_amdgcn_exp2f(b1[r] - mx);
        ps += (a0[r] + a1[r]) + (b0[r] + b1[r]); }
    ps = xhalf_sum(ps);
    const float inv = ps > 0.f ? 1.0f / ps : 0.f;
#pragma unroll
    for (int r = 0; r < 16; ++r) { a0[r] *= inv; a1[r] *= inv; b0[r] *= inv; b1[r] *= inv; }
#define QSUM(x) ({ float y_ = (x); y_ += __int_as_float(__builtin_amdgcn_update_dpp(0, __float_as_int(y_), 0xB1, 0xf, 0xf, false)); y_ += __int_as_float(__builtin_amdgcn_update_dpp(0, __float_as_int(y_), 0x4E, 0xf, 0xf, false)); y_; })
#pragma unroll
    for (int g4 = 0; g4 < 4; ++g4) {
        f32x4 va, vb, vc, vd;
#pragma unroll
        for (int e = 0; e < 4; ++e) { va[e] = QSUM(a0[4 * g4 + e]); vb[e] = QSUM(a1[4 * g4 + e]); vc[e] = QSUM(b0[4 * g4 + e]); vd[e] = QSUM(b1[4 * g4 + e]); }
        if (g == 0) { LAS float* pr = PgL + tl * 128 + 8 * g4 + 4 * hi; *(LAS f32x4*)pr = va; *(LAS f32x4*)(pr + 32) = vb; *(LAS f32x4*)(pr + 64) = vc; *(LAS f32x4*)(pr + 96) = vd; }
    }
#undef QSUM
    f32x16 o[4] = {};
    { bf16x8 pa0, pa1, pa2, pa3; PK4(a0, 0, pa0); PK4(a0, 8, pa1); PK4(a1, 0, pa2); PK4(a1, 8, pa3); SBAR(); pv_tile<0>(o, A.vb0, pa0, pa1, pa2, pa3); }
    if (two) { bf16x8 pa0, pa1, pa2, pa3; PK4(b0, 0, pa0); PK4(b0, 8, pa1); PK4(b1, 0, pa2); PK4(b1, 8, pa3); SBAR(); pv_tile<1>(o, A.vb0, pa0, pa1, pa2, pa3); }
    if (hi == 0) tab[32 + r32] = gt0;
    asm volatile("s_waitcnt lgkmcnt(0)" ::: "memory");
    { bf16_t* Ob = (bf16_t*)(ws + WS_NSA0) + ((size_t)b * T + 64 * jq + 8 * wid) * 1024 + kvh * 512;
      O_STORE(o, tab + 32, NSA_ROWPTR); }
    asm volatile("s_waitcnt lgkmcnt(0)" ::: "memory");
    __syncthreads();
#pragma unroll
    for (int i = 0; i < 4; ++i) { const int tok = (tid >> 5) + 16 * i, j = tid & 31; const LAS float* pr = PgL + tok * 128;
        float imp = pr[4 * j] + pr[4 * j + 1] + pr[4 * j + 2] + pr[4 * j + 3]; if (j > 0) imp += pr[4 * j - 1];
        const float scv = (j == 0 || j == jq || j == jq - 1) ? 1e9f : (j <= jq ? imp : -1e30f);
        SC[tok * 32 + j] = scv; }
    __syncthreads();
    unsigned uni_w = 0u;
#pragma unroll
    for (int i = 0; i < 4; ++i) { const int tok = (tid >> 5) + 16 * i, j = tid & 31; const float my = SC[tok * 32 + j]; int cnt = 0;
#pragma unroll
        for (int q = 0; q < 8; ++q) { const f32x4 v = *(const LAS f32x4*)(SC + tok * 32 + 4 * q);
#pragma unroll
            for (int e = 0; e < 4; ++e) { const int jj = 4 * q + e; cnt += (v[e] > my || (v[e] == my && jj < j)) ? 1 : 0; } }
        const unsigned long long bal = __ballot(cnt < 8);
        if ((lane & 31) == 0) SEL[tok] = (unsigned)(bal >> (lane & 32));
        uni_w |= (unsigned)bal | (unsigned)(bal >> 32); }
    if (lane == 0) atomicOr((unsigned*)UNI, uni_w);
    __syncthreads();
}
template <int MODE>
__device__ __forceinline__ void nsa_branch(Frame& F, int L, int b, int kvh, int jq, const bf16x8* qr) {
    using namespace att;
    (void)L; RELAUNDER();
    lptr lds = (lptr)F.ldsl; unsigned char* ws = arg_ws();
    const bf16_t* HID = (const bf16_t*)(ws + WS_HID); const float* GF = (const float*)(ws + WS_GF);
    const Lanes A = mk_lanes(F); const int wid = A.wid, r32 = A.r32, hi = A.hi;
    LAS float* tab = (LAS float*)(lds + OFF_WS) + wid * 64;
    LAS unsigned* SEL = (LAS unsigned*)(lds + OFF_SEL); LAS unsigned* UNI = (LAS unsigned*)(lds + OFF_UNI);
    const int tl = 8 * wid + (r32 >> 2), g = r32 & 3, t = 64 * jq + tl, hq = kvh * 4 + g;
    const size_t mrow = (size_t)b * T + t;
    const float NEG = -__builtin_inff();

    const float gt = GF[mrow * 32 + hq * 3 + MODE];
    const float sref = -C2 * 12.0f * qrow_norm(qr);
    const bf16_t* Kb = HID + (size_t)b * T * LDP + C_KV + MODE * 512 + kvh * 128; const bf16_t* Vb = Kb + 256;
    unsigned U, Uw = 0xFFFFFFFFu, selm = 0xFFFFFFFFu;
    if (MODE == 1) {
        const unsigned causal = (jq == 31) ? 0xFFFFFFFFu : ((2u << jq) - 1u);
        selm = SEL[tl] & causal;
        U = (unsigned)__builtin_amdgcn_readfirstlane((int)(*UNI & causal));
        unsigned uw = selm; uw |= __shfl_xor(uw, 4); uw |= __shfl_xor(uw, 8); uw |= __shfl_xor(uw, 16); uw |= __shfl_xor(uw, 32);
        Uw = (unsigned)__builtin_amdgcn_readfirstlane((int)uw);
    } else {
        const int jlo = jq >= 8 ? jq - 8 : 0;
        U = (jq == 31 ? 0xFFFFFFFFu : ((2u << jq) - 1u)) & ~((1u << jlo) - 1u);
    }
    f32x16 o[4] = {}; float l = 0.f;
#define NSA_TRANSFORM(P0, P1, J) do { const bool rowsel_ = (MODE == 1) ? (((selm >> (J)) & 1u) != 0u) : true; \
        const int dhi_ = ((J) == jq) ? (tl - 4 * hi) : 1000; const int dlo_ = (MODE == 2 && (J) == jq - 8) ? (tl - 4 * hi) : -1000; \
        _Pragma("unroll") for (int r = 0; r < 16; ++r) { const int c = (r & 3) + 8 * (r >> 2); \
            P0[r] = (rowsel_ && c <= dhi_ && c > dlo_) ? fmaf(P0[r], C2, sref) : NEG; P1[r] = (rowsel_ && c + 32 <= dhi_ && c + 32 > dlo_) ? fmaf(P1[r], C2, sref) : NEG; } } while (0)
    (void)Uw;
    unsigned rem = U; int j = __builtin_ctz(rem); rem &= rem - 1u;
    const Dma D = dma_offs(wid, A.lane, LDP);
    __syncthreads();
    dma_tile2(D, Kb + (size_t)(64 * j) * LDP, Vb + (size_t)(64 * j) * LDP, lds, 0, 0, wid);
    int jn = -1;
    if (rem) { jn = __builtin_ctz(rem); rem &= rem - 1u; dma_tile2(D, Kb + (size_t)(64 * jn) * LDP, Vb + (size_t)(64 * jn) * LDP, lds, 1, 1, wid);
               asm volatile("s_waitcnt vmcnt(4)" ::: "memory"); }
    else DMA_WAIT();
    __syncthreads();
    f32x16 pA0, pA1;
    { qkt(pA0, pA1, lds, 0, r32, hi, qr); NSA_TRANSFORM(pA0, pA1, j);
      DMA_WAIT(); __syncthreads(); }
    int vs = 1, n = 1;
    while (jn >= 0) {
        j = jn; jn = -1;
        const int vn = vs == 2 ? 0 : vs + 1, vp = vs == 0 ? 2 : vs - 1;
        if (rem) { jn = __builtin_ctz(rem); rem &= rem - 1u; dma_tile2(D, Kb + (size_t)(64 * jn) * LDP, Vb + (size_t)(64 * jn) * LDP, lds, (n + 1) & 1, vn, wid); }
        f32x16 pB0, pB1;
        qkt(pB0, pB1, lds, n & 1, r32, hi, qr);
        float ps = 0.f;
#pragma unroll
        for (int r = 0; r < 16; ++r) { pA0[r] = __builtin_amdgcn_exp2f(pA0[r]); ps += pA0[r]; }
#pragma unroll
        for (int r = 0; r < 16; ++r) { pA1[r] = __builtin_amdgcn_exp2f(pA1[r]); ps += pA1[r]; }
        l += ps;
        bf16x8 pa0, pa1, pa2, pa3;
        PK4(pA0, 0, pa0); PK4(pA0, 8, pa1); PK4(pA1, 0, pa2); PK4(pA1, 8, pa3);
        pv_tile<0>(o, A.vb0 + vp * SHM_V, pa0, pa1, pa2, pa3);
        NSA_TRANSFORM(pB0, pB1, j);
        pA0 = pB0; pA1 = pB1;
        DMA_WAIT(); __syncthreads();
        vs = vn; ++n;
    }
    {
        const int vp = vs == 0 ? 2 : vs - 1;
        float ps = 0.f;
#pragma unroll
        for (int r = 0; r < 16; ++r) { pA0[r] = __builtin_amdgcn_exp2f(pA0[r]); ps += pA0[r]; }
#pragma unroll
        for (int r = 0; r < 16; ++r) { pA1[r] = __builtin_amdgcn_exp2f(pA1[r]); ps += pA1[r]; }
        l += ps;
        bf16x8 pa0, pa1, pa2, pa3;
        PK4(pA0, 0, pa0); PK4(pA0, 8, pa1); PK4(pA1, 0, pa2); PK4(pA1, 8, pa3);
        SBAR();
        pv_tile<0>(o, A.vb0 + vp * SHM_V, pa0, pa1, pa2, pa3);
    }
#undef NSA_TRANSFORM
    l = xhalf_sum(l);
    if (hi == 0) tab[32 + r32] = gt / l;
    asm volatile("s_waitcnt lgkmcnt(0)" ::: "memory");
    { bf16_t* Ob = (bf16_t*)(ws + (MODE == 1 ? WS_NSA1 : WS_NSA2)) + ((size_t)b * T + 64 * jq + 8 * wid) * 1024 + kvh * 512;
      O_STORE(o, tab + 32, NSA_ROWPTR); }
    asm volatile("s_waitcnt lgkmcnt(0)" ::: "memory");
}
#undef NSA_ROWPTR

__device__ __forceinline__ void phase_attn(Frame& F, int L) {
    for (int it = F.vcu; it < 512; it += F.G) { const int b = it >> 5, h = (it >> 2) & 7, p = it & 3;
#if !defined(NO_FOX)
        for (int half = 0; half < 2; ++half) fox_block(F, L, b, h, half ? p : 7 - p);
#endif
    }
    STAMP(11);
    for (int rd = 0; rd * F.G < 1024; ++rd) { const int i = rd * F.G + ((rd & 1) ? (F.G - 1 - F.vcu) : F.vcu); if (i >= 1024) continue;
        const int jq = 31 - (i >> 5), rem = i & 31, b = rem >> 1, kvh = rem & 1;
#if !defined(NO_NSA)
        { using namespace att; RELAUNDER();
          const int wid_ = F.wave, r32_ = F.lane & 31, hi_ = F.lane >> 5, tl_ = 8 * wid_ + (r32_ >> 2), t_ = 64 * jq + tl_, hq_ = kvh * 4 + (r32_ & 3);
          const bf16_t* HID_ = (const bf16_t*)(arg_ws() + WS_HID); const float* rc_ = (const float*)(arg_ws() + WS_ROPE);
          bf16x8 qr[8];
          load_q_norm<true>(qr, HID_ + ((size_t)b * T + t_) * LDP + hq_ * 128 + hi_ * 8, arg_in(7) + L * 128, hi_, t_, rc_, rc_ + T * 16);
          nsa_cmp_select(F, L, b, kvh, jq, qr);
          nsa_branch<1>(F, L, b, kvh, jq, qr);
          nsa_branch<2>(F, L, b, kvh, jq, qr); }
#endif
    }
}

struct Args { const float* in[22]; float* out; unsigned char* ws; };
#define GRID_BAR() do { XcdBarrier bar_; bar_.bar = (unsigned*)(arg_ws() + WS_CTL) + CW_BAR; bar_.x = xb_xcc_id(); bar_.st = (volatile LAS unsigned*)(F.ldsl + MISC_OFF) + 8; xcd_barrier(bar_); RELAUNDER(); } while (0)
__global__ void __launch_bounds__(512, 2) mega_fwd(Args args) {
    extern __shared__ __attribute__((aligned(16))) unsigned char lds[];
    (void)args;
    Frame F;
    F.lds = lds; F.ldsl = (LAS unsigned char*)lds;
    F.tid = threadIdx.x; F.lane = F.tid & 63; F.wave = __builtin_amdgcn_readfirstlane(F.tid >> 6);
    F.G = gridDim.x; { const int bx = blockIdx.x; F.vcu = (F.G % 8 == 0) ? (bx % 8) * (F.G / 8) + bx / 8 : bx; }
    F.gw = F.vcu * 8 + F.wave; F.NGW = F.G * 8;
    for (int u = F.tid; u < (LDS_BYTES - LDSCTL_OFF) / 4; u += 512) ((LAS unsigned*)(F.ldsl + LDSCTL_OFF))[u] = 0u;
    __syncthreads();
    (void)xcd_barrier_post((unsigned*)(arg_ws() + WS_CTL) + CW_BAR, (volatile LAS unsigned*)(F.ldsl + MISC_OFF) + 8);
#if PROBE_MASK
    if (blockIdx.x == 0 && F.tid == 0) { volatile LAS unsigned long long* pa_ = (volatile LAS unsigned long long*)(F.ldsl + MISC_OFF + 64); const unsigned long long r0_ = __builtin_amdgcn_s_memrealtime(); pa_[15] = r0_; pa_[14] = r0_; pa_[13] = __builtin_amdgcn_s_memtime(); }
#endif
    for (int L = 0; L < NL; ++L) {
        for (int sb = 0; sb < 3; ++sb) {
            if (sb != 1) {
                const int first = (L == 0 && sb == 0);
                if (first) {
                    phase_convert(F, 0, F.gw, F.NGW);
                    phase_prenorm(F, arg_in(0), arg_in(1), (bf16_t*)(arg_ws() + WS_XB), (float*)(arg_ws() + WS_PS));
                    GRID_BAR(); STAMP(0);
                }
                { unsigned char* ws = arg_ws();
                  pg8::Gemm g{(const bf16_t*)(ws + WS_XB), (const bf16_t*)(ws + (size_t)(L & 1) * WSET + (sb == 0 ? WS_WGU : WS_WGU2)), M, 2 * DFF, DM}; pg8::StaticOrder S; S.init(M, 2 * DFF, F.G, (int)blockIdx.x);
                  pg8::EpiSwiglu E{(bf16_t*)(ws + WS_HID), DFF, (const float*)(ws + WS_PS) + (size_t)(L * 3 + sb) * M * 32, (LAS float*)(F.ldsl + RL_OFF), -1}; pg8::gemm_phase<pg8::EpiSwiglu, pg8::StaticOrder, true, true>(F.ldsl, g, S, E, F.tid); }
                GRID_BAR(); STAMP(1);
                { unsigned char* ws = arg_ws();
                  const bool last = (L == NL - 1 && sb == 2);
                  pg8::Gemm g{(const bf16_t*)(ws + WS_HID), (const bf16_t*)(ws + (size_t)(L & 1) * WSET + (sb == 0 ? WS_WD : WS_WD2)), M, DM, DFF}; pg8::StaticOrder S; S.init(M, DM, F.G, (int)blockIdx.x); S.rev = 1; S.wgm = 4;
                  pg8::EpiResid E{0.5f, last ? 1 : 0, sb == 0 ? L * 3 + 1 : (L + 1) * 3}; pg8::gemm_phase<pg8::EpiResid, pg8::StaticOrder, false, true>(F.ldsl, g, S, E, F.tid); }
                GRID_BAR(); STAMP(2);
            } else {
                { unsigned char* ws = arg_ws();
                  pg8::Gemm g{(const bf16_t*)(ws + WS_XB), (const bf16_t*)(ws + (size_t)(L & 1) * WSET + WS_WIN), M, NWIN, DM}; pg8::StaticOrder S; S.init(M, NWIN, F.G, (int)blockIdx.x);
                  pg8::EpiProj E{(bf16_t*)(ws + WS_HID), LDP, (float*)(ws + WS_GF), (const float*)(ws + WS_PS) + (size_t)(L * 3 + 1) * M * 32, (LAS float*)(F.ldsl + RL_OFF), -1}; pg8::gemm_phase<pg8::EpiProj, pg8::StaticOrder, true, true>(F.ldsl, g, S, E, F.tid); }
                GRID_BAR(); STAMP(4);
                phase_prep(F, L);
                GRID_BAR(); STAMP(5);
                { unsigned char* ws = arg_ws();
                  pg8::Gemm g{(const bf16_t*)(ws + WS_CMPA), (const bf16_t*)(ws + (size_t)(L & 1) * WSET + WS_WC1), 8192, 512, 4096}; pg8::CmpOrder S{F.G, (int)blockIdx.x};
                  pg8::EpiGeluCmp E{(bf16_t*)(ws + WS_CMPH)}; pg8::gemm_phase<pg8::EpiGeluCmp, pg8::CmpOrder, true, true>(F.ldsl, g, S, E, F.tid); }
                phase_scan(F);
                if (L + 1 < NL && blockIdx.x >= 32) phase_convert(F, L + 1, ((int)blockIdx.x - 32) * 8 + F.wave, (F.G - 32) * 8);
                GRID_BAR(); STAMP(6);
                phase_cmp2(F, L);
                GRID_BAR(); STAMP(7);
                phase_attn(F, L); STAMP(12);
                GRID_BAR(); STAMP(8);
                phase_outnorm(F, L);
                GRID_BAR(); STAMP(9);
                { unsigned char* ws = arg_ws();
                  pg8::Gemm g{(const bf16_t*)(ws + WS_HN), (const bf16_t*)(ws + (size_t)(L & 1) * WSET + WS_WOUT), M, DM, DM}; pg8::StaticOrder S; S.init(M, DM, F.G, (int)blockIdx.x); S.wgm = 4;
                  pg8::EpiResid E{1.0f, 0, L * 3 + 2};
                  pg8::gemm_phase<pg8::EpiResid, pg8::StaticOrder, false, true>(F.ldsl, g, S, E, F.tid); }
                GRID_BAR(); STAMP(10);
            }
        }
    }
#if PROBE_MASK
    if (blockIdx.x == 0 && F.tid == 0) {
        volatile LAS unsigned long long* pa_ = (volatile LAS unsigned long long*)(F.ldsl + MISC_OFF + 64);
        const unsigned long long r1 = __builtin_amdgcn_s_memrealtime(), c1 = __builtin_amdgcn_s_memtime();
        unsigned long long target = 0;
        if (PROBE_MASK & 0x10000) target = (unsigned long long)((float)(c1 - pa_[13]) / (float)(r1 - pa_[14]) * 100000.0f);
        else { for (int t_ = 0; t_ < 13; ++t_) if ((PROBE_MASK >> t_) & 1) target += pa_[t_]; target *= PROBE_K; }
        while (__builtin_amdgcn_s_memrealtime() - r1 < target) __builtin_amdgcn_s_sleep(32);
    }
#endif
}

extern "C" void kernel_launch(void* const* d_in, const int* in_sizes, int n_in, void* d_out, int out_size, void* d_ws, size_t ws_size, hipStream_t stream) {
    static int grid = 0;
    if (grid == 0) {
        if (n_in != 22 || out_size != M * DM || ws_size < WS_END) { fprintf(stderr, "kernel_launch: unexpected shapes (n_in %d out %d ws %zu)\n", n_in, out_size, ws_size); grid = -1; return; }
        int dev = 0, cus = 0, per_cu = 0;
        if (hipGetDevice(&dev) != hipSuccess || hipDeviceGetAttribute(&cus, hipDeviceAttributeMultiprocessorCount, dev) != hipSuccess) { grid = -1; return; }
        if (hipFuncSetAttribute((const void*)mega_fwd, hipFuncAttributeMaxDynamicSharedMemorySize, LDS_BYTES) != hipSuccess) { fprintf(stderr, "kernel_launch: hipFuncSetAttribute failed\n"); grid = -1; return; }
        if (hipOccupancyMaxActiveBlocksPerMultiprocessor(&per_cu, (const void*)mega_fwd, 512, LDS_BYTES) != hipSuccess || per_cu < 1) fprintf(stderr, "kernel_launch: occupancy query reports %d\n", per_cu);
        (void)hipGetLastError();
        grid = cus;
    }
    if (grid < 0) return;
    (void)in_sizes;
    if (hipMemsetAsync((char*)d_ws + WS_CTL, 0, CTL_ZERO_BYTES, stream) != hipSuccess) return;
    Args a{};
    for (int i = 0; i < 22; ++i) a.in[i] = (const float*)d_in[i];
    a.out = (float*)d_out; a.ws = (unsigned char*)d_ws;
    hipLaunchKernelGGL(mega_fwd, dim3(grid), dim3(512), LDS_BYTES, stream, a);
}
```

```cpp
#include <hip/hip_runtime.h>
#include <cstdio>
#include <cstdint>

#ifndef PROBE_MASK
#define PROBE_MASK 0
#endif
#ifndef PROBE_K
#define PROBE_K 1
#endif
#define GAS __attribute__((address_space(1)))
#define LAS __attribute__((address_space(3)))
typedef unsigned short bf16_t;
typedef short bf16x8 __attribute__((ext_vector_type(8)));
typedef short s16x4 __attribute__((ext_vector_type(4)));
typedef float f32x4 __attribute__((ext_vector_type(4)));
typedef float f32x2 __attribute__((ext_vector_type(2)));
typedef float f32x16 __attribute__((ext_vector_type(16)));
typedef unsigned u32x4 __attribute__((ext_vector_type(4)));
typedef unsigned u32x2 __attribute__((ext_vector_type(2)));

constexpr int NB = 16, T = 2048, DM = 2048, M = NB * T, NL = 4, HD = 128, DFF = 5632;
constexpr int LDP = 5632;
constexpr int PROJ_COLS = 5664, NWIN = 5888;
constexpr int C_KV = 1024, C_FQ = 2560, C_FK = 3584, C_FV = 4608;
constexpr int NCMP = 127;
constexpr float EPS = 1e-6f;
constexpr float RS_SCALE = 16777216.0f, RS_INV = 1.0f / 16777216.0f / 2048.0f;
typedef unsigned long long u64_t;
constexpr float LOG2E = 1.4426950408889634f;
constexpr float C2 = 0.08838834764831845f * 1.4426950408889634f;

constexpr size_t MiB = 1u << 20;
constexpr size_t WS_CTL = 0, CTL_ZERO_BYTES = 1 * MiB;
constexpr size_t WS_ROPE = 1 * MiB;
constexpr size_t WS_CUM = 2 * MiB;
constexpr size_t WS_GF = 3 * MiB;
constexpr size_t WS_KC = 7 * MiB;
constexpr size_t WS_VC = 8 * MiB;
constexpr size_t WS_CMPH = 9 * MiB;
constexpr size_t WS_WGU = 16 * MiB;
constexpr size_t WS_WD = 60 * MiB;
constexpr size_t WS_WIN = 82 * MiB;
constexpr size_t WS_WOUT = 105 * MiB;
constexpr size_t WS_WGU2 = 113 * MiB;
constexpr size_t WS_WD2 = 157 * MiB;
constexpr size_t WS_WC1 = 179 * MiB;
constexpr size_t WS_LF = 183 * MiB;
constexpr size_t WS_CMPA = 184 * MiB;
constexpr size_t WS_HN = 248 * MiB;
constexpr size_t WS_HID = 376 * MiB;
constexpr size_t WS_NSA0 = 728 * MiB, WS_NSA1 = 792 * MiB, WS_NSA2 = 856 * MiB;
constexpr size_t WS_XB = 920 * MiB;
constexpr size_t WS_RS = 13 * MiB, RS_BYTES = (size_t)NL * 3 * M * 8;
constexpr size_t WSET = 1032 * MiB;
constexpr size_t WS_PS = 1216 * MiB;
constexpr size_t WS_END = 1216 * MiB + 48 * MiB;
constexpr int CW_BAR = 4096;

constexpr int RING_BYTES = 131072;
constexpr int LDSCTL_OFF = RING_BYTES, MISC_OFF = LDSCTL_OFF + 320;
constexpr int RL_OFF = LDSCTL_OFF + 1024;
constexpr int LDS_BYTES = 147456;

__device__ __forceinline__ unsigned long long karg(int i) {
    const __attribute__((address_space(4))) unsigned char* kp = (const __attribute__((address_space(4))) unsigned char*)__builtin_amdgcn_kernarg_segment_ptr();
    return *(const __attribute__((address_space(4))) unsigned long long volatile*)(kp + 8 * i);
}
__device__ __forceinline__ const float* arg_in(int i) { return (const float*)(const GAS float*)karg(i); }
__device__ __forceinline__ float* arg_out() { return (float*)(GAS float*)karg(22); }
__device__ __forceinline__ unsigned char* arg_ws() { return (unsigned char*)(GAS unsigned char*)karg(23); }
namespace pg8 {
#define PG8_LAS __attribute__((address_space(3)))
constexpr int BM = 256, BK = 64, HALF = 128, HTB = HALF * BK * 2, STAGE_BYTES = 8 * HTB, NXCD = 8, WGM = 8;
__host__ __device__ __forceinline__ int lds_byte(int r, int c) { const int st = (r >> 4) * 2 + (c >> 5), rr = r & 15, cc = c & 31, ob = rr * 64 + cc * 2; return st * 1024 + (ob ^ (((ob >> 9) & 1) << 5)); }
__host__ __device__ __forceinline__ void stage_rc(int b, int& R, int& C) { const int st = b / 1024, sb = b % 1024, swz = sb ^ (((sb >> 9) & 1) << 5); R = (st >> 1) * 16 + swz / 64; C = (st & 1) * 32 + (swz % 64) / 2; }
__host__ __device__ __forceinline__ int perm32(int rho) { const int n = rho >> 4, i = rho & 15; return 8 * (i >> 2) + 4 * n + (i & 3); }
struct Unit { int pm, pn; };
struct Gemm { const bf16_t* A; const bf16_t* Bt; int M, N, K; };
struct StaticOrder {
    int nM, nN, nwg, G, c, rev, wgm;
    __host__ __device__ void init(int M_, int N_, int G_, int c_) { nM = M_ / BM; nN = N_ / BM; nwg = nM * nN; G = G_; c = c_; rev = 0; wgm = WGM; }
    __host__ __device__ bool next(int i, Unit& u) const {
        const long L = (long)i * G + c; if (L >= nwg) return false;
        int wgid = (int)L; { const int q = nwg / NXCD, r = nwg % NXCD, xcd = wgid % NXCD, off = wgid / NXCD; wgid = (xcd < r ? xcd * (q + 1) : r * (q + 1) + (xcd - r) * q) + off; }
        const int nig = wgm * nN, gid = wgid / nig, fm = gid * wgm, gsz = (nM - fm) < wgm ? (nM - fm) : wgm;
        u.pm = fm + ((wgid % nig) % gsz); u.pn = (wgid % nig) / gsz; if (rev) u.pm = nM - 1 - u.pm; return true;
    }
    __device__ __forceinline__ void a_ready(const Unit&) const {}
    __device__ __forceinline__ void done(const Unit&) const {}
};
struct CmpOrder {
    int G, c;
    __device__ bool next(int i, Unit& u) const { const int L = i * G + c; if (L >= 32) return false; u.pm = L; u.pn = L >> 4; return true; }
    __device__ __forceinline__ void a_ready(const Unit&) const {}
    __device__ __forceinline__ void done(const Unit&) const {}
};
typedef float cvf32x2_t __attribute__((ext_vector_type(2)));
typedef __bf16 cvbf16x2_t __attribute__((ext_vector_type(2)));
__device__ __forceinline__ unsigned cvt_pk_bf16(float lo, float hi) { const cvf32x2_t v = {lo, hi}; const cvbf16x2_t b = __builtin_convertvector(v, cvbf16x2_t); return __builtin_bit_cast(unsigned, b); }

__device__ __forceinline__ float silu_f(float g) { return g * __builtin_amdgcn_rcpf(1.0f + __builtin_amdgcn_exp2f(-g * LOG2E)); }
struct EpiSwiglu {
    static constexpr bool PERM = true, AFTER_DRAIN = false;
    bf16_t* O; int ldc; const float* rs; PG8_LAS float* rl; mutable int cpm;
    __device__ __forceinline__ void operator()(const f32x4 (&acc)[2][2][4][2], const Unit& u, int wr, int wc, int fr, int fq) const {
        const int row0 = u.pm * BM + wr * 64 + fr, col0 = u.pn * HALF + wc * 32 + 8 * fq;
        if (u.pm != cpm) {
            const int t = (wr * 4 + wc) * 64 + fq * 16 + fr;
            if (t < 256) { const f32x4* pp = (const f32x4*)(rs + (size_t)(u.pm * BM + t) * 32); float sq = 0.f;
_Pragma("unroll") for (int i = 0; i < 8; ++i) { const f32x4 v = pp[i]; sq += (v[0] + v[1]) + (v[2] + v[3]); }
                rl[t] = 1.0f / sqrtf(sq * (1.0f / DM) + EPS); }
            cpm = u.pm;
            asm volatile("s_waitcnt lgkmcnt(0)" ::: "memory"); __builtin_amdgcn_s_barrier(); asm volatile("" ::: "memory");
        }
#pragma unroll
        for (int ai = 0; ai < 2; ++ai)
#pragma unroll
            for (int m = 0; m < 4; ++m) { bf16_t* rowp = O + (size_t)(row0 + ai * HALF + m * 16) * ldc + col0;
                const float r = rl[wr * 64 + fr + ai * HALF + m * 16];
                const f32x4 g0 = acc[ai][0][m][0] * r, g1 = acc[ai][0][m][1] * r, u0 = acc[ai][1][m][0] * r, u1 = acc[ai][1][m][1] * r;
                u32x4 w;
                w.x = cvt_pk_bf16(silu_f(g0[0]) * u0[0], silu_f(g0[1]) * u0[1]); w.y = cvt_pk_bf16(silu_f(g0[2]) * u0[2], silu_f(g0[3]) * u0[3]);
                w.z = cvt_pk_bf16(silu_f(g1[0]) * u1[0], silu_f(g1[1]) * u1[1]); w.w = cvt_pk_bf16(silu_f(g1[2]) * u1[2], silu_f(g1[3]) * u1[3]);
                __builtin_nontemporal_store(w, (u32x4*)rowp); }
    }
};
struct EpiResid {
    static constexpr bool PERM = true, AFTER_DRAIN = false;
    float scale; int final_out; int rs_idx;
    __device__ __forceinline__ void operator()(const f32x4 (&acc)[2][2][4][2], const Unit& u, int wr, int wc, int fr, int fq) const {
        const int row0 = u.pm * BM + wr * 64 + fr, col0 = u.pn * BM + wc * 32 + 8 * fq;
        constexpr int ldc = DM;
        bf16_t* xb = (bf16_t*)(arg_ws() + WS_XB); float* out = arg_out();
        float* ps = (float*)(arg_ws() + WS_PS) + (size_t)rs_idx * M * 32 + u.pn * 4 + wc;
#pragma unroll
        for (int ai = 0; ai < 2; ++ai) {
            u32x4 bs[4][2];
#pragma unroll
            for (int m = 0; m < 4; ++m) { const size_t off = (size_t)(row0 + ai * HALF + m * 16) * ldc + col0;
#pragma unroll
                for (int bj = 0; bj < 2; ++bj) bs[m][bj] = *(const u32x4*)(xb + off + bj * HALF); }
            __builtin_amdgcn_sched_barrier(0);
#pragma unroll
            for (int m = 0; m < 4; ++m) { const int row = row0 + ai * HALF + m * 16; const size_t off = (size_t)row * ldc + col0; float ss = 0.f;
#pragma unroll
                for (int bj = 0; bj < 2; ++bj) { const u32x4 b = bs[m][bj]; u32x4 w;
#pragma unroll
                    for (int n = 0; n < 2; ++n) { const f32x4 a = acc[ai][bj][m][n]; const unsigned bx = n ? b.z : b.x, by = n ? b.w : b.y;
                        const f32x4 v = {__uint_as_float(bx << 16) + a[0] * scale, __uint_as_float(bx & 0xffff0000u) + a[1] * scale, __uint_as_float(by << 16) + a[2] * scale, __uint_as_float(by & 0xffff0000u) + a[3] * scale};
                        if (final_out) *(f32x4*)(out + off + bj * HALF + 4 * n) = v;
                        else { const unsigned p0 = cvt_pk_bf16(v[0], v[1]), p1 = cvt_pk_bf16(v[2], v[3]); if (n) { w.z = p0; w.w = p1; } else { w.x = p0; w.y = p1; }
                            ss += (v[0] * v[0] + v[1] * v[1]) + (v[2] * v[2] + v[3] * v[3]); } }
                    if (!final_out) *(u32x4*)(xb + off + bj * HALF) = w; }
                if (!final_out) { ss += __shfl_xor(ss, 16); ss += __shfl_xor(ss, 32); if (fq == 0) ps[(size_t)row * 32] = ss; } }
            __builtin_amdgcn_sched_barrier(0);
        }
    }
};
struct EpiProj {
    static constexpr bool PERM = true, AFTER_DRAIN = false;
    bf16_t* O; int ldc; float* GF; const float* rs; PG8_LAS float* rl; mutable int cpm;
    __device__ __forceinline__ void operator()(const f32x4 (&acc)[2][2][4][2], const Unit& u, int wr, int wc, int fr, int fq) const {
        const int row0 = u.pm * BM + wr * 64 + fr;
        if (u.pm != cpm) {
            const int t = (wr * 4 + wc) * 64 + fq * 16 + fr;
            if (t < 256) { const f32x4* pp = (const f32x4*)(rs + (size_t)(u.pm * BM + t) * 32); float sq = 0.f;
_Pragma("unroll") for (int i = 0; i < 8; ++i) { const f32x4 v = pp[i]; sq += (v[0] + v[1]) + (v[2] + v[3]); }
                rl[t] = 1.0f / sqrtf(sq * (1.0f / DM) + EPS); }
            cpm = u.pm;
            asm volatile("s_waitcnt lgkmcnt(0)" ::: "memory"); __builtin_amdgcn_s_barrier(); asm volatile("" ::: "memory");
        }
        float rr[2][4];
#pragma unroll
        for (int ai = 0; ai < 2; ++ai)
#pragma unroll
            for (int m = 0; m < 4; ++m) rr[ai][m] = rl[wr * 64 + fr + ai * HALF + m * 16];
        if (u.pn < 22) {
            const int col0 = u.pn * BM + wc * 32 + 8 * fq;
#pragma unroll
            for (int ai = 0; ai < 2; ++ai)
#pragma unroll
                for (int m = 0; m < 4; ++m) { bf16_t* rowp = O + (size_t)(row0 + ai * HALF + m * 16) * ldc + col0; const float r = rr[ai][m];
#pragma unroll
                    for (int bj = 0; bj < 2; ++bj) { const f32x4 v0 = acc[ai][bj][m][0] * r, v1 = acc[ai][bj][m][1] * r;
                        u32x4 w; w.x = cvt_pk_bf16(v0[0], v0[1]); w.y = cvt_pk_bf16(v0[2], v0[3]); w.z = cvt_pk_bf16(v1[0], v1[1]); w.w = cvt_pk_bf16(v1[2], v1[3]);
                        *(u32x4*)(rowp + bj * HALF) = w; } }
        } else if (wc == 0) {
#pragma unroll
            for (int ai = 0; ai < 2; ++ai)
#pragma unroll
                for (int m = 0; m < 4; ++m) { float* rowp = GF + (size_t)(row0 + ai * HALF + m * 16) * 32 + 8 * fq; const float r = rr[ai][m];
                    *(f32x4*)rowp = acc[ai][0][m][0] * r; *(f32x4*)(rowp + 4) = acc[ai][0][m][1] * r; }
        }
    }
};
__device__ __forceinline__ float gelu_tanh_f(float x) {
    const float u2 = 1.5957691216057308f * (x + 0.044715f * x * x * x);
    return x * __builtin_amdgcn_rcpf(1.0f + __builtin_amdgcn_exp2f(-u2 * LOG2E));
}
struct EpiGeluCmp {
    static constexpr bool PERM = true, AFTER_DRAIN = false;
    bf16_t* O;
    __device__ __forceinline__ void operator()(const f32x4 (&acc)[2][2][4][2], const Unit& u, int wr, int wc, int fr, int fq) const {
        const int row0 = u.pm * BM + wr * 64 + fr, col0 = wc * 32 + 8 * fq;
#pragma unroll
        for (int ai = 0; ai < 2; ++ai)
#pragma unroll
            for (int m = 0; m < 4; ++m) { bf16_t* rowp = O + (size_t)(row0 + ai * HALF + m * 16) * 256 + col0;
#pragma unroll
                for (int bj = 0; bj < 2; ++bj) { const f32x4 v0 = acc[ai][bj][m][0], v1 = acc[ai][bj][m][1];
                    u32x4 w; w.x = cvt_pk_bf16(gelu_tanh_f(v0[0]), gelu_tanh_f(v0[1])); w.y = cvt_pk_bf16(gelu_tanh_f(v0[2]), gelu_tanh_f(v0[3]));
                    w.z = cvt_pk_bf16(gelu_tanh_f(v1[0]), gelu_tanh_f(v1[1])); w.w = cvt_pk_bf16(gelu_tanh_f(v1[2]), gelu_tanh_f(v1[3]));
                    *(u32x4*)(rowp + bj * HALF) = w; } }
    }
};

template <class Epi, class Sched, bool ALIGN_EPI = false, bool SP2 = false>
__device__ __forceinline__ void gemm_phase(PG8_LAS unsigned char* lds, const Gemm g, const Sched& S, const Epi& E, const int tid) {
    const int wid = __builtin_amdgcn_readfirstlane(tid >> 6), lane = tid & 63, wr = wid >> 2, wc = wid & 3, fr = lane & 15, fq = lane >> 4;
    const int K = g.K, nt = K / BK;
    unsigned voffA[2], voffB[2];
#pragma unroll
    for (int i = 0; i < 2; ++i) { int R, C; stage_rc(tid * 16 + i * 8192, R, C); const int Rb = Epi::PERM ? ((R & ~31) + perm32(R & 31)) : R;
        voffA[i] = (unsigned)(R * K + C) * 2u; voffB[i] = (unsigned)(Rb * K + C) * 2u; }
    const size_t kstep = (size_t)(BK * 2);
    const size_t hstep = (size_t)HALF * K * 2;
    const size_t tstep = 2 * hstep;
    const unsigned ldsw = (unsigned)wid * 1024u;
    const int aoff = lds_byte(wr * 64 + fr, fq * 8), boff = lds_byte(wc * 32 + fr, fq * 8);
#define PG8_SA(b, h) (((b) * 2 + (h)) * HTB)
#define PG8_SB(b, h) ((4 + (b) * 2 + (h)) * HTB)
#define PG8_STAGE(bufoff, gbase, voff) do { _Pragma("unroll") for (int _i = 0; _i < 2; ++_i) \
        __builtin_amdgcn_global_load_lds((const unsigned*)((const char*)(gbase) + (voff)[_i]), (PG8_LAS unsigned*)(lds + (bufoff) + ldsw + _i * 8192), 16, 0, 0); } while (0)
#define PG8_LDA(dst, b, h) do { _Pragma("unroll") for (int m = 0; m < 4; ++m) _Pragma("unroll") for (int k = 0; k < 2; ++k) dst[m][k] = *(const PG8_LAS bf16x8*)(lds + PG8_SA(b, h) + aoff + m * 2048 + k * 1024); } while (0)
#define PG8_LDB(dst, b, h) do { _Pragma("unroll") for (int n = 0; n < 2; ++n) _Pragma("unroll") for (int k = 0; k < 2; ++k) dst[n][k] = *(const PG8_LAS bf16x8*)(lds + PG8_SB(b, h) + boff + n * 2048 + k * 1024); } while (0)
#define PG8_MMA(ai, bj, At, Bt) do { __builtin_amdgcn_s_setprio(1); _Pragma("unroll") for (int m = 0; m < 4; ++m) _Pragma("unroll") for (int n = 0; n < 2; ++n) _Pragma("unroll") for (int k = 0; k < 2; ++k) \
        acc[ai][bj][m][n] = __builtin_amdgcn_mfma_f32_16x16x32_bf16(Bt[n][k], At[m][k], acc[ai][bj][m][n], 0, 0, 0); __builtin_amdgcn_s_setprio(0); } while (0)
#define PG8_WAIT_V(n) asm volatile("s_waitcnt vmcnt(" #n ")" ::: "memory")
#define PG8_WAIT_L(n) asm volatile("s_waitcnt lgkmcnt(" #n ")" ::: "memory")
#define PG8_BAR __builtin_amdgcn_s_barrier()
#define PG8_SCHED __builtin_amdgcn_sched_barrier(0)
    Unit cur, nxt; int ui = 0;
    if (!S.next(0, cur)) return;
    f32x4 acc[2][2][4][2];
#pragma unroll
    for (int a = 0; a < 2; ++a)
#pragma unroll
        for (int b = 0; b < 2; ++b)
#pragma unroll
            for (int m = 0; m < 4; ++m)
#pragma unroll
                for (int n = 0; n < 2; ++n) acc[a][b][m][n] = (f32x4){0.f, 0.f, 0.f, 0.f};
    bf16x8 At[4][2], B0[2][2], B1[2][2];
    const char* cA = (const char*)g.A + (size_t)cur.pm * tstep; const char* cB = (const char*)g.Bt + (size_t)cur.pn * tstep;
    S.a_ready(cur);
    if constexpr (SP2) {
        PG8_STAGE(PG8_SB(0, 0), cB, voffB); PG8_STAGE(PG8_SB(0, 1), cB + hstep, voffB); PG8_STAGE(PG8_SA(0, 0), cA, voffA); PG8_STAGE(PG8_SA(0, 1), cA + hstep, voffA);
        if (wr == 1) PG8_BAR;
        PG8_WAIT_V(2); PG8_BAR;
        PG8_STAGE(PG8_SB(1, 0), cB + kstep, voffB); PG8_STAGE(PG8_SA(1, 0), cA + kstep, voffA); PG8_STAGE(PG8_SB(1, 1), cB + hstep + kstep, voffB);
        PG8_WAIT_V(6); PG8_BAR;
    } else {
        PG8_STAGE(PG8_SB(0, 0), cB, voffB); PG8_STAGE(PG8_SA(0, 0), cA, voffA); PG8_STAGE(PG8_SB(0, 1), cB + hstep, voffB); PG8_STAGE(PG8_SA(0, 1), cA + hstep, voffA);
        if (wr == 1) PG8_BAR;
        PG8_WAIT_V(4); PG8_BAR;
        PG8_STAGE(PG8_SB(1, 0), cB + kstep, voffB); PG8_STAGE(PG8_SA(1, 0), cA + kstep, voffA); PG8_STAGE(PG8_SB(1, 1), cB + hstep + kstep, voffB);
        PG8_WAIT_V(6); PG8_BAR;
    }
    for (;;) {
        const bool has_next = S.next(ui + 1, nxt);
        const char* nA = has_next ? (const char*)g.A + (size_t)nxt.pm * tstep : cA; const char* nB = has_next ? (const char*)g.Bt + (size_t)nxt.pn * tstep : cB;
        for (int t = 0; t < nt; t += 2) {
            const bool last = (t == nt - 2);
            const char* a1 = cA + (size_t)(t + 1) * kstep;
            const char* a2 = last ? nA : cA + (size_t)(t + 2) * kstep; const char* b2 = last ? nB : cB + (size_t)(t + 2) * kstep;
            const char* a3 = a2 + kstep; const char* b3 = b2 + kstep;
            if (last && has_next) S.a_ready(nxt);
            if constexpr (SP2) {
            PG8_LDB(B0, 0, 0); PG8_LDB(B1, 0, 1); PG8_SCHED; PG8_LDA(At, 0, 0); PG8_STAGE(PG8_SA(1, 1), a1 + hstep, voffA);
            PG8_WAIT_V(8); PG8_WAIT_L(0); PG8_BAR; PG8_MMA(0, 0, At, B0); PG8_MMA(0, 1, At, B1); PG8_BAR; PG8_SCHED;
            PG8_LDA(At, 0, 1); PG8_STAGE(PG8_SB(0, 0), b2, voffB); PG8_STAGE(PG8_SB(0, 1), b2 + hstep, voffB); PG8_STAGE(PG8_SA(0, 0), a2, voffA);
            PG8_WAIT_V(8); PG8_WAIT_L(0); PG8_BAR; PG8_MMA(1, 0, At, B0); PG8_MMA(1, 1, At, B1); PG8_BAR; PG8_SCHED;
            PG8_LDB(B0, 1, 0); PG8_LDB(B1, 1, 1); PG8_SCHED; PG8_LDA(At, 1, 0); PG8_STAGE(PG8_SA(0, 1), a2 + hstep, voffA);
            PG8_WAIT_V(8); PG8_WAIT_L(0); PG8_BAR; PG8_MMA(0, 0, At, B0); PG8_MMA(0, 1, At, B1); PG8_BAR; PG8_SCHED;
            PG8_LDA(At, 1, 1); PG8_STAGE(PG8_SB(1, 0), b3, voffB); PG8_STAGE(PG8_SB(1, 1), b3 + hstep, voffB); PG8_STAGE(PG8_SA(1, 0), a3, voffA);
            PG8_WAIT_V(8); PG8_WAIT_L(0); PG8_BAR; PG8_MMA(1, 0, At, B0); PG8_MMA(1, 1, At, B1); PG8_BAR; PG8_SCHED;
            } else {
            PG8_LDB(B0, 0, 0); PG8_SCHED; PG8_LDA(At, 0, 0); PG8_STAGE(PG8_SA(1, 1), a1 + hstep, voffA);
            PG8_WAIT_L(8); PG8_BAR; PG8_WAIT_L(0); PG8_MMA(0, 0, At, B0); PG8_BAR; PG8_SCHED;
            PG8_LDB(B1, 0, 1); PG8_STAGE(PG8_SB(0, 0), b2, voffB);
            PG8_BAR; PG8_WAIT_L(0); PG8_MMA(0, 1, At, B1); PG8_BAR;
            PG8_LDA(At, 0, 1); PG8_STAGE(PG8_SA(0, 0), a2, voffA);
            PG8_BAR; PG8_WAIT_L(0); PG8_MMA(1, 0, At, B0); PG8_BAR; PG8_SCHED;
            PG8_STAGE(PG8_SB(0, 1), b2 + hstep, voffB);
            PG8_WAIT_V(6); PG8_BAR; PG8_MMA(1, 1, At, B1); PG8_BAR;
            PG8_LDB(B0, 1, 0); PG8_SCHED; PG8_LDA(At, 1, 0); PG8_STAGE(PG8_SA(0, 1), a2 + hstep, voffA);
            PG8_WAIT_L(8); PG8_BAR; PG8_WAIT_L(0); PG8_MMA(0, 0, At, B0); PG8_BAR; PG8_SCHED;
            PG8_LDB(B1, 1, 1); PG8_STAGE(PG8_SB(1, 0), b3, voffB);
            PG8_BAR; PG8_WAIT_L(0); PG8_MMA(0, 1, At, B1); PG8_BAR;
            PG8_LDA(At, 1, 1); PG8_STAGE(PG8_SA(1, 0), a3, voffA);
            PG8_BAR; PG8_WAIT_L(0); PG8_MMA(1, 0, At, B0); PG8_BAR; PG8_SCHED;
            PG8_STAGE(PG8_SB(1, 1), b3 + hstep, voffB);
            PG8_WAIT_V(6); PG8_BAR; PG8_MMA(1, 1, At, B1); PG8_BAR;
            }
        }
        if constexpr (ALIGN_EPI) { if (wr == 0) PG8_BAR; }
        if constexpr (!Epi::AFTER_DRAIN) { E(acc, cur, wr, wc, fr, fq); S.done(cur); }
        if (!has_next) break;
#pragma unroll
        for (int a = 0; a < 2; ++a)
#pragma unroll
            for (int b = 0; b < 2; ++b)
#pragma unroll
                for (int m = 0; m < 4; ++m)
#pragma unroll
                    for (int n = 0; n < 2; ++n) acc[a][b][m][n] = (f32x4){0.f, 0.f, 0.f, 0.f};
        cur = nxt; cA = nA; cB = nB; ++ui;
        if constexpr (ALIGN_EPI) { if (wr == 1) PG8_BAR; }
    }
    PG8_WAIT_V(0);
    if constexpr (!ALIGN_EPI) { if (wr == 0) PG8_BAR; }
    PG8_BAR;
#undef PG8_SA
#undef PG8_SB
#undef PG8_STAGE
#undef PG8_LDA
#undef PG8_LDB
#undef PG8_MMA
#undef PG8_WAIT_V
#undef PG8_WAIT_L
#undef PG8_BAR
#undef PG8_SCHED
}
}

#define XB_TMO      128
#define XB_XCNT(j)  (256  + 64 * (j))
#define XB_XSUB(j)  (1280 + 64 * (j))
#define XB_XGEN(j)  (2304 + 64 * (j))
#define XB_TOP      3328
#define XB_TOPGEN   3392
#define XCD_BAR_WORDS 3456
#define XB_SPIN_CAP (1u << 18)
__device__ __forceinline__ unsigned xb_ld(unsigned* p)              { return __hip_atomic_load(p, __ATOMIC_RELAXED, __HIP_MEMORY_SCOPE_AGENT); }
__device__ __forceinline__ unsigned xb_add(unsigned* p, unsigned v) { return __hip_atomic_fetch_add(p, v, __ATOMIC_RELAXED, __HIP_MEMORY_SCOPE_AGENT); }
__device__ __forceinline__ unsigned xb_xcc_id() { return (unsigned)__builtin_amdgcn_s_getreg((3 << 11) | 20) & 0xFu; }
#define XB_SPIN(cond, bar) do { unsigned _sp = 0; while (cond) { __builtin_amdgcn_s_sleep(1); \
    if ((++_sp & 255u) == 0u) { if (xb_ld(&(bar)[XB_TMO])) break; if (_sp > XB_SPIN_CAP) { atomicAdd(&(bar)[XB_TMO], 1u); break; } } } } while (0)
struct XcdBarrier { unsigned* bar; unsigned x; volatile LAS unsigned* st; };
__device__ __forceinline__ XcdBarrier xcd_barrier_post(unsigned* bar, volatile LAS unsigned* st) {
    XcdBarrier b; b.bar = bar; b.x = xb_xcc_id(); b.st = st;
    if (threadIdx.x == 0) (void)xb_add(&bar[XB_XCNT(b.x)], 1u);
    return b;
}
__device__ __forceinline__ void xcd_barrier_complete(unsigned* bar, unsigned x, unsigned& nloc, unsigned& nx) {
    const unsigned G = gridDim.x * gridDim.y * gridDim.z;
    unsigned sum, cnt, mine, sp = 0u;
    for (;;) {
        sum = 0u; cnt = 0u; mine = 0u;
#pragma unroll
        for (unsigned j = 0; j < 16; ++j) { const unsigned c = xb_ld(&bar[XB_XCNT(j)]); sum += c; cnt += (c > 0u) ? 1u : 0u; mine = (j == x) ? c : mine; }
        if (sum == G) break;
        __builtin_amdgcn_s_sleep(1);
        if ((++sp & 255u) == 0u) { if (xb_ld(&bar[XB_TMO])) break; if (sp > XB_SPIN_CAP) { atomicAdd(&bar[XB_TMO], 1u); break; } }
    }
    nloc = mine > 0u ? mine : 1u; nx = cnt > 0u ? cnt : 1u;
}
__device__ __forceinline__ void xcd_barrier(const XcdBarrier& b) {
    asm volatile("s_waitcnt vmcnt(0)" ::: "memory");
    __syncthreads();
    if (threadIdx.x == 0) {
        unsigned* bar = b.bar;
        __builtin_amdgcn_s_waitcnt(0);
        unsigned nloc = b.st[0], nx = b.st[1];
        if (nloc == 0u) { xcd_barrier_complete(bar, b.x, nloc, nx); b.st[0] = nloc; b.st[1] = nx; }
        const unsigned old = xb_add(&bar[XB_XSUB(b.x)], 1u);
        const unsigned gen = old / nloc;
        if (old + 1u == (gen + 1u) * nloc) {
            __builtin_amdgcn_fence(__ATOMIC_RELEASE, "agent");
            asm volatile("s_waitcnt vmcnt(0)" ::: "memory");
            const unsigned og = xb_add(&bar[XB_TOP], 1u);
            const unsigned tg = og / nx;
            if (og + 1u == (tg + 1u) * nx) xb_add(&bar[XB_TOPGEN], 1u);
            else XB_SPIN(xb_ld(&bar[XB_TOPGEN]) == tg, bar);
            __builtin_amdgcn_fence(__ATOMIC_ACQUIRE, "agent");
            xb_add(&bar[XB_XGEN(b.x)], 1u);
            asm volatile("s_waitcnt vmcnt(0)" ::: "memory");
        } else {
            XB_SPIN(xb_ld(&bar[XB_XGEN(b.x)]) == gen, bar);
            __builtin_amdgcn_fence(__ATOMIC_ACQUIRE, "agent");
            asm volatile("s_waitcnt vmcnt(0)" ::: "memory");
        }
    }
    __syncthreads();
}

#define LDS_WAIT() asm volatile("s_waitcnt lgkmcnt(0)" ::: "memory")
#define SBAR() __builtin_amdgcn_sched_barrier(0)
__device__ __forceinline__ float wave_sum(float v) {
#pragma unroll
    for (int o = 1; o < 64; o <<= 1) v += __shfl_xor(v, o);
    return v;
}
__device__ __forceinline__ unsigned cvtpk(float lo, float hi) { return pg8::cvt_pk_bf16(lo, hi); }
__device__ __forceinline__ float bf_lo(unsigned w) { return __uint_as_float(w << 16); }
__device__ __forceinline__ float bf_hi(unsigned w) { return __uint_as_float(w & 0xffff0000u); }

struct Frame {
    unsigned char* lds; LAS unsigned char* ldsl;
    int tid, lane, wave, vcu, G, gw, NGW;
};
#if PROBE_MASK
#define STAMP(type) do { if (blockIdx.x == 0 && F.tid == 0) { const unsigned long long now_ = __builtin_amdgcn_s_memrealtime(); volatile LAS unsigned long long* pa_ = (volatile LAS unsigned long long*)(F.ldsl + MISC_OFF + 64); pa_[type] += now_ - pa_[15]; pa_[15] = now_; } } while (0)
#else
#define STAMP(type) do { } while (0)
#endif
#define RELAUNDER() do { int t_ = threadIdx.x; asm volatile("" : "+v"(t_)); F.tid = t_; F.lane = t_ & 63; F.wave = __builtin_amdgcn_readfirstlane(t_ >> 6); F.gw = F.vcu * 8 + F.wave; } while (0)

struct CvItem { const float* src; bf16_t* dst; const float* gain; int K, N, kind, k0, n0; };
__device__ __forceinline__ int cv_rowmap(int kind, int n) {
    if (kind == 1 || kind == 2) return 256 * (n >> 7) + (kind - 1) * 128 + (n & 127);
    if (kind == 3) return n < 2560 ? n : (n < 2584 ? 5632 + (n - 2560) : (n < 5656 ? n - 24 : n));
    if (kind == 4) return 256 + n;
    return n;
}
__device__ __forceinline__ void cv_load(const CvItem& c, float (&v)[32], int lane) {
    const float* p = c.src + (size_t)(c.k0 + (lane >> 5)) * c.N + c.n0 + (lane & 31);
#pragma unroll
    for (int i = 0; i < 32; ++i) v[i] = __builtin_nontemporal_load(p + (size_t)(2 * i) * c.N);
}
__device__ __forceinline__ void cv_store(const CvItem& c, const float (&v)[32], LAS float* scr, int lane) {
#pragma unroll
    for (int i = 0; i < 32; ++i) scr[(2 * i + (lane >> 5)) * 33 + (lane & 31)] = v[i];
    LDS_WAIT(); asm volatile("" ::: "memory");
    const int cc = lane & 7;
    f32x4 ga = {1.f, 1.f, 1.f, 1.f}, gb = ga;
    if (c.gain) { ga = *(const f32x4*)(c.gain + c.k0 + 8 * cc); gb = *(const f32x4*)(c.gain + c.k0 + 8 * cc + 4); }
#pragma unroll
    for (int j = 0; j < 4; ++j) { const int n = (lane >> 3) + 8 * j; const LAS float* s = scr + (8 * cc) * 33 + n;
        u32x4 o; o.x = cvtpk(s[0 * 33] * ga.x, s[1 * 33] * ga.y); o.y = cvtpk(s[2 * 33] * ga.z, s[3 * 33] * ga.w); o.z = cvtpk(s[4 * 33] * gb.x, s[5 * 33] * gb.y); o.w = cvtpk(s[6 * 33] * gb.z, s[7 * 33] * gb.w);
        __builtin_nontemporal_store(o, (u32x4*)(c.dst + (size_t)cv_rowmap(c.kind, c.n0 + n) * c.K + c.k0 + 8 * cc)); }
    LDS_WAIT(); asm volatile("" ::: "memory");
}
__device__ __forceinline__ void prenorm_row(const float* xrow, const float* g, bf16_t* orow, float* rs, int lane) {
    const f32x4* xr = (const f32x4*)xrow + lane; f32x4 v[8]; float s = 0.f;
#pragma unroll
    for (int j = 0; j < 8; ++j) { v[j] = xr[64 * j]; s += (v[j].x * v[j].x + v[j].y * v[j].y) + (v[j].z * v[j].z + v[j].w * v[j].w); }
    s = wave_sum(s);
    (void)g; u32x2* o8 = (u32x2*)orow + lane;
#pragma unroll
    for (int j = 0; j < 8; ++j) { u32x2 w; w.x = cvtpk(v[j].x, v[j].y); w.y = cvtpk(v[j].z, v[j].w); o8[64 * j] = w; }
    if (lane < 32) rs[lane] = lane == 0 ? s : 0.f;
}
__device__ __forceinline__ float rope_inv(int i) {
    constexpr float tab[16] = {1.000000000e+00f, 4.403665960e-01f, 1.939227432e-01f, 8.539710194e-02f, 3.760603070e-02f, 1.656043902e-02f, 7.292664610e-03f, 3.211445874e-03f, 1.414213562e-03f, 6.227723788e-04f, 2.742481884e-04f, 1.207697351e-04f, 5.318296098e-05f, 2.341999971e-05f, 1.031338616e-05f, 4.541670478e-06f};
    float v = tab[0];
#pragma unroll
    for (int k = 1; k < 16; ++k) v = (i == k) ? tab[k] : v;
    return v;
}
__device__ __forceinline__ CvItem cv_decode(int it, int L) {
    const size_t wset = (size_t)(L & 1) * WSET;
    constexpr int I_G = (DM / 64) * (DFF / 32);
    constexpr int I_IN = (DM / 64) * (PROJ_COLS / 32);
    constexpr int I_O = (DM / 64) * (DM / 32);
    constexpr int I_C = (4096 / 64) * (256 / 32);
    unsigned char* ws = arg_ws() + wset; CvItem c; int r = it;
    if (r < 6 * I_G) { const int w = r / I_G; r -= w * I_G; const int ffn = w / 3, part = w % 3;
        c.gain = nullptr;
        if (part < 2) { c.src = arg_in((ffn ? 19 : 2) + part) + (size_t)L * DM * DFF; c.dst = (bf16_t*)(ws + (ffn ? WS_WGU2 : WS_WGU)); c.K = DM; c.N = DFF; c.kind = 1 + part; c.gain = arg_in(ffn ? 18 : 1) + L * DM; }
        else { c.src = arg_in(ffn ? 21 : 4) + (size_t)L * DFF * DM; c.dst = (bf16_t*)(ws + (ffn ? WS_WD2 : WS_WD)); c.K = DFF; c.N = DM; c.kind = 0; } }
    else { r -= 6 * I_G; c.gain = nullptr;
        if (r < I_IN) { c.src = arg_in(6) + (size_t)L * DM * PROJ_COLS; c.dst = (bf16_t*)(ws + WS_WIN); c.K = DM; c.N = PROJ_COLS; c.kind = 3; c.gain = arg_in(5) + L * DM; }
        else { r -= I_IN;
            if (r < I_O) { c.src = arg_in(17) + (size_t)L * DM * DM; c.dst = (bf16_t*)(ws + WS_WOUT); c.K = DM; c.N = DM; c.kind = 0; c.gain = (r / (DM / 32)) * 64 < 1024 ? arg_in(12) + L * 1024 : arg_in(16) + L * 1024 - 1024; }
            else { r -= I_O; const int which = r / I_C; r -= which * I_C;
                c.src = arg_in(10) + ((size_t)L * 2 + which) * 4096 * 256; c.dst = (bf16_t*)(ws + WS_WC1); c.K = 4096; c.N = 256; c.kind = which ? 4 : 0; } } }
    const int nblk = c.N / 32, kb = r / nblk, nb = r - kb * nblk; c.k0 = 64 * kb; c.n0 = 32 * nb;
    return c;
}
__device__ __forceinline__ void phase_convert(Frame& F, int L, int gw, int ngw) {
    LAS float* scr = (LAS float*)(F.ldsl + F.wave * 16384);
    constexpr int NITEMS = 6 * 5632 + 5664 + 2048 + 2 * 512;
    int it = gw;
    if (it < NITEMS) {
        CvItem c = cv_decode(it, L); float va[32]; cv_load(c, va, F.lane);
        for (;;) {
            const int nx = it + ngw; const bool has = nx < NITEMS; CvItem cn = c; float vb[32];
            if (has) { cn = cv_decode(nx, L); cv_load(cn, vb, F.lane); }
            cv_store(c, va, scr, F.lane);
            if (!has) break;
            c = cn; it = nx;
#pragma unroll
            for (int i = 0; i < 32; ++i) va[i] = vb[i];
        }
    }
    if (L == 0) {
        float* rc = (float*)(arg_ws() + WS_ROPE); float* rs = rc + T * 16;
        for (int idx = blockIdx.x * 512 + F.tid; idx < T * 16; idx += F.G * 512) { const int t = idx >> 4, i = idx & 15;
            const float ang = (float)t * rope_inv(i); rc[idx] = cosf(ang); rs[idx] = sinf(ang); }
    }
}
__device__ __forceinline__ void phase_prenorm(Frame& F, const float* x, const float* g, bf16_t* o, float* rs) {
    for (int m = F.gw; m < M; m += F.NGW) prenorm_row(x + (size_t)m * DM, g, o + (size_t)m * DM, rs + (size_t)m * 32, F.lane);
}

__device__ __forceinline__ float log_sigmoid_f(float x) { return x >= 0.f ? -log1pf(expf(-x)) : x - log1pf(expf(x)); }
__device__ __forceinline__ void phase_prep(Frame& F, int L) {
    unsigned char* ws = arg_ws();
    bf16_t* HID = (bf16_t*)(ws + WS_HID); float* GF = (float*)(ws + WS_GF);
    const float* rc = (const float*)(ws + WS_ROPE); const float* rs = rc + T * 16; float* LF = (float*)(ws + WS_LF);
    const int lane = F.lane, sub = lane >> 4, l16 = lane & 15;
    {
        bf16_t* CA = (bf16_t*)(ws + WS_CMPA);
        for (int r = F.gw; r < 2 * 4064; r += F.NGW) {
            const int which = r >= 4064 ? 1 : 0, rr = r - which * 4064, h = rr & 1, bc = rr >> 1, b = bc / NCMP, c = bc - b * NCMP;
            const bf16_t* src = HID + ((size_t)b * T + 16 * c) * LDP + C_KV + which * 256 + h * 128 + l16 * 8;
            const float* pe = arg_in(9) + ((size_t)(L * 2 + which) * 32) * 128 + l16 * 8;
            bf16_t* dst = CA + ((size_t)which * 4096 + rr) * 4096 + l16 * 8;
#pragma unroll
            for (int it = 0; it < 8; ++it) { const int l = 4 * it + sub;
                const u32x4 w = *(const u32x4*)(src + (size_t)l * LDP); const f32x4 p0 = *(const f32x4*)(pe + l * 128), p1 = *(const f32x4*)(pe + l * 128 + 4);
                u32x4 o; o.x = cvtpk(bf_lo(w.x) + p0.x, bf_hi(w.x) + p0.y); o.y = cvtpk(bf_lo(w.y) + p0.z, bf_hi(w.y) + p0.w);
                o.z = cvtpk(bf_lo(w.z) + p1.x, bf_hi(w.z) + p1.y); o.w = cvtpk(bf_lo(w.w) + p1.z, bf_hi(w.w) + p1.w);
                *(u32x4*)(dst + l * 128) = o; }
        }
    }
    const float* gk1 = arg_in(8) + (L * 3 + 1) * 128; const float* gk2 = arg_in(8) + (L * 3 + 2) * 128; const float* gfk = arg_in(14) + L * 128;
    int col[3]; const float* gp[3];
    col[0] = C_KV + (sub < 2 ? 512 + sub * 128 : 1024 + (sub - 2) * 128) + l16 * 8; gp[0] = sub < 2 ? gk1 : gk2;
    col[1] = C_FK + sub * 128 + l16 * 8; gp[1] = gfk; col[2] = C_FK + (4 + sub) * 128 + l16 * 8; gp[2] = gfk;
    const float fbias = (lane >= 24 && lane < 32) ? arg_in(15)[L * 8 + lane - 24] : 0.f;
    u32x4 wa[3]; float gfa = 0.f;
    int m = F.gw;
    if (m < M) {
#pragma unroll
        for (int it = 0; it < 3; ++it) wa[it] = *(const u32x4*)(HID + (size_t)m * LDP + col[it]);
        if (lane < 32) gfa = GF[(size_t)m * 32 + lane];
    }
    while (m < M) {
        const int mn = m + F.NGW; u32x4 wb[3]; float gfb = 0.f;
        if (mn < M) {
#pragma unroll
            for (int it = 0; it < 3; ++it) wb[it] = *(const u32x4*)(HID + (size_t)mn * LDP + col[it]);
            if (lane < 32) gfb = GF[(size_t)mn * 32 + lane];
        }
        __builtin_amdgcn_sched_barrier(0);
        const int t = m & (T - 1);
        bf16_t* prow = HID + (size_t)m * LDP;
#pragma unroll
        for (int it = 0; it < 3; ++it) {
            const u32x4 w = wa[it];
            float x[8] = {bf_lo(w.x), bf_hi(w.x), bf_lo(w.y), bf_hi(w.y), bf_lo(w.z), bf_hi(w.z), bf_lo(w.w), bf_hi(w.w)};
            float ss = 0.f;
#pragma unroll
            for (int e = 0; e < 8; ++e) ss += x[e] * x[e];
            ss += __shfl_xor(ss, 1); ss += __shfl_xor(ss, 2); ss += __shfl_xor(ss, 4); ss += __shfl_xor(ss, 8);
            const float r = 1.0f / sqrtf(ss * (1.0f / 128.f) + EPS);
            const f32x4 g0 = *(const f32x4*)(gp[it] + l16 * 8), g1 = *(const f32x4*)(gp[it] + l16 * 8 + 4);
            x[0] *= r * g0.x; x[1] *= r * g0.y; x[2] *= r * g0.z; x[3] *= r * g0.w; x[4] *= r * g1.x; x[5] *= r * g1.y; x[6] *= r * g1.z; x[7] *= r * g1.w;
            if (it == 0) {
                const int fi = (l16 & 1) * 8;
                const f32x4 c0 = *(const f32x4*)(rc + t * 16 + fi), c1 = *(const f32x4*)(rc + t * 16 + fi + 4);
                const f32x4 s0 = *(const f32x4*)(rs + t * 16 + fi), s1 = *(const f32x4*)(rs + t * 16 + fi + 4);
                const float cc[8] = {c0.x, c0.y, c0.z, c0.w, c1.x, c1.y, c1.z, c1.w}, sn[8] = {s0.x, s0.y, s0.z, s0.w, s1.x, s1.y, s1.z, s1.w};
#pragma unroll
                for (int e = 0; e < 8; ++e) { const float other = __shfl_xor(x[e], 2);
                    const float ro = (l16 & 2) ? (x[e] * cc[e] + other * sn[e]) : (x[e] * cc[e] - other * sn[e]);
                    if (l16 < 4) x[e] = ro; }
            }
            u32x4 o; o.x = cvtpk(x[0], x[1]); o.y = cvtpk(x[2], x[3]); o.z = cvtpk(x[4], x[5]); o.w = cvtpk(x[6], x[7]);
            *(u32x4*)(prow + col[it]) = o;
        }
        if (lane < 24) GF[(size_t)m * 32 + lane] = 1.0f / (1.0f + expf(-gfa));
        else if (lane < 32) LF[((size_t)(m >> 11) * 8 + (lane - 24)) * T + t] = log_sigmoid_f(gfa + fbias);
#pragma unroll
        for (int it = 0; it < 3; ++it) wa[it] = wb[it];
        gfa = gfb; m = mn;
    }
}

__device__ __forceinline__ void phase_scan(Frame& F) {
    if (blockIdx.x < 32) return;
    const int sw = ((int)blockIdx.x - 32) * 8 + F.wave; if (sw >= NB * 8) return;
    const int lane = F.lane;
    const f32x4* src = (const f32x4*)((const float*)(arg_ws() + WS_LF) + (size_t)sw * T + lane * 32);
    f32x4 v[8]; float s = 0.f;
#pragma unroll
    for (int i = 0; i < 8; ++i) { v[i] = src[i]; s += (v[i].x + v[i].y) + (v[i].z + v[i].w); }
    float inc = s;
#pragma unroll
    for (int o = 1; o < 64; o <<= 1) { const float tt = __shfl_up(inc, o); if (lane >= o) inc += tt; }
    float run = inc - s;
    f32x4* dst = (f32x4*)((float*)(arg_ws() + WS_CUM) + (size_t)sw * T + lane * 32);
#pragma unroll
    for (int i = 0; i < 8; ++i) { f32x4 o; run += v[i].x; o.x = run; run += v[i].y; o.y = run; run += v[i].z; o.z = run; run += v[i].w; o.w = run; dst[i] = o; }
}

__device__ __forceinline__ void phase_cmp2(Frame& F, int L) {
    unsigned char* ws = arg_ws(); const int lane = F.lane;
    const bf16_t* CH = (const bf16_t*)(ws + WS_CMPH);
    const float* rc = (const float*)(ws + WS_ROPE); const float* rs = rc + T * 16;
    const float* gk0 = arg_in(8) + (L * 3 + 0) * 128;
    for (int it = F.gw; it < 2032 + 64; it += F.NGW) {
        if (it >= 2032) {
            const int z = it - 2032, which = z >> 5, bh = z & 31;
            bf16_t* dst = (bf16_t*)(ws + (which ? WS_VC : WS_KC)) + ((size_t)bh * 128 + 127) * 128;
            *(unsigned*)(dst + 2 * lane) = 0u; continue;
        }
        const int r0 = it * 4, which = r0 >= 4064 ? 1 : 0;
        const float* w2 = arg_in(11) + (size_t)(L * 2 + which) * 256 * 128;
        LAS float* hs = (LAS float*)(F.ldsl + F.wave * 16384);
#pragma unroll
        for (int q = 0; q < 4; ++q) { const int rr = r0 - which * 4064 + q; const u32x2 w = *(const u32x2*)(CH + ((size_t)which * 4096 + rr) * 256 + 4 * lane);
            *(LAS f32x4*)(hs + q * 256 + 4 * lane) = (f32x4){bf_lo(w.x), bf_hi(w.x), bf_lo(w.y), bf_hi(w.y)}; }
        asm volatile("s_waitcnt lgkmcnt(0)" ::: "memory");
        float a[4][2] = {};
#pragma unroll 8
        for (int kk = 0; kk < 64; ++kk) {
            f32x4 hq[4];
#pragma unroll
            for (int q = 0; q < 4; ++q) hq[q] = *(const LAS f32x4*)(hs + q * 256 + 4 * kk);
#pragma unroll
            for (int j = 0; j < 4; ++j) { const f32x2 wv = *(const f32x2*)(w2 + (size_t)(kk * 4 + j) * 128 + 2 * lane);
#pragma unroll
                for (int q = 0; q < 4; ++q) { a[q][0] += hq[q][j] * wv.x; a[q][1] += hq[q][j] * wv.y; } }
        }
        asm volatile("s_waitcnt lgkmcnt(0)" ::: "memory");
#pragma unroll
        for (int q = 0; q < 4; ++q) { const int rr = r0 - which * 4064 + q, h = rr & 1, bc = rr >> 1, b = bc / NCMP, c = bc - b * NCMP;
            float y0 = a[q][0], y1 = a[q][1];
            if (which == 0) {
                const float ss = wave_sum(y0 * y0 + y1 * y1); const float r = 1.0f / sqrtf(ss * (1.0f / 128.f) + EPS);
                const f32x2 g = *(const f32x2*)(gk0 + 2 * lane); y0 *= r * g.x; y1 *= r * g.y;
                const int pos = 16 * c + 31; const int fi = 2 * (lane & 7);
                const f32x2 cc = *(const f32x2*)(rc + pos * 16 + fi), sn = *(const f32x2*)(rs + pos * 16 + fi);
                const float o0 = __shfl_xor(y0, 8), o1 = __shfl_xor(y1, 8);
                if (lane < 8) { y0 = y0 * cc.x - o0 * sn.x; y1 = y1 * cc.y - o1 * sn.y; }
                else if (lane < 16) { y0 = y0 * cc.x + o0 * sn.x; y1 = y1 * cc.y + o1 * sn.y; }
            }
            bf16_t* dst = (bf16_t*)(ws + (which ? WS_VC : WS_KC)) + ((size_t)(b * 2 + h) * 128 + c) * 128;
            *(unsigned*)(dst + 2 * lane) = cvtpk(y0, y1);
        }
    }
}

__device__ __forceinline__ void unpack8(const u32x4 w, float* x) { x[0] = bf_lo(w.x); x[1] = bf_hi(w.x); x[2] = bf_lo(w.y); x[3] = bf_hi(w.y); x[4] = bf_lo(w.z); x[5] = bf_hi(w.z); x[6] = bf_lo(w.w); x[7] = bf_hi(w.w); }
__device__ __forceinline__ void phase_outnorm(Frame& F, int L) {
    (void)L;
    unsigned char* ws = arg_ws();
    bf16_t* HN = (bf16_t*)(ws + WS_HN); const int lane = F.lane;
    const bf16_t* N0 = (const bf16_t*)(ws + WS_NSA0); const bf16_t* N1 = (const bf16_t*)(ws + WS_NSA1); const bf16_t* N2 = (const bf16_t*)(ws + WS_NSA2);
    u32x4 wa[8];
    int m = F.gw;
#define ONORM_LOAD(w, mm) do { const size_t off_ = (size_t)(mm) * 1024 + (size_t)lane * 8; \
        w[0] = *(const u32x4*)(N0 + off_); w[1] = *(const u32x4*)(N1 + off_); w[2] = *(const u32x4*)(N2 + off_); \
        w[3] = *(const u32x4*)(N0 + off_ + 512); w[4] = *(const u32x4*)(N1 + off_ + 512); w[5] = *(const u32x4*)(N2 + off_ + 512); \
        w[6] = ((const u32x4*)(HN + (size_t)(mm) * DM))[lane + 128]; w[7] = ((const u32x4*)(HN + (size_t)(mm) * DM))[lane + 192]; } while (0)
    if (m < M) ONORM_LOAD(wa, m);
    while (m < M) {
        const int mn = m + F.NGW; u32x4 wb[8];
        if (mn < M) ONORM_LOAD(wb, mn);
        __builtin_amdgcn_sched_barrier(0);
        float x[4][8]; float sa = 0.f, sb = 0.f;
#pragma unroll
        for (int j = 0; j < 4; ++j) {
            if (j < 2) { float y0[8], y1[8], y2[8]; unpack8(wa[3 * j], y0); unpack8(wa[3 * j + 1], y1); unpack8(wa[3 * j + 2], y2);
#pragma unroll
                for (int e = 0; e < 8; ++e) x[j][e] = y0[e] + y1[e] + y2[e]; }
            else unpack8(wa[4 + j], x[j]);
            float s = 0.f;
#pragma unroll
            for (int e = 0; e < 8; ++e) s += x[j][e] * x[j][e];
            if (j < 2) sa += s; else sb += s; }
        const float ra = 1.0f / sqrtf(wave_sum(sa) * (1.0f / 1024.f) + EPS), rb = 1.0f / sqrtf(wave_sum(sb) * (1.0f / 1024.f) + EPS);
        u32x4* row = (u32x4*)(HN + (size_t)m * DM) + lane;
#pragma unroll
        for (int j = 0; j < 4; ++j) { const float r = j < 2 ? ra : rb;
            u32x4 o; o.x = cvtpk(x[j][0] * r, x[j][1] * r); o.y = cvtpk(x[j][2] * r, x[j][3] * r); o.z = cvtpk(x[j][4] * r, x[j][5] * r); o.w = cvtpk(x[j][6] * r, x[j][7] * r);
            row[64 * j] = o; }
#pragma unroll
        for (int i = 0; i < 8; ++i) wa[i] = wb[i];
        m = mn;
    }
#undef ONORM_LOAD
}

namespace att {
constexpr int SHM_V = 16384, SHM_K = 16384;
constexpr int OFF_V = 0, OFF_K = 3 * SHM_V, OFF_WS = 81920, OFF_BIAS = OFF_WS + 2048, OFF_PG = 86016, OFF_SC = OFF_PG + 32768, OFF_SEL = OFF_SC + 8192, OFF_UNI = OFF_SEL + 256;
static_assert(OFF_UNI + 16 <= 131072, "attention LDS map");
typedef LAS char* lptr;
#define KSWZ(row, colB) ((row) * 256 + ((colB) ^ (((row) & 7) << 4)))
__device__ __forceinline__ int v_st(int k, int c) { const int kk = (k & ~0xC) | ((k & 4) << 1) | ((k & 8) >> 1); return ((kk >> 3) * 4 + (c >> 5)) * 512 + ((kk & 7) * 32 + (c & 31)) * 2; }
__device__ __forceinline__ int v_rd_base(int lane) { return ((lane & 3) << 3) | (((lane >> 2) & 3) << 6) | (((lane >> 4) & 1) << 5) | (((lane >> 5) & 1) << 8); }
constexpr int v_rd_off(int d0, int ks, int half) { return d0 * 512 + ks * 4096 + half * 2048; }
__device__ __forceinline__ int crow(int r, int hi) { return (r & 3) + 8 * (r >> 2) + 4 * hi; }

__device__ __forceinline__ void qkt(f32x16& p0, f32x16& p1, lptr lds, int kbuf, int r32, int hi, const bf16x8* qr) {
    p0 = f32x16{}; p1 = f32x16{};
    lptr kb[4];
#pragma unroll
    for (int dd = 0; dd < 4; ++dd) kb[dd] = lds + OFF_K + kbuf * SHM_K + KSWZ(r32, (dd * 16 + hi * 8) * 2);
    bf16x8 ka[3], kc[3];
    ka[0] = *reinterpret_cast<const LAS bf16x8*>(kb[0]); kc[0] = *reinterpret_cast<const LAS bf16x8*>(kb[0] + 32 * 256);
    ka[1] = *reinterpret_cast<const LAS bf16x8*>(kb[1]); kc[1] = *reinterpret_cast<const LAS bf16x8*>(kb[1] + 32 * 256);
#pragma unroll
    for (int d0 = 0; d0 < 8; ++d0) {
        if (d0 + 2 < 8) { lptr a = kb[(d0 + 2) & 3] + ((d0 + 2) >> 2) * 128; ka[(d0 + 2) % 3] = *reinterpret_cast<const LAS bf16x8*>(a); kc[(d0 + 2) % 3] = *reinterpret_cast<const LAS bf16x8*>(a + 32 * 256); }
        p0 = __builtin_amdgcn_mfma_f32_32x32x16_bf16(ka[d0 % 3], qr[d0], p0, 0, 0, 0);
        p1 = __builtin_amdgcn_mfma_f32_32x32x16_bf16(kc[d0 % 3], qr[d0], p1, 0, 0, 0); }
}
template <int VB>
__device__ __forceinline__ void pv_tile(f32x16* o, int vb0, bf16x8 pa0, bf16x8 pa1, bf16x8 pa2, bf16x8 pa3) {
#define TRRD(dst, off) asm volatile("ds_read_b64_tr_b16 %0, %1 offset:%2" : "=&v"(dst) : "v"(vb0), "i"(off) : "memory")
#define PV_D0(d0) do { s16x4 l0, l1, l2, l3, h0, h1, h2, h3; constexpr int b_ = VB * SHM_V + v_rd_off(d0, 0, 0); \
        TRRD(l0, b_); TRRD(h0, b_ + 2048); TRRD(l1, b_ + 4096); TRRD(h1, b_ + 6144); TRRD(l2, b_ + 8192); TRRD(h2, b_ + 10240); TRRD(l3, b_ + 12288); TRRD(h3, b_ + 14336); \
        asm volatile("s_waitcnt lgkmcnt(0)" ::: "memory"); SBAR(); \
        o[d0] = __builtin_amdgcn_mfma_f32_32x32x16_bf16(pa0, (bf16x8){l0[0], l0[1], l0[2], l0[3], h0[0], h0[1], h0[2], h0[3]}, o[d0], 0, 0, 0);   \
        o[d0] = __builtin_amdgcn_mfma_f32_32x32x16_bf16(pa1, (bf16x8){l1[0], l1[1], l1[2], l1[3], h1[0], h1[1], h1[2], h1[3]}, o[d0], 0, 0, 0);   \
        o[d0] = __builtin_amdgcn_mfma_f32_32x32x16_bf16(pa2, (bf16x8){l2[0], l2[1], l2[2], l2[3], h2[0], h2[1], h2[2], h2[3]}, o[d0], 0, 0, 0);   \
        o[d0] = __builtin_amdgcn_mfma_f32_32x32x16_bf16(pa3, (bf16x8){l3[0], l3[1], l3[2], l3[3], h3[0], h3[1], h3[2], h3[3]}, o[d0], 0, 0, 0); } while (0)
    PV_D0(0); PV_D0(1); PV_D0(2); PV_D0(3);
#undef PV_D0
#undef TRRD
}
__device__ __forceinline__ float xhalf_max(float x) { auto rr = __builtin_amdgcn_permlane32_swap(__float_as_uint(x), __float_as_uint(x), false, false); return fmaxf(__uint_as_float(rr[0]), __uint_as_float(rr[1])); }
__device__ __forceinline__ float xhalf_sum(float x) { auto rr = __builtin_amdgcn_permlane32_swap(__float_as_uint(x), __float_as_uint(x), false, false); return __uint_as_float(rr[0]) + __uint_as_float(rr[1]); }
#define PK4(P, B_, OUT) do { unsigned xa0_ = cvtpk(P[B_+0], P[B_+1]), xa1_ = cvtpk(P[B_+2], P[B_+3]);                          \
        unsigned xb0_ = cvtpk(P[B_+4], P[B_+5]), xb1_ = cvtpk(P[B_+6], P[B_+7]);                                             \
        auto xr0_ = __builtin_amdgcn_permlane32_swap(xa0_, xb0_, false, false); auto xr1_ = __builtin_amdgcn_permlane32_swap(xa1_, xb1_, false, false); \
        u32x4 xw_ = {xr0_[0], xr1_[0], xr0_[1], xr1_[1]}; OUT = *reinterpret_cast<bf16x8*>(&xw_); } while (0)
__device__ __forceinline__ void scale_rows(f32x16* o, LAS float* tab, float v, int r32, int hi) {
    if (hi == 0) tab[r32] = v;
    asm volatile("s_waitcnt lgkmcnt(0)" ::: "memory");
#pragma unroll
    for (int g4 = 0; g4 < 4; ++g4) { const f32x4 f = *(const LAS f32x4*)(tab + 8 * g4 + 4 * hi);
#pragma unroll
        for (int e = 0; e < 4; ++e)
#pragma unroll
            for (int d = 0; d < 4; ++d) o[d][4 * g4 + e] *= f[e]; }
    asm volatile("s_waitcnt lgkmcnt(0)" ::: "memory");
}
__device__ __forceinline__ void softmax_pv(f32x16& p0, f32x16& p1, f32x16* o, float& m, float& l, int vb0, LAS float* tab, int r32, int hi) {
    float pmax = p0[0];
#pragma unroll
    for (int r = 1; r < 16; ++r) pmax = fmaxf(pmax, p0[r]);
#pragma unroll
    for (int r = 0; r < 16; ++r) pmax = fmaxf(pmax, p1[r]);
    pmax = xhalf_max(pmax);
    const float mn = fmaxf(m, pmax);
    if (__any(mn > m)) {
        const float alpha = __builtin_amdgcn_exp2f(m - mn);
        l *= alpha; m = mn;
        scale_rows(o, tab, alpha, r32, hi);
    }
    float ps = 0.f;
#pragma unroll
    for (int r = 0; r < 16; ++r) { p0[r] = __builtin_amdgcn_exp2f(p0[r] - m); ps += p0[r]; }
#pragma unroll
    for (int r = 0; r < 16; ++r) { p1[r] = __builtin_amdgcn_exp2f(p1[r] - m); ps += p1[r]; }
    l += xhalf_sum(ps);
    bf16x8 pa0, pa1, pa2, pa3;
    PK4(p0, 0, pa0); PK4(p0, 8, pa1); PK4(p1, 0, pa2); PK4(p1, 8, pa3);
    SBAR();
    pv_tile<0>(o, vb0, pa0, pa1, pa2, pa3);
}
__device__ __forceinline__ void expsum_pv(f32x16& p0, f32x16& p1, f32x16* o, float& lp, int vb0) {
    float ps = 0.f;
#pragma unroll
    for (int r = 0; r < 16; ++r) { p0[r] = __builtin_amdgcn_exp2f(p0[r]); ps += p0[r]; }
#pragma unroll
    for (int r = 0; r < 16; ++r) { p1[r] = __builtin_amdgcn_exp2f(p1[r]); ps += p1[r]; }
    lp += ps;
    bf16x8 pa0, pa1, pa2, pa3;
    PK4(p0, 0, pa0); PK4(p0, 8, pa1); PK4(p1, 0, pa2); PK4(p1, 8, pa3);
    SBAR();
    pv_tile<0>(o, vb0, pa0, pa1, pa2, pa3);
}
__device__ __forceinline__ float qrow_norm(const bf16x8* qr) {
    float ss = 0.f;
#pragma unroll
    for (int d0 = 0; d0 < 8; ++d0) { const u32x4 w = *reinterpret_cast<const u32x4*>(&qr[d0]);
        ss += (bf_lo(w.x) * bf_lo(w.x) + bf_hi(w.x) * bf_hi(w.x)) + (bf_lo(w.y) * bf_lo(w.y) + bf_hi(w.y) * bf_hi(w.y)) + (bf_lo(w.z) * bf_lo(w.z) + bf_hi(w.z) * bf_hi(w.z)) + (bf_lo(w.w) * bf_lo(w.w) + bf_hi(w.w) * bf_hi(w.w)); }
    return sqrtf(xhalf_sum(ss));
}
template <bool ROPE>
__device__ __forceinline__ void load_q_norm(bf16x8* qr, const bf16_t* qp, const float* g, int hi, int t, const float* rc, const float* rs) {
    float x[8][8]; float ss = 0.f;
#pragma unroll
    for (int d0 = 0; d0 < 8; ++d0) { const u32x4 w = *(const u32x4*)(qp + d0 * 16);
        x[d0][0] = bf_lo(w.x); x[d0][1] = bf_hi(w.x); x[d0][2] = bf_lo(w.y); x[d0][3] = bf_hi(w.y); x[d0][4] = bf_lo(w.z); x[d0][5] = bf_hi(w.z); x[d0][6] = bf_lo(w.w); x[d0][7] = bf_hi(w.w);
#pragma unroll
        for (int j = 0; j < 8; ++j) ss += x[d0][j] * x[d0][j]; }
    ss = xhalf_sum(ss);
    const float r = 1.0f / sqrtf(ss * (1.0f / 128.f) + EPS);
#pragma unroll
    for (int d0 = 0; d0 < 8; ++d0) { const f32x4 ga = *(const f32x4*)(g + d0 * 16 + hi * 8), gb = *(const f32x4*)(g + d0 * 16 + hi * 8 + 4);
        x[d0][0] *= r * ga.x; x[d0][1] *= r * ga.y; x[d0][2] *= r * ga.z; x[d0][3] *= r * ga.w; x[d0][4] *= r * gb.x; x[d0][5] *= r * gb.y; x[d0][6] *= r * gb.z; x[d0][7] *= r * gb.w; }
    if (ROPE) {
        const f32x4 c0 = *(const f32x4*)(rc + t * 16 + hi * 8), c1 = *(const f32x4*)(rc + t * 16 + hi * 8 + 4), s0 = *(const f32x4*)(rs + t * 16 + hi * 8), s1 = *(const f32x4*)(rs + t * 16 + hi * 8 + 4);
        const float cc[8] = {c0.x, c0.y, c0.z, c0.w, c1.x, c1.y, c1.z, c1.w}, sn[8] = {s0.x, s0.y, s0.z, s0.w, s1.x, s1.y, s1.z, s1.w};
#pragma unroll
        for (int j = 0; j < 8; ++j) { const float x1 = x[0][j], x2 = x[1][j]; x[0][j] = x1 * cc[j] - x2 * sn[j]; x[1][j] = x2 * cc[j] + x1 * sn[j]; }
    }
#pragma unroll
    for (int d0 = 0; d0 < 8; ++d0) { u32x4 w; w.x = cvtpk(x[d0][0], x[d0][1]); w.y = cvtpk(x[d0][2], x[d0][3]); w.z = cvtpk(x[d0][4], x[d0][5]); w.w = cvtpk(x[d0][6], x[d0][7]);
        qr[d0] = *reinterpret_cast<bf16x8*>(&w); }
}
struct Stg { bf16x8 k0, k1, v0, v1; };
__device__ __forceinline__ void stg_load(Stg& s, const bf16_t* Kp, const bf16_t* Vp, size_t stride, int sr, int sc) {
    s.k0 = *(const bf16x8*)(Kp + (size_t)sr * stride + sc); s.k1 = *(const bf16x8*)(Kp + (size_t)(32 + sr) * stride + sc);
    s.v0 = *(const bf16x8*)(Vp + (size_t)sr * stride + sc); s.v1 = *(const bf16x8*)(Vp + (size_t)(32 + sr) * stride + sc);
}
__device__ __forceinline__ void stg_write(const Stg& s, lptr lds, int kbuf, int vbuf, int kws, int vst0, int vst1) {
    *(LAS bf16x8*)(lds + OFF_K + kbuf * SHM_K + kws) = s.k0; *(LAS bf16x8*)(lds + OFF_K + kbuf * SHM_K + kws + 32 * 256) = s.k1;
    *(LAS bf16x8*)(lds + OFF_V + vbuf * SHM_V + vst0) = s.v0; *(LAS bf16x8*)(lds + OFF_V + vbuf * SHM_V + vst1) = s.v1;
}
struct Dma { int k[2], v[2]; };
__device__ __forceinline__ Dma dma_offs(int wid, int lane, int stride) {
    Dma d;
#pragma unroll
    for (int i = 0; i < 2; ++i) { const int q = wid + 8 * i;
        { const int r = 4 * q + (lane >> 4), p = lane & 15; d.k[i] = r * stride + ((p ^ (r & 7)) << 3); }
        { const int st = 2 * q + (lane >> 5), kk = (st >> 2) * 8 + ((lane & 31) >> 2), c = (st & 3) * 32 + (lane & 3) * 8;
          const int k = (kk & ~0xC) | ((kk & 4) << 1) | ((kk & 8) >> 1); d.v[i] = k * stride + c; } }
    return d;
}
__device__ __forceinline__ void dma_tile2(const Dma& d, const bf16_t* Kp, const bf16_t* Vp, lptr lds, int kbuf, int vbuf, int wid) {
#pragma unroll
    for (int i = 0; i < 2; ++i) {
        __builtin_amdgcn_global_load_lds((const unsigned*)(Kp + d.k[i]), (LAS unsigned*)(lds + OFF_K + kbuf * SHM_K + (wid + 8 * i) * 1024), 16, 0, 0);
        __builtin_amdgcn_global_load_lds((const unsigned*)(Vp + d.v[i]), (LAS unsigned*)(lds + OFF_V + vbuf * SHM_V + (wid + 8 * i) * 1024), 16, 0, 0); }
}
__device__ __forceinline__ void dma_tile(const Dma& d, const bf16_t* Kp, const bf16_t* Vp, lptr lds, int buf, int wid) {
#pragma unroll
    for (int i = 0; i < 2; ++i) {
        __builtin_amdgcn_global_load_lds((const unsigned*)(Kp + d.k[i]), (LAS unsigned*)(lds + OFF_K + buf * SHM_K + (wid + 8 * i) * 1024), 16, 0, 0);
        __builtin_amdgcn_global_load_lds((const unsigned*)(Vp + d.v[i]), (LAS unsigned*)(lds + OFF_V + buf * SHM_V + (wid + 8 * i) * 1024), 16, 0, 0); }
}
#define DMA_WAIT() asm volatile("s_waitcnt vmcnt(0)" ::: "memory")
#define O_STORE(o, ftab, ROWPTR) do { _Pragma("unroll") for (int r = 0; r < 16; ++r) { const int rr_ = crow(r, hi); bf16_t* rp_ = ROWPTR(rr_); const float f_ = (ftab)[rr_]; \
        _Pragma("unroll") for (int d0 = 0; d0 < 4; ++d0) { const float v_ = o[d0][r] * f_; const float vn_ = __shfl_xor(v_, 1); \
            if ((r32 & 1) == 0) *(unsigned*)(rp_ + d0 * 32 + r32) = cvtpk(v_, vn_); } } } while (0)
struct Lanes { int tid, wid, lane, r32, hi, sr, sc, kws, vst0, vst1, vb0; };
__device__ __forceinline__ Lanes mk_lanes(const Frame& F) {
    Lanes a; a.tid = F.tid; a.wid = F.wave; a.lane = F.lane; a.r32 = a.lane & 31; a.hi = a.lane >> 5;
    a.sr = a.tid >> 4; a.sc = (a.tid & 15) * 8; a.kws = KSWZ(a.sr, a.sc * 2); a.vst0 = v_st(a.sr, a.sc); a.vst1 = v_st(32 + a.sr, a.sc);
    a.vb0 = OFF_V + v_rd_base(a.lane); return a;
}
}

__device__ __forceinline__ void fox_block(Frame& F, int L, int b, int h, int qb) {
    using namespace att;
    RELAUNDER();
    lptr lds = (lptr)F.ldsl; unsigned char* ws = arg_ws();
    const bf16_t* HID = (const bf16_t*)(ws + WS_HID); bf16_t* HN = (bf16_t*)(ws + WS_HN);
    const Lanes A = mk_lanes(F); const int tid = A.tid, wid = A.wid, r32 = A.r32, hi = A.hi;
    LAS float* tab = (LAS float*)(lds + OFF_WS) + wid * 64; LAS float* biasL = (LAS float*)(lds + OFF_BIAS);
    const int tok0 = qb * 256 + wid * 32, t = tok0 + r32;
    const float* cum = (const float*)(ws + WS_CUM) + (size_t)(b * 8 + h) * T;
    bf16x8 qr[8];
    const bf16_t* Kb = HID + (size_t)b * T * LDP + C_FK + h * 128; const bf16_t* Vb = HID + (size_t)b * T * LDP + C_FV + h * 128;
    const int ntiles = 4 * qb + 4;
    f32x16 o[4] = {}; float l = 0.f;
    const Dma D = dma_offs(wid, A.lane, LDP);
    const float NEG = -__builtin_inff();
#define FOX_TRANSFORM(P0, P1, J, SLOT) do { const LAS float* bl_ = biasL + (SLOT) * 64; \
        _Pragma("unroll") for (int g4 = 0; g4 < 4; ++g4) { const f32x4 ba = *(const LAS f32x4*)(bl_ + 8 * g4 + 4 * hi), bb = *(const LAS f32x4*)(bl_ + 32 + 8 * g4 + 4 * hi); \
            _Pragma("unroll") for (int e = 0; e < 4; ++e) { P0[4 * g4 + e] = fmaf(P0[4 * g4 + e], C2, ct2 + ba[e]); P1[4 * g4 + e] = fmaf(P1[4 * g4 + e], C2, ct2 + bb[e]); } } \
        if (64 * (J) + 63 > tok0) { const int dq_ = t - 64 * (J) - 4 * hi; \
            _Pragma("unroll") for (int r = 0; r < 16; ++r) { const int c = (r & 3) + 8 * (r >> 2); if (c > dq_) P0[r] = NEG; if (c + 32 > dq_) P1[r] = NEG; } } } while (0)
    float cb0 = 0.f, cb1 = 0.f;
    if (tid < 64) { cb0 = cum[tid]; cb1 = cum[64 + tid]; }
    __syncthreads();
    dma_tile2(D, Kb, Vb, lds, 0, 0, wid);
    dma_tile2(D, Kb + (size_t)64 * LDP, Vb + (size_t)64 * LDP, lds, 1, 1, wid);
    load_q_norm<false>(qr, HID + ((size_t)b * T + t) * LDP + C_FQ + h * 128 + hi * 8, arg_in(13) + L * 128, hi, t, nullptr, nullptr);
    const float ct2 = cum[t] * LOG2E - C2 * 12.0f * qrow_norm(qr);
    if (tid < 64) { biasL[tid] = -cb0 * LOG2E; biasL[64 + tid] = -cb1 * LOG2E; }
    asm volatile("s_waitcnt vmcnt(4)" ::: "memory"); __syncthreads();
    f32x16 pA0, pA1;
    { qkt(pA0, pA1, lds, 0, r32, hi, qr); FOX_TRANSFORM(pA0, pA1, 0, 0);
      DMA_WAIT(); __syncthreads(); }
    int vs = 1;
    for (int j = 1; j < ntiles; ++j) {
        const int vn = vs == 2 ? 0 : vs + 1, vp = vs == 0 ? 2 : vs - 1;
        if (j + 1 < ntiles) { dma_tile2(D, Kb + (size_t)(64 * (j + 1)) * LDP, Vb + (size_t)(64 * (j + 1)) * LDP, lds, (j + 1) & 1, vn, wid); if (tid < 64) biasL[vn * 64 + tid] = -cum[64 * (j + 1) + tid] * LOG2E; }
        f32x16 pB0, pB1;
        qkt(pB0, pB1, lds, j & 1, r32, hi, qr);
        float ps = 0.f;
#pragma unroll
        for (int r = 0; r < 16; ++r) { pA0[r] = __builtin_amdgcn_exp2f(pA0[r]); ps += pA0[r]; }
#pragma unroll
        for (int r = 0; r < 16; ++r) { pA1[r] = __builtin_amdgcn_exp2f(pA1[r]); ps += pA1[r]; }
        l += ps;
        bf16x8 pa0, pa1, pa2, pa3;
        PK4(pA0, 0, pa0); PK4(pA0, 8, pa1); PK4(pA1, 0, pa2); PK4(pA1, 8, pa3);
        pv_tile<0>(o, A.vb0 + vp * SHM_V, pa0, pa1, pa2, pa3);
        FOX_TRANSFORM(pB0, pB1, j, vs);
        pA0 = pB0; pA1 = pB1;
        DMA_WAIT(); __syncthreads();
        vs = vn;
    }
    {
        const int vp = vs == 0 ? 2 : vs - 1;
        float ps = 0.f;
#pragma unroll
        for (int r = 0; r < 16; ++r) { pA0[r] = __builtin_amdgcn_exp2f(pA0[r]); ps += pA0[r]; }
#pragma unroll
        for (int r = 0; r < 16; ++r) { pA1[r] = __builtin_amdgcn_exp2f(pA1[r]); ps += pA1[r]; }
        l += ps;
        bf16x8 pa0, pa1, pa2, pa3;
        PK4(pA0, 0, pa0); PK4(pA0, 8, pa1); PK4(pA1, 0, pa2); PK4(pA1, 8, pa3);
        SBAR();
        pv_tile<0>(o, A.vb0 + vp * SHM_V, pa0, pa1, pa2, pa3);
    }
#undef FOX_TRANSFORM
    l = xhalf_sum(l);
    if (hi == 0) tab[32 + r32] = 1.0f / l;
    asm volatile("s_waitcnt lgkmcnt(0)" ::: "memory");
    bf16_t* Ob = HN + ((size_t)b * T + tok0) * DM + 1024 + h * 128;
#define FOX_ROWPTR(rr) (Ob + (size_t)(rr) * DM)
    O_STORE(o, tab + 32, FOX_ROWPTR);
#undef FOX_ROWPTR
    asm volatile("s_waitcnt lgkmcnt(0)" ::: "memory");
}

#define NSA_ROWPTR(rr) (Ob + (size_t)((rr) >> 2) * 1024 + ((rr) & 3) * 128)
__device__ __forceinline__ void nsa_cmp_select(Frame& F, int L, int b, int kvh, int jq, const bf16x8* qr) {
    using namespace att;
    (void)L; RELAUNDER();
    lptr lds = (lptr)F.ldsl; unsigned char* ws = arg_ws();
    const bf16_t* HID = (const bf16_t*)(ws + WS_HID); const float* GF = (const float*)(ws + WS_GF);
    const Lanes A = mk_lanes(F); const int tid = A.tid, wid = A.wid, lane = A.lane, r32 = A.r32, hi = A.hi;
    LAS float* tab = (LAS float*)(lds + OFF_WS) + wid * 64;
    LAS float* PgL = (LAS float*)(lds + OFF_PG); LAS float* SC = (LAS float*)(lds + OFF_SC); LAS unsigned* SEL = (LAS unsigned*)(lds + OFF_SEL); LAS unsigned* UNI = (LAS unsigned*)(lds + OFF_UNI);
    const int tl = 8 * wid + (r32 >> 2), g = r32 & 3, t = 64 * jq + tl, hq = kvh * 4 + g;
    const size_t mrow = (size_t)b * T + t;
    const float NEG = -__builtin_inff();

    const float gt0 = GF[mrow * 32 + hq * 3 + 0];
    const bf16_t* KC = (const bf16_t*)(ws + WS_KC) + (size_t)(b * 2 + kvh) * 128 * 128; const bf16_t* VC = (const bf16_t*)(ws + WS_VC) + (size_t)(b * 2 + kvh) * 128 * 128;
    const bool two = jq >= 16;
    { Stg s0; stg_load(s0, KC, VC, 128, A.sr, A.sc);
      __syncthreads();
      stg_write(s0, lds, 0, 0, A.kws, A.vst0, A.vst1);
      if (two) { Stg s1; stg_load(s1, KC + 64 * 128, VC + 64 * 128, 128, A.sr, A.sc); stg_write(s1, lds, 1, 1, A.kws, A.vst0, A.vst1); }
      if (tid == 0) *UNI = 0u;
      __syncthreads(); }
    f32x16 a0, a1, b0, b1;
    qkt(a0, a1, lds, 0, r32, hi, qr);
    if (two) qkt(b0, b1, lds, 1, r32, hi, qr);
    else {
#pragma unroll
        for (int r = 0; r < 16; ++r) { b0[r] = NEG; b1[r] = NEG; } }
    const int cmax = (t - 31) >> 4; float mx = -1e30f;
#pragma unroll
    for (int r = 0; r < 16; ++r) { const int c = crow(r, hi);
        a0[r] = (c <= cmax) ? a0[r] * C2 : NEG; a1[r] = (c + 32 <= cmax) ? a1[r] * C2 : NEG; b0[r] = (c + 64 <= cmax) ? b0[r] * C2 : NEG; b1[r] = (c + 96 <= cmax) ? b1[r] * C2 : NEG;
        mx = fmaxf(mx, fmaxf(fmaxf(a0[r], a1[r]), fmaxf(b0[r], b1[r]))); }
    mx = xhalf_max(mx);
    float ps = 0.f;
#pragma unroll
    for (int r = 0; r < 16; ++r) { a0[r] = __builtin_amdgcn_exp2f(a0[r] - mx); a1[r] = __builtin_amdgcn_exp2f(a1[r] - mx); b0[r] = __builtin_amdgcn_exp2f(b0[r] - mx); b1[r] = __builtin_amdgcn_exp2f(b1[r] - mx);
        ps += (a0[r] + a1[r]) + (b0[r] + b1[r]); }
    ps = xhalf_sum(ps);
    const float inv = ps > 0.f ? 1.0f / ps : 0.f;
#pragma unroll
    for (int r = 0; r < 16; ++r) { a0[r] *= inv; a1[r] *= inv; b0[r] *= inv; b1[r] *= inv; }
#define QSUM(x) ({ float y_ = (x); y_ += __int_as_float(__builtin_amdgcn_update_dpp(0, __float_as_int(y_), 0xB1, 0xf, 0xf, false)); y_ += __int_as_float(__builtin_amdgcn_update_dpp(0, __float_as_int(y_), 0x4E, 0xf, 0xf, false)); y_; })
#pragma unroll
    for (int g4 = 0; g4 < 4; ++g4) {
        f32x4 va, vb, vc, vd;
#pragma unroll
        for (int e = 0; e < 4; ++e) { va[e] = QSUM(a0[4 * g4 + e]); vb[e] = QSUM(a1[4 * g4 + e]); vc[e] = QSUM(b0[4 * g4 + e]); vd[e] = QSUM(b1[4 * g4 + e]); }
        if (g == 0) { LAS float* pr = PgL + tl * 128 + 8 * g4 + 4 * hi; *(LAS f32x4*)pr = va; *(LAS f32x4*)(pr + 32) = vb; *(LAS f32x4*)(pr + 64) = vc; *(LAS f32x4*)(pr + 96) = vd; }
    }
#undef QSUM
    f32x16 o[4] = {};
    { bf16x8 pa0, pa1, pa2, pa3; PK4(a0, 0, pa0); PK4(a0, 8, pa1); PK4(a1, 0, pa2); PK4(a1, 8, pa3); SBAR(); pv_tile<0>(o, A.vb0, pa0, pa1, pa2, pa3); }
    if (two) { bf16x8 pa0, pa1, pa2, pa3; PK4(b0, 0, pa0); PK4(b0, 8, pa1); PK4(b1, 0, pa2); PK4(b1, 8, pa3); SBAR(); pv_tile<1>(o, A.vb0, pa0, pa1, pa2, pa3); }
    if (hi == 0) tab[32 + r32] = gt0;
    asm volatile("s_waitcnt lgkmcnt(0)" ::: "memory");
    { bf16_t* Ob = (bf16_t*)(ws + WS_NSA0) + ((size_t)b * T + 64 * jq + 8 * wid) * 1024 + kvh * 512;
      O_STORE(o, tab + 32, NSA_ROWPTR); }
    asm volatile("s_waitcnt lgkmcnt(0)" ::: "memory");
    __syncthreads();
#pragma unroll
    for (int i = 0; i < 4; ++i) { const int tok = (tid >> 5) + 16 * i, j = tid & 31; const LAS float* pr = PgL + tok * 128;
        float imp = pr[4 * j] + pr[4 * j + 1] + pr[4 * j + 2] + pr[4 * j + 3]; if (j > 0) imp += pr[4 * j - 1];
        const float scv = (j == 0 || j == jq || j == jq - 1) ? 1e9f : (j <= jq ? imp : -1e30f);
        SC[tok * 32 + j] = scv; }
    __syncthreads();
    unsigned uni_w = 0u;
#pragma unroll
    for (int i = 0; i < 4; ++i) { const int tok = (tid >> 5) + 16 * i, j = tid & 31; const float my = SC[tok * 32 + j]; int cnt = 0;
#pragma unroll
        for (int q = 0; q < 8; ++q) { const f32x4 v = *(const LAS f32x4*)(SC + tok * 32 + 4 * q);
#pragma unroll
            for (int e = 0; e < 4; ++e) { const int jj = 4 * q + e; cnt += (v[e] > my || (v[e] == my && jj < j)) ? 1 : 0; } }
        const unsigned long long bal = __ballot(cnt < 8);
        if ((lane & 31) == 0) SEL[tok] = (unsigned)(bal >> (lane & 32));
        uni_w |= (unsigned)bal | (unsigned)(bal >> 32); }
    if (lane == 0) atomicOr((unsigned*)UNI, uni_w);
    __syncthreads();
}
template <int MODE>
__device__ __forceinline__ void nsa_branch(Frame& F, int L, int b, int kvh, int jq, const bf16x8* qr) {
    using namespace att;
    (void)L; RELAUNDER();
    lptr lds = (lptr)F.ldsl; unsigned char* ws = arg_ws();
    const bf16_t* HID = (const bf16_t*)(ws + WS_HID); const float* GF = (const float*)(ws + WS_GF);
    const Lanes A = mk_lanes(F); const int wid = A.wid, r32 = A.r32, hi = A.hi;
    LAS float* tab = (LAS float*)(lds + OFF_WS) + wid * 64;
    LAS unsigned* SEL = (LAS unsigned*)(lds + OFF_SEL); LAS unsigned* UNI = (LAS unsigned*)(lds + OFF_UNI);
    const int tl = 8 * wid + (r32 >> 2), g = r32 & 3, t = 64 * jq + tl, hq = kvh * 4 + g;
    const size_t mrow = (size_t)b * T + t;
    const float NEG = -__builtin_inff();

    const float gt = GF[mrow * 32 + hq * 3 + MODE];
    const float sref = -C2 * 12.0f * qrow_norm(qr);
    const bf16_t* Kb = HID + (size_t)b * T * LDP + C_KV + MODE * 512 + kvh * 128; const bf16_t* Vb = Kb + 256;
    unsigned U, Uw = 0xFFFFFFFFu, selm = 0xFFFFFFFFu;
    if (MODE == 1) {
        const unsigned causal = (jq == 31) ? 0xFFFFFFFFu : ((2u << jq) - 1u);
        selm = SEL[tl] & causal;
        U = (unsigned)__builtin_amdgcn_readfirstlane((int)(*UNI & causal));
        unsigned uw = selm; uw |= __shfl_xor(uw, 4); uw |= __shfl_xor(uw, 8); uw |= __shfl_xor(uw, 16); uw |= __shfl_xor(uw, 32);
        Uw = (unsigned)__builtin_amdgcn_readfirstlane((int)uw);
    } else {
        const int jlo = jq >= 8 ? jq - 8 : 0;
        U = (jq == 31 ? 0xFFFFFFFFu : ((2u << jq) - 1u)) & ~((1u << jlo) - 1u);
    }
    f32x16 o[4] = {}; float l = 0.f;
#define NSA_TRANSFORM(P0, P1, J) do { const bool rowsel_ = (MODE == 1) ? (((selm >> (J)) & 1u) != 0u) : true; \
        const int dhi_ = ((J) == jq) ? (tl - 4 * hi) : 1000; const int dlo_ = (MODE == 2 && (J) == jq - 8) ? (tl - 4 * hi) : -1000; \
        _Pragma("unroll") for (int r = 0; r < 16; ++r) { const int c = (r & 3) + 8 * (r >> 2); \
            P0[r] = (rowsel_ && c <= dhi_ && c > dlo_) ? fmaf(P0[r], C2, sref) : NEG; P1[r] = (rowsel_ && c + 32 <= dhi_ && c + 32 > dlo_) ? fmaf(P1[r], C2, sref) : NEG; } } while (0)
    (void)Uw;
    unsigned rem = U; int j = __builtin_ctz(rem); rem &= rem - 1u;
    const Dma D = dma_offs(wid, A.lane, LDP);
    __syncthreads();
    dma_tile2(D, Kb + (size_t)(64 * j) * LDP, Vb + (size_t)(64 * j) * LDP, lds, 0, 0, wid);
    int jn = -1;
    if (rem) { jn = __builtin_ctz(rem); rem &= rem - 1u; dma_tile2(D, Kb + (size_t)(64 * jn) * LDP, Vb + (size_t)(64 * jn) * LDP, lds, 1, 1, wid);
               asm volatile("s_waitcnt vmcnt(4)" ::: "memory"); }
    else DMA_WAIT();
    __syncthreads();
    f32x16 pA0, pA1;
    { qkt(pA0, pA1, lds, 0, r32, hi, qr); NSA_TRANSFORM(pA0, pA1, j);
      DMA_WAIT(); __syncthreads(); }
    int vs = 1, n = 1;
    while (jn >= 0) {
        j = jn; jn = -1;
        const int vn = vs == 2 ? 0 : vs + 1, vp = vs == 0 ? 2 : vs - 1;
        if (rem) { jn = __builtin_ctz(rem); rem &= rem - 1u; dma_tile2(D, Kb + (size_t)(64 * jn) * LDP, Vb + (size_t)(64 * jn) * LDP, lds, (n + 1) & 1, vn, wid); }
        f32x16 pB0, pB1;
        qkt(pB0, pB1, lds, n & 1, r32, hi, qr);
        float ps = 0.f;
#pragma unroll
        for (int r = 0; r < 16; ++r) { pA0[r] = __builtin_amdgcn_exp2f(pA0[r]); ps += pA0[r]; }
#pragma unroll
        for (int r = 0; r < 16; ++r) { pA1[r] = __builtin_amdgcn_exp2f(pA1[r]); ps += pA1[r]; }
        l += ps;
        bf16x8 pa0, pa1, pa2, pa3;
        PK4(pA0, 0, pa0); PK4(pA0, 8, pa1); PK4(pA1, 0, pa2); PK4(pA1, 8, pa3);
        pv_tile<0>(o, A.vb0 + vp * SHM_V, pa0, pa1, pa2, pa3);
        NSA_TRANSFORM(pB0, pB1, j);
        pA0 = pB0; pA1 = pB1;
        DMA_WAIT(); __syncthreads();
        vs = vn; ++n;
    }
    {
        const int vp = vs == 0 ? 2 : vs - 1;
        float ps = 0.f;
#pragma unroll
        for (int r = 0; r < 16; ++r) { pA0[r] = __builtin_amdgcn_exp2f(pA0[r]); ps += pA0[r]; }
#pragma unroll
        for (int r = 0; r < 16; ++r) { pA1[r] = __builtin_amdgcn_exp2f(pA1[r]); ps += pA1[r]; }
        l += ps;
        bf16x8 pa0, pa1, pa2, pa3;
        PK4(pA0, 0, pa0); PK4(pA0, 8, pa1); PK4(pA1, 0, pa2); PK4(pA1, 8, pa3);
        SBAR();
        pv_tile<0>(o, A.vb0 + vp * SHM_V, pa0, pa1, pa2, pa3);
    }
#undef NSA_TRANSFORM
    l = xhalf_sum(l);
    if (hi == 0) tab[32 + r32] = gt / l;
    asm volatile("s_waitcnt lgkmcnt(0)" ::: "memory");
    { bf16_t* Ob = (bf16_t*)(ws + (MODE == 1 ? WS_NSA1 : WS_NSA2)) + ((size_t)b * T + 64 * jq + 8 * wid) * 1024 + kvh * 512;
      O_STORE(o, tab + 32, NSA_ROWPTR); }
    asm volatile("s_waitcnt lgkmcnt(0)" ::: "memory");
}
#undef NSA_ROWPTR

__device__ __forceinline__ void phase_attn(Frame& F, int L) {
    for (int it = F.vcu; it < 512; it += F.G) { const int b = it >> 5, h = (it >> 2) & 7, p = it & 3;
#if !defined(NO_FOX)
        for (int half = 0; half < 2; ++half) fox_block(F, L, b, h, half ? p : 7 - p);
#endif
    }
    STAMP(11);
    for (int rd = 0; rd * F.G < 1024; ++rd) { const int i = rd * F.G + ((rd & 1) ? (F.G - 1 - F.vcu) : F.vcu); if (i >= 1024) continue;
        const int jq = 31 - (i >> 5), rem = i & 31, b = rem >> 1, kvh = rem & 1;
#if !defined(NO_NSA)
        { using namespace att; RELAUNDER();
          const int wid_ = F.wave, r32_ = F.lane & 31, hi_ = F.lane >> 5, tl_ = 8 * wid_ + (r32_ >> 2), t_ = 64 * jq + tl_, hq_ = kvh * 4 + (r32_ & 3);
          const bf16_t* HID_ = (const bf16_t*)(arg_ws() + WS_HID); const float* rc_ = (const float*)(arg_ws() + WS_ROPE);
          bf16x8 qr[8];
          load_q_norm<true>(qr, HID_ + ((size_t)b * T + t_) * LDP + hq_ * 128 + hi_ * 8, arg_in(7) + L * 128, hi_, t_, rc_, rc_ + T * 16);
          nsa_cmp_select(F, L, b, kvh, jq, qr);
          nsa_branch<1>(F, L, b, kvh, jq, qr);
          nsa_branch<2>(F, L, b, kvh, jq, qr); }
#endif
    }
}

struct Args { const float* in[22]; float* out; unsigned char* ws; };
#define GRID_BAR() do { XcdBarrier bar_; bar_.bar = (unsigned*)(arg_ws() + WS_CTL) + CW_BAR; bar_.x = xb_xcc_id(); bar_.st = (volatile LAS unsigned*)(F.ldsl + MISC_OFF) + 8; xcd_barrier(bar_); RELAUNDER(); } while (0)
__global__ void __launch_bounds__(512, 2) mega_fwd(Args args) {
    extern __shared__ __attribute__((aligned(16))) unsigned char lds[];
    (void)args;
    Frame F;
    F.lds = lds; F.ldsl = (LAS unsigned char*)lds;
    F.tid = threadIdx.x; F.lane = F.tid & 63; F.wave = __builtin_amdgcn_readfirstlane(F.tid >> 6);
    F.G = gridDim.x; { const int bx = blockIdx.x; F.vcu = (F.G % 8 == 0) ? (bx % 8) * (F.G / 8) + bx / 8 : bx; }
    F.gw = F.vcu * 8 + F.wave; F.NGW = F.G * 8;
    for (int u = F.tid; u < (LDS_BYTES - LDSCTL_OFF) / 4; u += 512) ((LAS unsigned*)(F.ldsl + LDSCTL_OFF))[u] = 0u;
    __syncthreads();
    (void)xcd_barrier_post((unsigned*)(arg_ws() + WS_CTL) + CW_BAR, (volatile LAS unsigned*)(F.ldsl + MISC_OFF) + 8);
#if PROBE_MASK
    if (blockIdx.x == 0 && F.tid == 0) { volatile LAS unsigned long long* pa_ = (volatile LAS unsigned long long*)(F.ldsl + MISC_OFF + 64); const unsigned long long r0_ = __builtin_amdgcn_s_memrealtime(); pa_[15] = r0_; pa_[14] = r0_; pa_[13] = __builtin_amdgcn_s_memtime(); }
#endif
    for (int L = 0; L < NL; ++L) {
        for (int sb = 0; sb < 3; ++sb) {
            if (sb != 1) {
                const int first = (L == 0 && sb == 0);
                if (first) {
                    phase_convert(F, 0, F.gw, F.NGW);
                    phase_prenorm(F, arg_in(0), arg_in(1), (bf16_t*)(arg_ws() + WS_XB), (float*)(arg_ws() + WS_PS));
                    GRID_BAR(); STAMP(0);
                }
                { unsigned char* ws = arg_ws();
                  pg8::Gemm g{(const bf16_t*)(ws + WS_XB), (const bf16_t*)(ws + (size_t)(L & 1) * WSET + (sb == 0 ? WS_WGU : WS_WGU2)), M, 2 * DFF, DM}; pg8::StaticOrder S; S.init(M, 2 * DFF, F.G, (int)blockIdx.x); S.wgm = 4;
                  pg8::EpiSwiglu E{(bf16_t*)(ws + WS_HID), DFF, (const float*)(ws + WS_PS) + (size_t)(L * 3 + sb) * M * 32, (LAS float*)(F.ldsl + RL_OFF), -1}; pg8::gemm_phase<pg8::EpiSwiglu, pg8::StaticOrder, true, true>(F.ldsl, g, S, E, F.tid); }
                GRID_BAR(); STAMP(1);
                { unsigned char* ws = arg_ws();
                  const bool last = (L == NL - 1 && sb == 2);
                  pg8::Gemm g{(const bf16_t*)(ws + WS_HID), (const bf16_t*)(ws + (size_t)(L & 1) * WSET + (sb == 0 ? WS_WD : WS_WD2)), M, DM, DFF}; pg8::StaticOrder S; S.init(M, DM, F.G, (int)blockIdx.x); S.rev = 1; S.wgm = 4;
                  pg8::EpiResid E{0.5f, last ? 1 : 0, sb == 0 ? L * 3 + 1 : (L + 1) * 3}; pg8::gemm_phase<pg8::EpiResid, pg8::StaticOrder, false, true>(F.ldsl, g, S, E, F.tid); }
                GRID_BAR(); STAMP(2);
            } else {
                { unsigned char* ws = arg_ws();
                  pg8::Gemm g{(const bf16_t*)(ws + WS_XB), (const bf16_t*)(ws + (size_t)(L & 1) * WSET + WS_WIN), M, NWIN, DM}; pg8::StaticOrder S; S.init(M, NWIN, F.G, (int)blockIdx.x);
                  pg8::EpiProj E{(bf16_t*)(ws + WS_HID), LDP, (float*)(ws + WS_GF), (const float*)(ws + WS_PS) + (size_t)(L * 3 + 1) * M * 32, (LAS float*)(F.ldsl + RL_OFF), -1}; pg8::gemm_phase<pg8::EpiProj, pg8::StaticOrder, true, true>(F.ldsl, g, S, E, F.tid); }
                GRID_BAR(); STAMP(4);
                phase_prep(F, L);
                GRID_BAR(); STAMP(5);
                { unsigned char* ws = arg_ws();
                  pg8::Gemm g{(const bf16_t*)(ws + WS_CMPA), (const bf16_t*)(ws + (size_t)(L & 1) * WSET + WS_WC1), 8192, 512, 4096}; pg8::CmpOrder S{F.G, (int)blockIdx.x};
                  pg8::EpiGeluCmp E{(bf16_t*)(ws + WS_CMPH)}; pg8::gemm_phase<pg8::EpiGeluCmp, pg8::CmpOrder, true, true>(F.ldsl, g, S, E, F.tid); }
                phase_scan(F);
                if (L + 1 < NL && blockIdx.x >= 32) phase_convert(F, L + 1, ((int)blockIdx.x - 32) * 8 + F.wave, (F.G - 32) * 8);
                GRID_BAR(); STAMP(6);
                phase_cmp2(F, L);
                GRID_BAR(); STAMP(7);
                phase_attn(F, L); STAMP(12);
                GRID_BAR(); STAMP(8);
                phase_outnorm(F, L);
                GRID_BAR(); STAMP(9);
                { unsigned char* ws = arg_ws();
                  pg8::Gemm g{(const bf16_t*)(ws + WS_HN), (const bf16_t*)(ws + (size_t)(L & 1) * WSET + WS_WOUT), M, DM, DM}; pg8::StaticOrder S; S.init(M, DM, F.G, (int)blockIdx.x); S.wgm = 4;
                  pg8::EpiResid E{1.0f, 0, L * 3 + 2};
                  pg8::gemm_phase<pg8::EpiResid, pg8::StaticOrder, false, true>(F.ldsl, g, S, E, F.tid); }
                GRID_BAR(); STAMP(10);
            }
        }
    }
#if PROBE_MASK
    if (blockIdx.x == 0 && F.tid == 0) {
        volatile LAS unsigned long long* pa_ = (volatile LAS unsigned long long*)(F.ldsl + MISC_OFF + 64);
        const unsigned long long r1 = __builtin_amdgcn_s_memrealtime(), c1 = __builtin_amdgcn_s_memtime();
        unsigned long long target = 0;
        if (PROBE_MASK & 0x10000) target = (unsigned long long)((float)(c1 - pa_[13]) / (float)(r1 - pa_[14]) * 100000.0f);
        else { for (int t_ = 0; t_ < 13; ++t_) if ((PROBE_MASK >> t_) & 1) target += pa_[t_]; target *= PROBE_K; }
        while (__builtin_amdgcn_s_memrealtime() - r1 < target) __builtin_amdgcn_s_sleep(32);
    }
#endif
}

extern "C" void kernel_launch(void* const* d_in, const int* in_sizes, int n_in, void* d_out, int out_size, void* d_ws, size_t ws_size, hipStream_t stream) {
    static int grid = 0;
    if (grid == 0) {
        if (n_in != 22 || out_size != M * DM || ws_size < WS_END) { fprintf(stderr, "kernel_launch: unexpected shapes (n_in %d out %d ws %zu)\n", n_in, out_size, ws_size); grid = -1; return; }
        int dev = 0, cus = 0, per_cu = 0;
        if (hipGetDevice(&dev) != hipSuccess || hipDeviceGetAttribute(&cus, hipDeviceAttributeMultiprocessorCount, dev) != hipSuccess) { grid = -1; return; }
        if (hipFuncSetAttribute((const void*)mega_fwd, hipFuncAttributeMaxDynamicSharedMemorySize, LDS_BYTES) != hipSuccess) { fprintf(stderr, "kernel_launch: hipFuncSetAttribute failed\n"); grid = -1; return; }
        if (hipOccupancyMaxActiveBlocksPerMultiprocessor(&per_cu, (const void*)mega_fwd, 512, LDS_BYTES) != hipSuccess || per_cu < 1) fprintf(stderr, "kernel_launch: occupancy query reports %d\n", per_cu);
        (void)hipGetLastError();
        grid = cus;
    }
    if (grid < 0) return;
    (void)in_sizes;
    if (hipMemsetAsync((char*)d_ws + WS_CTL, 0, CTL_ZERO_BYTES, stream) != hipSuccess) return;
    Args a{};
    for (int i = 0; i < 22; ++i) a.in[i] = (const float*)d_in[i];
    a.out = (float*)d_out; a.ws = (unsigned char*)d_ws;
    hipLaunchKernelGGL(mega_fwd, dim3(grid), dim3(512), LDS_BYTES, stream, a);
}
```

```cpp
#include <hip/hip_runtime.h>
#include <cstdio>
#include <cstdint>

#ifndef PROBE_MASK
#define PROBE_MASK 0
#endif
#ifndef PROBE_K
#define PROBE_K 1
#endif
#define GAS __attribute__((address_space(1)))
#define LAS __attribute__((address_space(3)))
typedef unsigned short bf16_t;
typedef short bf16x8 __attribute__((ext_vector_type(8)));
typedef short s16x4 __attribute__((ext_vector_type(4)));
typedef float f32x4 __attribute__((ext_vector_type(4)));
typedef float f32x2 __attribute__((ext_vector_type(2)));
typedef float f32x16 __attribute__((ext_vector_type(16)));
typedef unsigned u32x4 __attribute__((ext_vector_type(4)));
typedef unsigned u32x2 __attribute__((ext_vector_type(2)));

constexpr int NB = 16, T = 2048, DM = 2048, M = NB * T, NL = 4, HD = 128, DFF = 5632;
constexpr int LDP = 5632;
constexpr int PROJ_COLS = 5664, NWIN = 5888;
constexpr int C_KV = 1024, C_FQ = 2560, C_FK = 3584, C_FV = 4608;
constexpr int NCMP = 127;
constexpr float EPS = 1e-6f;
constexpr float RS_SCALE = 16777216.0f, RS_INV = 1.0f / 16777216.0f / 2048.0f;
typedef unsigned long long u64_t;
constexpr float LOG2E = 1.4426950408889634f;
constexpr float C2 = 0.08838834764831845f * 1.4426950408889634f;

constexpr size_t MiB = 1u << 20;
constexpr size_t WS_CTL = 0, CTL_ZERO_BYTES = 1 * MiB;
constexpr size_t WS_ROPE = 1 * MiB;
constexpr size_t WS_CUM = 2 * MiB;
constexpr size_t WS_GF = 3 * MiB;
constexpr size_t WS_KC = 7 * MiB;
constexpr size_t WS_VC = 8 * MiB;
constexpr size_t WS_CMPH = 9 * MiB;
constexpr size_t WS_WGU = 16 * MiB;
constexpr size_t WS_WD = 60 * MiB;
constexpr size_t WS_WIN = 82 * MiB;
constexpr size_t WS_WOUT = 105 * MiB;
constexpr size_t WS_WGU2 = 113 * MiB;
constexpr size_t WS_WD2 = 157 * MiB;
constexpr size_t WS_WC1 = 179 * MiB;
constexpr size_t WS_LF = 183 * MiB;
constexpr size_t WS_CMPA = 184 * MiB;
constexpr size_t WS_HN = 248 * MiB;
constexpr size_t WS_HID = 376 * MiB;
constexpr size_t WS_NSA0 = 728 * MiB, WS_NSA1 = 792 * MiB, WS_NSA2 = 856 * MiB;
constexpr size_t WS_XB = 920 * MiB;
constexpr size_t WS_RS = 13 * MiB, RS_BYTES = (size_t)NL * 3 * M * 8;
constexpr size_t WSET = 1032 * MiB;
constexpr size_t WS_PS = 1216 * MiB;
constexpr size_t WS_END = 1216 * MiB + 48 * MiB;
constexpr int CW_BAR = 4096;

constexpr int RING_BYTES = 131072;
constexpr int LDSCTL_OFF = RING_BYTES, MISC_OFF = LDSCTL_OFF + 320;
constexpr int RL_OFF = LDSCTL_OFF + 1024;
constexpr int LDS_BYTES = 147456;

__device__ __forceinline__ unsigned long long karg(int i) {
    const __attribute__((address_space(4))) unsigned char* kp = (const __attribute__((address_space(4))) unsigned char*)__builtin_amdgcn_kernarg_segment_ptr();
    return *(const __attribute__((address_space(4))) unsigned long long volatile*)(kp + 8 * i);
}
__device__ __forceinline__ const float* arg_in(int i) { return (const float*)(const GAS float*)karg(i); }
__device__ __forceinline__ float* arg_out() { return (float*)(GAS float*)karg(22); }
__device__ __forceinline__ unsigned char* arg_ws() { return (unsigned char*)(GAS unsigned char*)karg(23); }
namespace pg8 {
#define PG8_LAS __attribute__((address_space(3)))
constexpr int BM = 256, BK = 64, HALF = 128, HTB = HALF * BK * 2, STAGE_BYTES = 8 * HTB, NXCD = 8, WGM = 8;
__host__ __device__ __forceinline__ int lds_byte(int r, int c) { const int st = (r >> 4) * 2 + (c >> 5), rr = r & 15, cc = c & 31, ob = rr * 64 + cc * 2; return st * 1024 + (ob ^ (((ob >> 9) & 1) << 5)); }
__host__ __device__ __forceinline__ void stage_rc(int b, int& R, int& C) { const int st = b / 1024, sb = b % 1024, swz = sb ^ (((sb >> 9) & 1) << 5); R = (st >> 1) * 16 + swz / 64; C = (st & 1) * 32 + (swz % 64) / 2; }
__host__ __device__ __forceinline__ int perm32(int rho) { const int n = rho >> 4, i = rho & 15; return 8 * (i >> 2) + 4 * n + (i & 3); }
struct Unit { int pm, pn; };
struct Gemm { const bf16_t* A; const bf16_t* Bt; int M, N, K; };
struct StaticOrder {
    int nM, nN, nwg, G, c, rev, wgm;
    __host__ __device__ void init(int M_, int N_, int G_, int c_) { nM = M_ / BM; nN = N_ / BM; nwg = nM * nN; G = G_; c = c_; rev = 0; wgm = WGM; }
    __host__ __device__ bool next(int i, Unit& u) const {
        const long L = (long)i * G + c; if (L >= nwg) return false;
        int wgid = (int)L; { const int q = nwg / NXCD, r = nwg % NXCD, xcd = wgid % NXCD, off = wgid / NXCD; wgid = (xcd < r ? xcd * (q + 1) : r * (q + 1) + (xcd - r) * q) + off; }
        const int nig = wgm * nN, gid = wgid / nig, fm = gid * wgm, gsz = (nM - fm) < wgm ? (nM - fm) : wgm;
        u.pm = fm + ((wgid % nig) % gsz); u.pn = (wgid % nig) / gsz; if (rev) u.pm = nM - 1 - u.pm; return true;
    }
    __device__ __forceinline__ void a_ready(const Unit&) const {}
    __device__ __forceinline__ void done(const Unit&) const {}
};
struct CmpOrder {
    int G, c;
    __device__ bool next(int i, Unit& u) const { const int L = i * G + c; if (L >= 32) return false; u.pm = L; u.pn = L >> 4; return true; }
    __device__ __forceinline__ void a_ready(const Unit&) const {}
    __device__ __forceinline__ void done(const Unit&) const {}
};
typedef float cvf32x2_t __attribute__((ext_vector_type(2)));
typedef __bf16 cvbf16x2_t __attribute__((ext_vector_type(2)));
__device__ __forceinline__ unsigned cvt_pk_bf16(float lo, float hi) { const cvf32x2_t v = {lo, hi}; const cvbf16x2_t b = __builtin_convertvector(v, cvbf16x2_t); return __builtin_bit_cast(unsigned, b); }

__device__ __forceinline__ float silu_f(float g) { return g * __builtin_amdgcn_rcpf(1.0f + __builtin_amdgcn_exp2f(-g * LOG2E)); }
struct EpiSwiglu {
    static constexpr bool PERM = true, AFTER_DRAIN = false;
    bf16_t* O; int ldc; const float* rs; PG8_LAS float* rl; mutable int cpm;
    __device__ __forceinline__ void operator()(const f32x4 (&acc)[2][2][4][2], const Unit& u, int wr, int wc, int fr, int fq) const {
        const int row0 = u.pm * BM + wr * 64 + fr, col0 = u.pn * HALF + wc * 32 + 8 * fq;
        if (u.pm != cpm) {
            const int t = (wr * 4 + wc) * 64 + fq * 16 + fr;
            if (t < 256) { const f32x4* pp = (const f32x4*)(rs + (size_t)(u.pm * BM + t) * 32); float sq = 0.f;
_Pragma("unroll") for (int i = 0; i < 8; ++i) { const f32x4 v = pp[i]; sq += (v[0] + v[1]) + (v[2] + v[3]); }
                rl[t] = 1.0f / sqrtf(sq * (1.0f / DM) + EPS); }
            cpm = u.pm;
            asm volatile("s_waitcnt lgkmcnt(0)" ::: "memory"); __builtin_amdgcn_s_barrier(); asm volatile("" ::: "memory");
        }
#pragma unroll
        for (int ai = 0; ai < 2; ++ai)
#pragma unroll
            for (int m = 0; m < 4; ++m) { bf16_t* rowp = O + (size_t)(row0 + ai * HALF + m * 16) * ldc + col0;
                const float r = rl[wr * 64 + fr + ai * HALF + m * 16];
                const f32x4 g0 = acc[ai][0][m][0] * r, g1 = acc[ai][0][m][1] * r, u0 = acc[ai][1][m][0] * r, u1 = acc[ai][1][m][1] * r;
                u32x4 w;
                w.x = cvt_pk_bf16(silu_f(g0[0]) * u0[0], silu_f(g0[1]) * u0[1]); w.y = cvt_pk_bf16(silu_f(g0[2]) * u0[2], silu_f(g0[3]) * u0[3]);
                w.z = cvt_pk_bf16(silu_f(g1[0]) * u1[0], silu_f(g1[1]) * u1[1]); w.w = cvt_pk_bf16(silu_f(g1[2]) * u1[2], silu_f(g1[3]) * u1[3]);
                __builtin_nontemporal_store(w, (u32x4*)rowp); }
    }
};
struct EpiResid {
    static constexpr bool PERM = true, AFTER_DRAIN = false;
    float scale; int final_out; int rs_idx;
    __device__ __forceinline__ void operator()(const f32x4 (&acc)[2][2][4][2], const Unit& u, int wr, int wc, int fr, int fq) const {
        const int row0 = u.pm * BM + wr * 64 + fr, col0 = u.pn * BM + wc * 32 + 8 * fq;
        constexpr int ldc = DM;
        bf16_t* xb = (bf16_t*)(arg_ws() + WS_XB); float* out = arg_out();
        float* ps = (float*)(arg_ws() + WS_PS) + (size_t)rs_idx * M * 32 + u.pn * 4 + wc;
#pragma unroll
        for (int ai = 0; ai < 2; ++ai) {
            u32x4 bs[4][2];
#pragma unroll
            for (int m = 0; m < 4; ++m) { const size_t off = (size_t)(row0 + ai * HALF + m * 16) * ldc + col0;
#pragma unroll
                for (int bj = 0; bj < 2; ++bj) bs[m][bj] = *(const u32x4*)(xb + off + bj * HALF); }
            __builtin_amdgcn_sched_barrier(0);
#pragma unroll
            for (int m = 0; m < 4; ++m) { const int row = row0 + ai * HALF + m * 16; const size_t off = (size_t)row * ldc + col0; float ss = 0.f;
#pragma unroll
                for (int bj = 0; bj < 2; ++bj) { const u32x4 b = bs[m][bj]; u32x4 w;
#pragma unroll
                    for (int n = 0; n < 2; ++n) { const f32x4 a = acc[ai][bj][m][n]; const unsigned bx = n ? b.z : b.x, by = n ? b.w : b.y;
                        const f32x4 v = {__uint_as_float(bx << 16) + a[0] * scale, __uint_as_float(bx & 0xffff0000u) + a[1] * scale, __uint_as_float(by << 16) + a[2] * scale, __uint_as_float(by & 0xffff0000u) + a[3] * scale};
                        if (final_out) *(f32x4*)(out + off + bj * HALF + 4 * n) = v;
                        else { const unsigned p0 = cvt_pk_bf16(v[0], v[1]), p1 = cvt_pk_bf16(v[2], v[3]); if (n) { w.z = p0; w.w = p1; } else { w.x = p0; w.y = p1; }
                            ss += (v[0] * v[0] + v[1] * v[1]) + (v[2] * v[2] + v[3] * v[3]); } }
                    if (!final_out) *(u32x4*)(xb + off + bj * HALF) = w; }
                if (!final_out) { ss += __shfl_xor(ss, 16); ss += __shfl_xor(ss, 32); if (fq == 0) ps[(size_t)row * 32] = ss; } }
            __builtin_amdgcn_sched_barrier(0);
        }
    }
};
struct EpiProj {
    static constexpr bool PERM = true, AFTER_DRAIN = false;
    bf16_t* O; int ldc; float* GF; const float* rs; PG8_LAS float* rl; mutable int cpm;
    __device__ __forceinline__ void operator()(const f32x4 (&acc)[2][2][4][2], const Unit& u, int wr, int wc, int fr, int fq) const {
        const int row0 = u.pm * BM + wr * 64 + fr;
        if (u.pm != cpm) {
            const int t = (wr * 4 + wc) * 64 + fq * 16 + fr;
            if (t < 256) { const f32x4* pp = (const f32x4*)(rs + (size_t)(u.pm * BM + t) * 32); float sq = 0.f;
_Pragma("unroll") for (int i = 0; i < 8; ++i) { const f32x4 v = pp[i]; sq += (v[0] + v[1]) + (v[2] + v[3]); }
                rl[t] = 1.0f / sqrtf(sq * (1.0f / DM) + EPS); }
            cpm = u.pm;
            asm volatile("s_waitcnt lgkmcnt(0)" ::: "memory"); __builtin_amdgcn_s_barrier(); asm volatile("" ::: "memory");
        }
        float rr[2][4];
#pragma unroll
        for (int ai = 0; ai < 2; ++ai)
#pragma unroll
            for (int m = 0; m < 4; ++m) rr[ai][m] = rl[wr * 64 + fr + ai * HALF + m * 16];
        if (u.pn < 22) {
            const int col0 = u.pn * BM + wc * 32 + 8 * fq;
#pragma unroll
            for (int ai = 0; ai < 2; ++ai)
#pragma unroll
                for (int m = 0; m < 4; ++m) { bf16_t* rowp = O + (size_t)(row0 + ai * HALF + m * 16) * ldc + col0; const float r = rr[ai][m];
#pragma unroll
                    for (int bj = 0; bj < 2; ++bj) { const f32x4 v0 = acc[ai][bj][m][0] * r, v1 = acc[ai][bj][m][1] * r;
                        u32x4 w; w.x = cvt_pk_bf16(v0[0], v0[1]); w.y = cvt_pk_bf16(v0[2], v0[3]); w.z = cvt_pk_bf16(v1[0], v1[1]); w.w = cvt_pk_bf16(v1[2], v1[3]);
                        __builtin_nontemporal_store(w, (u32x4*)(rowp + bj * HALF)); } }
        } else if (wc == 0) {
#pragma unroll
            for (int ai = 0; ai < 2; ++ai)
#pragma unroll
                for (int m = 0; m < 4; ++m) { float* rowp = GF + (size_t)(row0 + ai * HALF + m * 16) * 32 + 8 * fq; const float r = rr[ai][m];
                    *(f32x4*)rowp = acc[ai][0][m][0] * r; *(f32x4*)(rowp + 4) = acc[ai][0][m][1] * r; }
        }
    }
};
__device__ __forceinline__ float gelu_tanh_f(float x) {
    const float u2 = 1.5957691216057308f * (x + 0.044715f * x * x * x);
    return x * __builtin_amdgcn_rcpf(1.0f + __builtin_amdgcn_exp2f(-u2 * LOG2E));
}
struct EpiGeluCmp {
    static constexpr bool PERM = true, AFTER_DRAIN = false;
    bf16_t* O;
    __device__ __forceinline__ void operator()(const f32x4 (&acc)[2][2][4][2], const Unit& u, int wr, int wc, int fr, int fq) const {
        const int row0 = u.pm * BM + wr * 64 + fr, col0 = wc * 32 + 8 * fq;
#pragma unroll
        for (int ai = 0; ai < 2; ++ai)
#pragma unroll
            for (int m = 0; m < 4; ++m) { bf16_t* rowp = O + (size_t)(row0 + ai * HALF + m * 16) * 256 + col0;
#pragma unroll
                for (int bj = 0; bj < 2; ++bj) { const f32x4 v0 = acc[ai][bj][m][0], v1 = acc[ai][bj][m][1];
                    u32x4 w; w.x = cvt_pk_bf16(gelu_tanh_f(v0[0]), gelu_tanh_f(v0[1])); w.y = cvt_pk_bf16(gelu_tanh_f(v0[2]), gelu_tanh_f(v0[3]));
                    w.z = cvt_pk_bf16(gelu_tanh_f(v1[0]), gelu_tanh_f(v1[1])); w.w = cvt_pk_bf16(gelu_tanh_f(v1[2]), gelu_tanh_f(v1[3]));
                    *(u32x4*)(rowp + bj * HALF) = w; } }
    }
};

template <class Epi, class Sched, bool ALIGN_EPI = false, bool SP2 = false>
__device__ __forceinline__ void gemm_phase(PG8_LAS unsigned char* lds, const Gemm g, const Sched& S, const Epi& E, const int tid) {
    const int wid = __builtin_amdgcn_readfirstlane(tid >> 6), lane = tid & 63, wr = wid >> 2, wc = wid & 3, fr = lane & 15, fq = lane >> 4;
    const int K = g.K, nt = K / BK;
    unsigned voffA[2], voffB[2];
#pragma unroll
    for (int i = 0; i < 2; ++i) { int R, C; stage_rc(tid * 16 + i * 8192, R, C); const int Rb = Epi::PERM ? ((R & ~31) + perm32(R & 31)) : R;
        voffA[i] = (unsigned)(R * K + C) * 2u; voffB[i] = (unsigned)(Rb * K + C) * 2u; }
    const size_t kstep = (size_t)(BK * 2);
    const size_t hstep = (size_t)HALF * K * 2;
    const size_t tstep = 2 * hstep;
    const unsigned ldsw = (unsigned)wid * 1024u;
    const int aoff = lds_byte(wr * 64 + fr, fq * 8), boff = lds_byte(wc * 32 + fr, fq * 8);
#define PG8_SA(b, h) (((b) * 2 + (h)) * HTB)
#define PG8_SB(b, h) ((4 + (b) * 2 + (h)) * HTB)
#define PG8_STAGE(bufoff, gbase, voff) do { _Pragma("unroll") for (int _i = 0; _i < 2; ++_i) \
        __builtin_amdgcn_global_load_lds((const unsigned*)((const char*)(gbase) + (voff)[_i]), (PG8_LAS unsigned*)(lds + (bufoff) + ldsw + _i * 8192), 16, 0, 0); } while (0)
#define PG8_LDA(dst, b, h) do { _Pragma("unroll") for (int m = 0; m < 4; ++m) _Pragma("unroll") for (int k = 0; k < 2; ++k) dst[m][k] = *(const PG8_LAS bf16x8*)(lds + PG8_SA(b, h) + aoff + m * 2048 + k * 1024); } while (0)
#define PG8_LDB(dst, b, h) do { _Pragma("unroll") for (int n = 0; n < 2; ++n) _Pragma("unroll") for (int k = 0; k < 2; ++k) dst[n][k] = *(const PG8_LAS bf16x8*)(lds + PG8_SB(b, h) + boff + n * 2048 + k * 1024); } while (0)
#define PG8_MMA(ai, bj, At, Bt) do { __builtin_amdgcn_s_setprio(1); _Pragma("unroll") for (int m = 0; m < 4; ++m) _Pragma("unroll") for (int n = 0; n < 2; ++n) _Pragma("unroll") for (int k = 0; k < 2; ++k) \
        acc[ai][bj][m][n] = __builtin_amdgcn_mfma_f32_16x16x32_bf16(Bt[n][k], At[m][k], acc[ai][bj][m][n], 0, 0, 0); __builtin_amdgcn_s_setprio(0); } while (0)
#define PG8_WAIT_V(n) asm volatile("s_waitcnt vmcnt(" #n ")" ::: "memory")
#define PG8_WAIT_L(n) asm volatile("s_waitcnt lgkmcnt(" #n ")" ::: "memory")
#define PG8_BAR __builtin_amdgcn_s_barrier()
#define PG8_SCHED __builtin_amdgcn_sched_barrier(0)
    Unit cur, nxt; int ui = 0;
    if (!S.next(0, cur)) return;
    f32x4 acc[2][2][4][2];
#pragma unroll
    for (int a = 0; a < 2; ++a)
#pragma unroll
        for (int b = 0; b < 2; ++b)
#pragma unroll
            for (int m = 0; m < 4; ++m)
#pragma unroll
                for (int n = 0; n < 2; ++n) acc[a][b][m][n] = (f32x4){0.f, 0.f, 0.f, 0.f};
    bf16x8 At[4][2], B0[2][2], B1[2][2];
    const char* cA = (const char*)g.A + (size_t)cur.pm * tstep; const char* cB = (const char*)g.Bt + (size_t)cur.pn * tstep;
    S.a_ready(cur);
    if constexpr (SP2) {
        PG8_STAGE(PG8_SB(0, 0), cB, voffB); PG8_STAGE(PG8_SB(0, 1), cB + hstep, voffB); PG8_STAGE(PG8_SA(0, 0), cA, voffA); PG8_STAGE(PG8_SA(0, 1), cA + hstep, voffA);
        if (wr == 1) PG8_BAR;
        PG8_WAIT_V(2); PG8_BAR;
        PG8_STAGE(PG8_SB(1, 0), cB + kstep, voffB); PG8_STAGE(PG8_SA(1, 0), cA + kstep, voffA); PG8_STAGE(PG8_SB(1, 1), cB + hstep + kstep, voffB);
        PG8_WAIT_V(6); PG8_BAR;
    } else {
        PG8_STAGE(PG8_SB(0, 0), cB, voffB); PG8_STAGE(PG8_SA(0, 0), cA, voffA); PG8_STAGE(PG8_SB(0, 1), cB + hstep, voffB); PG8_STAGE(PG8_SA(0, 1), cA + hstep, voffA);
        if (wr == 1) PG8_BAR;
        PG8_WAIT_V(4); PG8_BAR;
        PG8_STAGE(PG8_SB(1, 0), cB + kstep, voffB); PG8_STAGE(PG8_SA(1, 0), cA + kstep, voffA); PG8_STAGE(PG8_SB(1, 1), cB + hstep + kstep, voffB);
        PG8_WAIT_V(6); PG8_BAR;
    }
    for (;;) {
        const bool has_next = S.next(ui + 1, nxt);
        const char* nA = has_next ? (const char*)g.A + (size_t)nxt.pm * tstep : cA; const char* nB = has_next ? (const char*)g.Bt + (size_t)nxt.pn * tstep : cB;
        for (int t = 0; t < nt; t += 2) {
            const bool last = (t == nt - 2);
            const char* a1 = cA + (size_t)(t + 1) * kstep;
            const char* a2 = last ? nA : cA + (size_t)(t + 2) * kstep; const char* b2 = last ? nB : cB + (size_t)(t + 2) * kstep;
            const char* a3 = a2 + kstep; const char* b3 = b2 + kstep;
            if (last && has_next) S.a_ready(nxt);
            if constexpr (SP2) {
            PG8_LDB(B0, 0, 0); PG8_LDB(B1, 0, 1); PG8_SCHED; PG8_LDA(At, 0, 0); PG8_STAGE(PG8_SA(1, 1), a1 + hstep, voffA);
            PG8_WAIT_V(8); PG8_WAIT_L(0); PG8_BAR; PG8_MMA(0, 0, At, B0); PG8_MMA(0, 1, At, B1); PG8_BAR; PG8_SCHED;
            PG8_LDA(At, 0, 1); PG8_STAGE(PG8_SB(0, 0), b2, voffB); PG8_STAGE(PG8_SB(0, 1), b2 + hstep, voffB); PG8_STAGE(PG8_SA(0, 0), a2, voffA);
            PG8_WAIT_V(8); PG8_WAIT_L(0); PG8_BAR; PG8_MMA(1, 0, At, B0); PG8_MMA(1, 1, At, B1); PG8_BAR; PG8_SCHED;
            PG8_LDB(B0, 1, 0); PG8_LDB(B1, 1, 1); PG8_SCHED; PG8_LDA(At, 1, 0); PG8_STAGE(PG8_SA(0, 1), a2 + hstep, voffA);
            PG8_WAIT_V(8); PG8_WAIT_L(0); PG8_BAR; PG8_MMA(0, 0, At, B0); PG8_MMA(0, 1, At, B1); PG8_BAR; PG8_SCHED;
            PG8_LDA(At, 1, 1); PG8_STAGE(PG8_SB(1, 0), b3, voffB); PG8_STAGE(PG8_SB(1, 1), b3 + hstep, voffB); PG8_STAGE(PG8_SA(1, 0), a3, voffA);
            PG8_WAIT_V(8); PG8_WAIT_L(0); PG8_BAR; PG8_MMA(1, 0, At, B0); PG8_MMA(1, 1, At, B1); PG8_BAR; PG8_SCHED;
            } else {
            PG8_LDB(B0, 0, 0); PG8_SCHED; PG8_LDA(At, 0, 0); PG8_STAGE(PG8_SA(1, 1), a1 + hstep, voffA);
            PG8_WAIT_L(8); PG8_BAR; PG8_WAIT_L(0); PG8_MMA(0, 0, At, B0); PG8_BAR; PG8_SCHED;
            PG8_LDB(B1, 0, 1); PG8_STAGE(PG8_SB(0, 0), b2, voffB);
            PG8_BAR; PG8_WAIT_L(0); PG8_MMA(0, 1, At, B1); PG8_BAR;
            PG8_LDA(At, 0, 1); PG8_STAGE(PG8_SA(0, 0), a2, voffA);
            PG8_BAR; PG8_WAIT_L(0); PG8_MMA(1, 0, At, B0); PG8_BAR; PG8_SCHED;
            PG8_STAGE(PG8_SB(0, 1), b2 + hstep, voffB);
            PG8_WAIT_V(6); PG8_BAR; PG8_MMA(1, 1, At, B1); PG8_BAR;
            PG8_LDB(B0, 1, 0); PG8_SCHED; PG8_LDA(At, 1, 0); PG8_STAGE(PG8_SA(0, 1), a2 + hstep, voffA);
            PG8_WAIT_L(8); PG8_BAR; PG8_WAIT_L(0); PG8_MMA(0, 0, At, B0); PG8_BAR; PG8_SCHED;
            PG8_LDB(B1, 1, 1); PG8_STAGE(PG8_SB(1, 0), b3, voffB);
            PG8_BAR; PG8_WAIT_L(0); PG8_MMA(0, 1, At, B1); PG8_BAR;
            PG8_LDA(At, 1, 1); PG8_STAGE(PG8_SA(1, 0), a3, voffA);
            PG8_BAR; PG8_WAIT_L(0); PG8_MMA(1, 0, At, B0); PG8_BAR; PG8_SCHED;
            PG8_STAGE(PG8_SB(1, 1), b3 + hstep, voffB);
            PG8_WAIT_V(6); PG8_BAR; PG8_MMA(1, 1, At, B1); PG8_BAR;
            }
        }
        if constexpr (ALIGN_EPI) { if (wr == 0) PG8_BAR; }
        if constexpr (!Epi::AFTER_DRAIN) { E(acc, cur, wr, wc, fr, fq); S.done(cur); }
        if (!has_next) break;
#pragma unroll
        for (int a = 0; a < 2; ++a)
#pragma unroll
            for (int b = 0; b < 2; ++b)
#pragma unroll
                for (int m = 0; m < 4; ++m)
#pragma unroll
                    for (int n = 0; n < 2; ++n) acc[a][b][m][n] = (f32x4){0.f, 0.f, 0.f, 0.f};
        cur = nxt; cA = nA; cB = nB; ++ui;
        if constexpr (ALIGN_EPI) { if (wr == 1) PG8_BAR; }
    }
    PG8_WAIT_V(0);
    if constexpr (!ALIGN_EPI) { if (wr == 0) PG8_BAR; }
    PG8_BAR;
#undef PG8_SA
#undef PG8_SB
#undef PG8_STAGE
#undef PG8_LDA
#undef PG8_LDB
#undef PG8_MMA
#undef PG8_WAIT_V
#undef PG8_WAIT_L
#undef PG8_BAR
#undef PG8_SCHED
}
}

#define XB_TMO      128
#define XB_XCNT(j)  (256  + 64 * (j))
#define XB_XSUB(j)  (1280 + 64 * (j))
#define XB_XGEN(j)  (2304 + 64 * (j))
#define XB_TOP      3328
#define XB_TOPGEN   3392
#define XCD_BAR_WORDS 3456
#define XB_SPIN_CAP (1u << 18)
__device__ __forceinline__ unsigned xb_ld(unsigned* p)              { return __hip_atomic_load(p, __ATOMIC_RELAXED, __HIP_MEMORY_SCOPE_AGENT); }
__device__ __forceinline__ unsigned xb_add(unsigned* p, unsigned v) { return __hip_atomic_fetch_add(p, v, __ATOMIC_RELAXED, __HIP_MEMORY_SCOPE_AGENT); }
__device__ __forceinline__ unsigned xb_xcc_id() { return (unsigned)__builtin_amdgcn_s_getreg((3 << 11) | 20) & 0xFu; }
#define XB_SPIN(cond, bar) do { unsigned _sp = 0; while (cond) { __builtin_amdgcn_s_sleep(1); \
    if ((++_sp & 255u) == 0u) { if (xb_ld(&(bar)[XB_TMO])) break; if (_sp > XB_SPIN_CAP) { atomicAdd(&(bar)[XB_TMO], 1u); break; } } } } while (0)
struct XcdBarrier { unsigned* bar; unsigned x; volatile LAS unsigned* st; };
__device__ __forceinline__ XcdBarrier xcd_barrier_post(unsigned* bar, volatile LAS unsigned* st) {
    XcdBarrier b; b.bar = bar; b.x = xb_xcc_id(); b.st = st;
    if (threadIdx.x == 0) (void)xb_add(&bar[XB_XCNT(b.x)], 1u);
    return b;
}
__device__ __forceinline__ void xcd_barrier_complete(unsigned* bar, unsigned x, unsigned& nloc, unsigned& nx) {
    const unsigned G = gridDim.x * gridDim.y * gridDim.z;
    unsigned sum, cnt, mine, sp = 0u;
    for (;;) {
        sum = 0u; cnt = 0u; mine = 0u;
#pragma unroll
        for (unsigned j = 0; j < 16; ++j) { const unsigned c = xb_ld(&bar[XB_XCNT(j)]); sum += c; cnt += (c > 0u) ? 1u : 0u; mine = (j == x) ? c : mine; }
        if (sum == G) break;
        __builtin_amdgcn_s_sleep(1);
        if ((++sp & 255u) == 0u) { if (xb_ld(&bar[XB_TMO])) break; if (sp > XB_SPIN_CAP) { atomicAdd(&bar[XB_TMO], 1u); break; } }
    }
    nloc = mine > 0u ? mine : 1u; nx = cnt > 0u ? cnt : 1u;
}
__device__ __forceinline__ void xcd_barrier(const XcdBarrier& b) {
    asm volatile("s_waitcnt vmcnt(0)" ::: "memory");
    __syncthreads();
    if (threadIdx.x == 0) {
        unsigned* bar = b.bar;
        __builtin_amdgcn_s_waitcnt(0);
        unsigned nloc = b.st[0], nx = b.st[1];
        if (nloc == 0u) { xcd_barrier_complete(bar, b.x, nloc, nx); b.st[0] = nloc; b.st[1] = nx; }
        const unsigned old = xb_add(&bar[XB_XSUB(b.x)], 1u);
        const unsigned gen = old / nloc;
        if (old + 1u == (gen + 1u) * nloc) {
            __builtin_amdgcn_fence(__ATOMIC_RELEASE, "agent");
            asm volatile("s_waitcnt vmcnt(0)" ::: "memory");
            const unsigned og = xb_add(&bar[XB_TOP], 1u);
            const unsigned tg = og / nx;
            if (og + 1u == (tg + 1u) * nx) xb_add(&bar[XB_TOPGEN], 1u);
            else XB_SPIN(xb_ld(&bar[XB_TOPGEN]) == tg, bar);
            __builtin_amdgcn_fence(__ATOMIC_ACQUIRE, "agent");
            xb_add(&bar[XB_XGEN(b.x)], 1u);
            asm volatile("s_waitcnt vmcnt(0)" ::: "memory");
        } else {
            XB_SPIN(xb_ld(&bar[XB_XGEN(b.x)]) == gen, bar);
            __builtin_amdgcn_fence(__ATOMIC_ACQUIRE, "agent");
            asm volatile("s_waitcnt vmcnt(0)" ::: "memory");
        }
    }
    __syncthreads();
}

#define LDS_WAIT() asm volatile("s_waitcnt lgkmcnt(0)" ::: "memory")
#define SBAR() __builtin_amdgcn_sched_barrier(0)
__device__ __forceinline__ float wave_sum(float v) {
#pragma unroll
    for (int o = 1; o < 64; o <<= 1) v += __shfl_xor(v, o);
    return v;
}
__device__ __forceinline__ unsigned cvtpk(float lo, float hi) { return pg8::cvt_pk_bf16(lo, hi); }
__device__ __forceinline__ float bf_lo(unsigned w) { return __uint_as_float(w << 16); }
__device__ __forceinline__ float bf_hi(unsigned w) { return __uint_as_float(w & 0xffff0000u); }

struct Frame {
    unsigned char* lds; LAS unsigned char* ldsl;
    int tid, lane, wave, vcu, G, gw, NGW;
};
#if PROBE_MASK
#define STAMP(type) do { if (blockIdx.x == 0 && F.tid == 0) { const unsigned long long now_ = __builtin_amdgcn_s_memrealtime(); volatile LAS unsigned long long* pa_ = (volatile LAS unsigned long long*)(F.ldsl + MISC_OFF + 64); pa_[type] += now_ - pa_[15]; pa_[15] = now_; } } while (0)
#else
#define STAMP(type) do { } while (0)
#endif
#define RELAUNDER() do { int t_ = threadIdx.x; asm volatile("" : "+v"(t_)); F.tid = t_; F.lane = t_ & 63; F.wave = __builtin_amdgcn_readfirstlane(t_ >> 6); F.gw = F.vcu * 8 + F.wave; } while (0)

struct CvItem { const float* src; bf16_t* dst; const float* gain; int K, N, kind, k0, n0; };
__device__ __forceinline__ int cv_rowmap(int kind, int n) {
    if (kind == 1 || kind == 2) return 256 * (n >> 7) + (kind - 1) * 128 + (n & 127);
    if (kind == 3) return n < 2560 ? n : (n < 2584 ? 5632 + (n - 2560) : (n < 5656 ? n - 24 : n));
    if (kind == 4) return 256 + n;
    return n;
}
__device__ __forceinline__ void cv_load(const CvItem& c, float (&v)[32], int lane) {
    const float* p = c.src + (size_t)(c.k0 + (lane >> 5)) * c.N + c.n0 + (lane & 31);
#pragma unroll
    for (int i = 0; i < 32; ++i) v[i] = __builtin_nontemporal_load(p + (size_t)(2 * i) * c.N);
}
__device__ __forceinline__ void cv_store(const CvItem& c, const float (&v)[32], LAS float* scr, int lane) {
#pragma unroll
    for (int i = 0; i < 32; ++i) scr[(2 * i + (lane >> 5)) * 33 + (lane & 31)] = v[i];
    LDS_WAIT(); asm volatile("" ::: "memory");
    const int cc = lane & 7;
    f32x4 ga = {1.f, 1.f, 1.f, 1.f}, gb = ga;
    if (c.gain) { ga = *(const f32x4*)(c.gain + c.k0 + 8 * cc); gb = *(const f32x4*)(c.gain + c.k0 + 8 * cc + 4); }
#pragma unroll
    for (int j = 0; j < 4; ++j) { const int n = (lane >> 3) + 8 * j; const LAS float* s = scr + (8 * cc) * 33 + n;
        u32x4 o; o.x = cvtpk(s[0 * 33] * ga.x, s[1 * 33] * ga.y); o.y = cvtpk(s[2 * 33] * ga.z, s[3 * 33] * ga.w); o.z = cvtpk(s[4 * 33] * gb.x, s[5 * 33] * gb.y); o.w = cvtpk(s[6 * 33] * gb.z, s[7 * 33] * gb.w);
        __builtin_nontemporal_store(o, (u32x4*)(c.dst + (size_t)cv_rowmap(c.kind, c.n0 + n) * c.K + c.k0 + 8 * cc)); }
    LDS_WAIT(); asm volatile("" ::: "memory");
}
__device__ __forceinline__ void prenorm_row(const float* xrow, const float* g, bf16_t* orow, float* rs, int lane) {
    const f32x4* xr = (const f32x4*)xrow + lane; f32x4 v[8]; float s = 0.f;
#pragma unroll
    for (int j = 0; j < 8; ++j) { v[j] = xr[64 * j]; s += (v[j].x * v[j].x + v[j].y * v[j].y) + (v[j].z * v[j].z + v[j].w * v[j].w); }
    s = wave_sum(s);
    (void)g; u32x2* o8 = (u32x2*)orow + lane;
#pragma unroll
    for (int j = 0; j < 8; ++j) { u32x2 w; w.x = cvtpk(v[j].x, v[j].y); w.y = cvtpk(v[j].z, v[j].w); o8[64 * j] = w; }
    if (lane < 32) rs[lane] = lane == 0 ? s : 0.f;
}
__device__ __forceinline__ float rope_inv(int i) {
    constexpr float tab[16] = {1.000000000e+00f, 4.403665960e-01f, 1.939227432e-01f, 8.539710194e-02f, 3.760603070e-02f, 1.656043902e-02f, 7.292664610e-03f, 3.211445874e-03f, 1.414213562e-03f, 6.227723788e-04f, 2.742481884e-04f, 1.207697351e-04f, 5.318296098e-05f, 2.341999971e-05f, 1.031338616e-05f, 4.541670478e-06f};
    float v = tab[0];
#pragma unroll
    for (int k = 1; k < 16; ++k) v = (i == k) ? tab[k] : v;
    return v;
}
__device__ __forceinline__ CvItem cv_decode(int it, int L) {
    const size_t wset = (size_t)(L & 1) * WSET;
    constexpr int I_G = (DM / 64) * (DFF / 32);
    constexpr int I_IN = (DM / 64) * (PROJ_COLS / 32);
    constexpr int I_O = (DM / 64) * (DM / 32);
    constexpr int I_C = (4096 / 64) * (256 / 32);
    unsigned char* ws = arg_ws() + wset; CvItem c; int r = it;
    if (r < 6 * I_G) { const int w = r / I_G; r -= w * I_G; const int ffn = w / 3, part = w % 3;
        c.gain = nullptr;
        if (part < 2) { c.src = arg_in((ffn ? 19 : 2) + part) + (size_t)L * DM * DFF; c.dst = (bf16_t*)(ws + (ffn ? WS_WGU2 : WS_WGU)); c.K = DM; c.N = DFF; c.kind = 1 + part; c.gain = arg_in(ffn ? 18 : 1) + L * DM; }
        else { c.src = arg_in(ffn ? 21 : 4) + (size_t)L * DFF * DM; c.dst = (bf16_t*)(ws + (ffn ? WS_WD2 : WS_WD)); c.K = DFF; c.N = DM; c.kind = 0; } }
    else { r -= 6 * I_G; c.gain = nullptr;
        if (r < I_IN) { c.src = arg_in(6) + (size_t)L * DM * PROJ_COLS; c.dst = (bf16_t*)(ws + WS_WIN); c.K = DM; c.N = PROJ_COLS; c.kind = 3; c.gain = arg_in(5) + L * DM; }
        else { r -= I_IN;
            if (r < I_O) { c.src = arg_in(17) + (size_t)L * DM * DM; c.dst = (bf16_t*)(ws + WS_WOUT); c.K = DM; c.N = DM; c.kind = 0; c.gain = (r / (DM / 32)) * 64 < 1024 ? arg_in(12) + L * 1024 : arg_in(16) + L * 1024 - 1024; }
            else { r -= I_O; const int which = r / I_C; r -= which * I_C;
                c.src = arg_in(10) + ((size_t)L * 2 + which) * 4096 * 256; c.dst = (bf16_t*)(ws + WS_WC1); c.K = 4096; c.N = 256; c.kind = which ? 4 : 0; } } }
    const int nblk = c.N / 32, kb = r / nblk, nb = r - kb * nblk; c.k0 = 64 * kb; c.n0 = 32 * nb;
    return c;
}
__device__ __forceinline__ void phase_convert(Frame& F, int L, int gw, int ngw) {
    LAS float* scr = (LAS float*)(F.ldsl + F.wave * 16384);
    constexpr int NITEMS = 6 * 5632 + 5664 + 2048 + 2 * 512;
    int it = gw;
    if (it < NITEMS) {
        CvItem c = cv_decode(it, L); float va[32]; cv_load(c, va, F.lane);
        for (;;) {
            const int nx = it + ngw; const bool has = nx < NITEMS; CvItem cn = c; float vb[32];
            if (has) { cn = cv_decode(nx, L); cv_load(cn, vb, F.lane); }
            cv_store(c, va, scr, F.lane);
            if (!has) break;
            c = cn; it = nx;
#pragma unroll
            for (int i = 0; i < 32; ++i) va[i] = vb[i];
        }
    }
    if (L == 0) {
        float* rc = (float*)(arg_ws() + WS_ROPE); float* rs = rc + T * 16;
        for (int idx = blockIdx.x * 512 + F.tid; idx < T * 16; idx += F.G * 512) { const int t = idx >> 4, i = idx & 15;
            const float ang = (float)t * rope_inv(i); rc[idx] = cosf(ang); rs[idx] = sinf(ang); }
    }
}
__device__ __forceinline__ void phase_prenorm(Frame& F, const float* x, const float* g, bf16_t* o, float* rs) {
    for (int m = F.gw; m < M; m += F.NGW) prenorm_row(x + (size_t)m * DM, g, o + (size_t)m * DM, rs + (size_t)m * 32, F.lane);
}

__device__ __forceinline__ float log_sigmoid_f(float x) { return x >= 0.f ? -log1pf(expf(-x)) : x - log1pf(expf(x)); }
__device__ __forceinline__ void phase_prep(Frame& F, int L) {
    unsigned char* ws = arg_ws();
    bf16_t* HID = (bf16_t*)(ws + WS_HID); float* GF = (float*)(ws + WS_GF);
    const float* rc = (const float*)(ws + WS_ROPE); const float* rs = rc + T * 16; float* LF = (float*)(ws + WS_LF);
    const int lane = F.lane, sub = lane >> 4, l16 = lane & 15;
    {
        bf16_t* CA = (bf16_t*)(ws + WS_CMPA);
        for (int r = F.gw; r < 2 * 4064; r += F.NGW) {
            const int which = r >= 4064 ? 1 : 0, rr = r - which * 4064, h = rr & 1, bc = rr >> 1, b = bc / NCMP, c = bc - b * NCMP;
            const bf16_t* src = HID + ((size_t)b * T + 16 * c) * LDP + C_KV + which * 256 + h * 128 + l16 * 8;
            const float* pe = arg_in(9) + ((size_t)(L * 2 + which) * 32) * 128 + l16 * 8;
            bf16_t* dst = CA + ((size_t)which * 4096 + rr) * 4096 + l16 * 8;
#pragma unroll
            for (int it = 0; it < 8; ++it) { const int l = 4 * it + sub;
                const u32x4 w = *(const u32x4*)(src + (size_t)l * LDP); const f32x4 p0 = *(const f32x4*)(pe + l * 128), p1 = *(const f32x4*)(pe + l * 128 + 4);
                u32x4 o; o.x = cvtpk(bf_lo(w.x) + p0.x, bf_hi(w.x) + p0.y); o.y = cvtpk(bf_lo(w.y) + p0.z, bf_hi(w.y) + p0.w);
                o.z = cvtpk(bf_lo(w.z) + p1.x, bf_hi(w.z) + p1.y); o.w = cvtpk(bf_lo(w.w) + p1.z, bf_hi(w.w) + p1.w);
                *(u32x4*)(dst + l * 128) = o; }
        }
    }
    const float* gk1 = arg_in(8) + (L * 3 + 1) * 128; const float* gk2 = arg_in(8) + (L * 3 + 2) * 128; const float* gfk = arg_in(14) + L * 128;
    int col[3]; const float* gp[3];
    col[0] = C_KV + (sub < 2 ? 512 + sub * 128 : 1024 + (sub - 2) * 128) + l16 * 8; gp[0] = sub < 2 ? gk1 : gk2;
    col[1] = C_FK + sub * 128 + l16 * 8; gp[1] = gfk; col[2] = C_FK + (4 + sub) * 128 + l16 * 8; gp[2] = gfk;
    const float fbias = (lane >= 24 && lane < 32) ? arg_in(15)[L * 8 + lane - 24] : 0.f;
    u32x4 wa[3]; float gfa = 0.f;
    int m = F.gw;
    if (m < M) {
#pragma unroll
        for (int it = 0; it < 3; ++it) wa[it] = *(const u32x4*)(HID + (size_t)m * LDP + col[it]);
        if (lane < 32) gfa = GF[(size_t)m * 32 + lane];
    }
    while (m < M) {
        const int mn = m + F.NGW; u32x4 wb[3]; float gfb = 0.f;
        if (mn < M) {
#pragma unroll
            for (int it = 0; it < 3; ++it) wb[it] = *(const u32x4*)(HID + (size_t)mn * LDP + col[it]);
            if (lane < 32) gfb = GF[(size_t)mn * 32 + lane];
        }
        __builtin_amdgcn_sched_barrier(0);
        const int t = m & (T - 1);
        bf16_t* prow = HID + (size_t)m * LDP;
#pragma unroll
        for (int it = 0; it < 3; ++it) {
            const u32x4 w = wa[it];
            float x[8] = {bf_lo(w.x), bf_hi(w.x), bf_lo(w.y), bf_hi(w.y), bf_lo(w.z), bf_hi(w.z), bf_lo(w.w), bf_hi(w.w)};
            float ss = 0.f;
#pragma unroll
            for (int e = 0; e < 8; ++e) ss += x[e] * x[e];
            ss += __shfl_xor(ss, 1); ss += __shfl_xor(ss, 2); ss += __shfl_xor(ss, 4); ss += __shfl_xor(ss, 8);
            const float r = 1.0f / sqrtf(ss * (1.0f / 128.f) + EPS);
            const f32x4 g0 = *(const f32x4*)(gp[it] + l16 * 8), g1 = *(const f32x4*)(gp[it] + l16 * 8 + 4);
            x[0] *= r * g0.x; x[1] *= r * g0.y; x[2] *= r * g0.z; x[3] *= r * g0.w; x[4] *= r * g1.x; x[5] *= r * g1.y; x[6] *= r * g1.z; x[7] *= r * g1.w;
            if (it == 0) {
                const int fi = (l16 & 1) * 8;
                const f32x4 c0 = *(const f32x4*)(rc + t * 16 + fi), c1 = *(const f32x4*)(rc + t * 16 + fi + 4);
                const f32x4 s0 = *(const f32x4*)(rs + t * 16 + fi), s1 = *(const f32x4*)(rs + t * 16 + fi + 4);
                const float cc[8] = {c0.x, c0.y, c0.z, c0.w, c1.x, c1.y, c1.z, c1.w}, sn[8] = {s0.x, s0.y, s0.z, s0.w, s1.x, s1.y, s1.z, s1.w};
#pragma unroll
                for (int e = 0; e < 8; ++e) { const float other = __shfl_xor(x[e], 2);
                    const float ro = (l16 & 2) ? (x[e] * cc[e] + other * sn[e]) : (x[e] * cc[e] - other * sn[e]);
                    if (l16 < 4) x[e] = ro; }
            }
            u32x4 o; o.x = cvtpk(x[0], x[1]); o.y = cvtpk(x[2], x[3]); o.z = cvtpk(x[4], x[5]); o.w = cvtpk(x[6], x[7]);
            *(u32x4*)(prow + col[it]) = o;
        }
        if (lane < 24) GF[(size_t)m * 32 + lane] = 1.0f / (1.0f + expf(-gfa));
        else if (lane < 32) LF[((size_t)(m >> 11) * 8 + (lane - 24)) * T + t] = log_sigmoid_f(gfa + fbias);
#pragma unroll
        for (int it = 0; it < 3; ++it) wa[it] = wb[it];
        gfa = gfb; m = mn;
    }
}

__device__ __forceinline__ void phase_scan(Frame& F) {
    if (blockIdx.x < 32) return;
    const int sw = ((int)blockIdx.x - 32) * 8 + F.wave; if (sw >= NB * 8) return;
    const int lane = F.lane;
    const f32x4* src = (const f32x4*)((const float*)(arg_ws() + WS_LF) + (size_t)sw * T + lane * 32);
    f32x4 v[8]; float s = 0.f;
#pragma unroll
    for (int i = 0; i < 8; ++i) { v[i] = src[i]; s += (v[i].x + v[i].y) + (v[i].z + v[i].w); }
    float inc = s;
#pragma unroll
    for (int o = 1; o < 64; o <<= 1) { const float tt = __shfl_up(inc, o); if (lane >= o) inc += tt; }
    float run = inc - s;
    f32x4* dst = (f32x4*)((float*)(arg_ws() + WS_CUM) + (size_t)sw * T + lane * 32);
#pragma unroll
    for (int i = 0; i < 8; ++i) { f32x4 o; run += v[i].x; o.x = run; run += v[i].y; o.y = run; run += v[i].z; o.z = run; run += v[i].w; o.w = run; dst[i] = o; }
}

__device__ __forceinline__ void phase_cmp2(Frame& F, int L) {
    unsigned char* ws = arg_ws(); const int lane = F.lane;
    const bf16_t* CH = (const bf16_t*)(ws + WS_CMPH);
    const float* rc = (const float*)(ws + WS_ROPE); const float* rs = rc + T * 16;
    const float* gk0 = arg_in(8) + (L * 3 + 0) * 128;
    for (int it = F.gw; it < 2032 + 64; it += F.NGW) {
        if (it >= 2032) {
            const int z = it - 2032, which = z >> 5, bh = z & 31;
            bf16_t* dst = (bf16_t*)(ws + (which ? WS_VC : WS_KC)) + ((size_t)bh * 128 + 127) * 128;
            *(unsigned*)(dst + 2 * lane) = 0u; continue;
        }
        const int r0 = it * 4, which = r0 >= 4064 ? 1 : 0;
        const float* w2 = arg_in(11) + (size_t)(L * 2 + which) * 256 * 128;
        LAS float* hs = (LAS float*)(F.ldsl + F.wave * 16384);
#pragma unroll
        for (int q = 0; q < 4; ++q) { const int rr = r0 - which * 4064 + q; const u32x2 w = *(const u32x2*)(CH + ((size_t)which * 4096 + rr) * 256 + 4 * lane);
            *(LAS f32x4*)(hs + q * 256 + 4 * lane) = (f32x4){bf_lo(w.x), bf_hi(w.x), bf_lo(w.y), bf_hi(w.y)}; }
        asm volatile("s_waitcnt lgkmcnt(0)" ::: "memory");
        float a[4][2] = {};
#pragma unroll 8
        for (int kk = 0; kk < 64; ++kk) {
            f32x4 hq[4];
#pragma unroll
            for (int q = 0; q < 4; ++q) hq[q] = *(const LAS f32x4*)(hs + q * 256 + 4 * kk);
#pragma unroll
            for (int j = 0; j < 4; ++j) { const f32x2 wv = *(const f32x2*)(w2 + (size_t)(kk * 4 + j) * 128 + 2 * lane);
#pragma unroll
                for (int q = 0; q < 4; ++q) { a[q][0] += hq[q][j] * wv.x; a[q][1] += hq[q][j] * wv.y; } }
        }
        asm volatile("s_waitcnt lgkmcnt(0)" ::: "memory");
#pragma unroll
        for (int q = 0; q < 4; ++q) { const int rr = r0 - which * 4064 + q, h = rr & 1, bc = rr >> 1, b = bc / NCMP, c = bc - b * NCMP;
            float y0 = a[q][0], y1 = a[q][1];
            if (which == 0) {
                const float ss = wave_sum(y0 * y0 + y1 * y1); const float r = 1.0f / sqrtf(ss * (1.0f / 128.f) + EPS);
                const f32x2 g = *(const f32x2*)(gk0 + 2 * lane); y0 *= r * g.x; y1 *= r * g.y;
                const int pos = 16 * c + 31; const int fi = 2 * (lane & 7);
                const f32x2 cc = *(const f32x2*)(rc + pos * 16 + fi), sn = *(const f32x2*)(rs + pos * 16 + fi);
                const float o0 = __shfl_xor(y0, 8), o1 = __shfl_xor(y1, 8);
                if (lane < 8) { y0 = y0 * cc.x - o0 * sn.x; y1 = y1 * cc.y - o1 * sn.y; }
                else if (lane < 16) { y0 = y0 * cc.x + o0 * sn.x; y1 = y1 * cc.y + o1 * sn.y; }
            }
            bf16_t* dst = (bf16_t*)(ws + (which ? WS_VC : WS_KC)) + ((size_t)(b * 2 + h) * 128 + c) * 128;
            *(unsigned*)(dst + 2 * lane) = cvtpk(y0, y1);
        }
    }
}

__device__ __forceinline__ void unpack8(const u32x4 w, float* x) { x[0] = bf_lo(w.x); x[1] = bf_hi(w.x); x[2] = bf_lo(w.y); x[3] = bf_hi(w.y); x[4] = bf_lo(w.z); x[5] = bf_hi(w.z); x[6] = bf_lo(w.w); x[7] = bf_hi(w.w); }
__device__ __forceinline__ void phase_outnorm(Frame& F, int L) {
    (void)L;
    unsigned char* ws = arg_ws();
    bf16_t* HN = (bf16_t*)(ws + WS_HN); const int lane = F.lane;
    const bf16_t* N0 = (const bf16_t*)(ws + WS_NSA0); const bf16_t* N1 = (const bf16_t*)(ws + WS_NSA1); const bf16_t* N2 = (const bf16_t*)(ws + WS_NSA2);
    u32x4 wa[8];
    int m = F.gw;
#define ONORM_LOAD(w, mm) do { const size_t off_ = (size_t)(mm) * 1024 + (size_t)lane * 8; \
        w[0] = *(const u32x4*)(N0 + off_); w[1] = *(const u32x4*)(N1 + off_); w[2] = *(const u32x4*)(N2 + off_); \
        w[3] = *(const u32x4*)(N0 + off_ + 512); w[4] = *(const u32x4*)(N1 + off_ + 512); w[5] = *(const u32x4*)(N2 + off_ + 512); \
        w[6] = ((const u32x4*)(HN + (size_t)(mm) * DM))[lane + 128]; w[7] = ((const u32x4*)(HN + (size_t)(mm) * DM))[lane + 192]; } while (0)
    if (m < M) ONORM_LOAD(wa, m);
    while (m < M) {
        const int mn = m + F.NGW; u32x4 wb[8];
        if (mn < M) ONORM_LOAD(wb, mn);
        __builtin_amdgcn_sched_barrier(0);
        float x[4][8]; float sa = 0.f, sb = 0.f;
#pragma unroll
        for (int j = 0; j < 4; ++j) {
            if (j < 2) { float y0[8], y1[8], y2[8]; unpack8(wa[3 * j], y0); unpack8(wa[3 * j + 1], y1); unpack8(wa[3 * j + 2], y2);
#pragma unroll
                for (int e = 0; e < 8; ++e) x[j][e] = y0[e] + y1[e] + y2[e]; }
            else unpack8(wa[4 + j], x[j]);
            float s = 0.f;
#pragma unroll
            for (int e = 0; e < 8; ++e) s += x[j][e] * x[j][e];
            if (j < 2) sa += s; else sb += s; }
        const float ra = 1.0f / sqrtf(wave_sum(sa) * (1.0f / 1024.f) + EPS), rb = 1.0f / sqrtf(wave_sum(sb) * (1.0f / 1024.f) + EPS);
        u32x4* row = (u32x4*)(HN + (size_t)m * DM) + lane;
#pragma unroll
        for (int j = 0; j < 4; ++j) { const float r = j < 2 ? ra : rb;
            u32x4 o; o.x = cvtpk(x[j][0] * r, x[j][1] * r); o.y = cvtpk(x[j][2] * r, x[j][3] * r); o.z = cvtpk(x[j][4] * r, x[j][5] * r); o.w = cvtpk(x[j][6] * r, x[j][7] * r);
            row[64 * j] = o; }
#pragma unroll
        for (int i = 0; i < 8; ++i) wa[i] = wb[i];
        m = mn;
    }
#undef ONORM_LOAD
}

namespace att {
constexpr int SHM_V = 16384, SHM_K = 16384;
constexpr int OFF_V = 0, OFF_K = 3 * SHM_V, OFF_WS = 81920, OFF_BIAS = OFF_WS + 2048, OFF_PG = 86016, OFF_SC = OFF_PG + 32768, OFF_SEL = OFF_SC + 8192, OFF_UNI = OFF_SEL + 256;
static_assert(OFF_UNI + 16 <= 131072, "attention LDS map");
typedef LAS char* lptr;
#define KSWZ(row, colB) ((row) * 256 + ((colB) ^ (((row) & 7) << 4)))
__device__ __forceinline__ int v_st(int k, int c) { const int kk = (k & ~0xC) | ((k & 4) << 1) | ((k & 8) >> 1); return ((kk >> 3) * 4 + (c >> 5)) * 512 + ((kk & 7) * 32 + (c & 31)) * 2; }
__device__ __forceinline__ int v_rd_base(int lane) { return ((lane & 3) << 3) | (((lane >> 2) & 3) << 6) | (((lane >> 4) & 1) << 5) | (((lane >> 5) & 1) << 8); }
constexpr int v_rd_off(int d0, int ks, int half) { return d0 * 512 + ks * 4096 + half * 2048; }
__device__ __forceinline__ int crow(int r, int hi) { return (r & 3) + 8 * (r >> 2) + 4 * hi; }

__device__ __forceinline__ void qkt(f32x16& p0, f32x16& p1, lptr lds, int kbuf, int r32, int hi, const bf16x8* qr) {
    p0 = f32x16{}; p1 = f32x16{};
    lptr kb[4];
#pragma unroll
    for (int dd = 0; dd < 4; ++dd) kb[dd] = lds + OFF_K + kbuf * SHM_K + KSWZ(r32, (dd * 16 + hi * 8) * 2);
    bf16x8 ka[3], kc[3];
    ka[0] = *reinterpret_cast<const LAS bf16x8*>(kb[0]); kc[0] = *reinterpret_cast<const LAS bf16x8*>(kb[0] + 32 * 256);
    ka[1] = *reinterpret_cast<const LAS bf16x8*>(kb[1]); kc[1] = *reinterpret_cast<const LAS bf16x8*>(kb[1] + 32 * 256);
#pragma unroll
    for (int d0 = 0; d0 < 8; ++d0) {
        if (d0 + 2 < 8) { lptr a = kb[(d0 + 2) & 3] + ((d0 + 2) >> 2) * 128; ka[(d0 + 2) % 3] = *reinterpret_cast<const LAS bf16x8*>(a); kc[(d0 + 2) % 3] = *reinterpret_cast<const LAS bf16x8*>(a + 32 * 256); }
        p0 = __builtin_amdgcn_mfma_f32_32x32x16_bf16(ka[d0 % 3], qr[d0], p0, 0, 0, 0);
        p1 = __builtin_amdgcn_mfma_f32_32x32x16_bf16(kc[d0 % 3], qr[d0], p1, 0, 0, 0); }
}
template <int VB>
__device__ __forceinline__ void pv_tile(f32x16* o, int vb0, bf16x8 pa0, bf16x8 pa1, bf16x8 pa2, bf16x8 pa3) {
#define TRRD(dst, off) asm volatile("ds_read_b64_tr_b16 %0, %1 offset:%2" : "=&v"(dst) : "v"(vb0), "i"(off) : "memory")
#define PV_D0(d0) do { s16x4 l0, l1, l2, l3, h0, h1, h2, h3; constexpr int b_ = VB * SHM_V + v_rd_off(d0, 0, 0); \
        TRRD(l0, b_); TRRD(h0, b_ + 2048); TRRD(l1, b_ + 4096); TRRD(h1, b_ + 6144); TRRD(l2, b_ + 8192); TRRD(h2, b_ + 10240); TRRD(l3, b_ + 12288); TRRD(h3, b_ + 14336); \
        asm volatile("s_waitcnt lgkmcnt(0)" ::: "memory"); SBAR(); \
        o[d0] = __builtin_amdgcn_mfma_f32_32x32x16_bf16(pa0, (bf16x8){l0[0], l0[1], l0[2], l0[3], h0[0], h0[1], h0[2], h0[3]}, o[d0], 0, 0, 0);   \
        o[d0] = __builtin_amdgcn_mfma_f32_32x32x16_bf16(pa1, (bf16x8){l1[0], l1[1], l1[2], l1[3], h1[0], h1[1], h1[2], h1[3]}, o[d0], 0, 0, 0);   \
        o[d0] = __builtin_amdgcn_mfma_f32_32x32x16_bf16(pa2, (bf16x8){l2[0], l2[1], l2[2], l2[3], h2[0], h2[1], h2[2], h2[3]}, o[d0], 0, 0, 0);   \
        o[d0] = __builtin_amdgcn_mfma_f32_32x32x16_bf16(pa3, (bf16x8){l3[0], l3[1], l3[2], l3[3], h3[0], h3[1], h3[2], h3[3]}, o[d0], 0, 0, 0); } while (0)
    PV_D0(0); PV_D0(1); PV_D0(2); PV_D0(3);
#undef PV_D0
#undef TRRD
}
__device__ __forceinline__ float xhalf_max(float x) { auto rr = __builtin_amdgcn_permlane32_swap(__float_as_uint(x), __float_as_uint(x), false, false); return fmaxf(__uint_as_float(rr[0]), __uint_as_float(rr[1])); }
__device__ __forceinline__ float xhalf_sum(float x) { auto rr = __builtin_amdgcn_permlane32_swap(__float_as_uint(x), __float_as_uint(x), false, false); return __uint_as_float(rr[0]) + __uint_as_float(rr[1]); }
#define PK4(P, B_, OUT) do { unsigned xa0_ = cvtpk(P[B_+0], P[B_+1]), xa1_ = cvtpk(P[B_+2], P[B_+3]);                          \
        unsigned xb0_ = cvtpk(P[B_+4], P[B_+5]), xb1_ = cvtpk(P[B_+6], P[B_+7]);                                             \
        auto xr0_ = __builtin_amdgcn_permlane32_swap(xa0_, xb0_, false, false); auto xr1_ = __builtin_amdgcn_permlane32_swap(xa1_, xb1_, false, false); \
        u32x4 xw_ = {xr0_[0], xr1_[0], xr0_[1], xr1_[1]}; OUT = *reinterpret_cast<bf16x8*>(&xw_); } while (0)
__device__ __forceinline__ void scale_rows(f32x16* o, LAS float* tab, float v, int r32, int hi) {
    if (hi == 0) tab[r32] = v;
    asm volatile("s_waitcnt lgkmcnt(0)" ::: "memory");
#pragma unroll
    for (int g4 = 0; g4 < 4; ++g4) { const f32x4 f = *(const LAS f32x4*)(tab + 8 * g4 + 4 * hi);
#pragma unroll
        for (int e = 0; e < 4; ++e)
#pragma unroll
            for (int d = 0; d < 4; ++d) o[d][4 * g4 + e] *= f[e]; }
    asm volatile("s_waitcnt lgkmcnt(0)" ::: "memory");
}
__device__ __forceinline__ void softmax_pv(f32x16& p0, f32x16& p1, f32x16* o, float& m, float& l, int vb0, LAS float* tab, int r32, int hi) {
    float pmax = p0[0];
#pragma unroll
    for (int r = 1; r < 16; ++r) pmax = fmaxf(pmax, p0[r]);
#pragma unroll
    for (int r = 0; r < 16; ++r) pmax = fmaxf(pmax, p1[r]);
    pmax = xhalf_max(pmax);
    const float mn = fmaxf(m, pmax);
    if (__any(mn > m)) {
        const float alpha = __builtin_amdgcn_exp2f(m - mn);
        l *= alpha; m = mn;
        scale_rows(o, tab, alpha, r32, hi);
    }
    float ps = 0.f;
#pragma unroll
    for (int r = 0; r < 16; ++r) { p0[r] = __builtin_amdgcn_exp2f(p0[r] - m); ps += p0[r]; }
#pragma unroll
    for (int r = 0; r < 16; ++r) { p1[r] = __builtin_amdgcn_exp2f(p1[r] - m); ps += p1[r]; }
    l += xhalf_sum(ps);
    bf16x8 pa0, pa1, pa2, pa3;
    PK4(p0, 0, pa0); PK4(p0, 8, pa1); PK4(p1, 0, pa2); PK4(p1, 8, pa3);
    SBAR();
    pv_tile<0>(o, vb0, pa0, pa1, pa2, pa3);
}
__device__ __forceinline__ void expsum_pv(f32x16& p0, f32x16& p1, f32x16* o, float& lp, int vb0) {
    float ps = 0.f;
#pragma unroll
    for (int r = 0; r < 16; ++r) { p0[r] = __builtin_amdgcn_exp2f(p0[r]); ps += p0[r]; }
#pragma unroll
    for (int r = 0; r < 16; ++r) { p1[r] = __builtin_amdgcn_exp2f(p1[r]); ps += p1[r]; }
    lp += ps;
    bf16x8 pa0, pa1, pa2, pa3;
    PK4(p0, 0, pa0); PK4(p0, 8, pa1); PK4(p1, 0, pa2); PK4(p1, 8, pa3);
    SBAR();
    pv_tile<0>(o, vb0, pa0, pa1, pa2, pa3);
}
__device__ __forceinline__ float qrow_norm(const bf16x8* qr) {
    float ss = 0.f;
#pragma unroll
    for (int d0 = 0; d0 < 8; ++d0) { const u32x4 w = *reinterpret_cast<const u32x4*>(&qr[d0]);
        ss += (bf_lo(w.x) * bf_lo(w.x) + bf_hi(w.x) * bf_hi(w.x)) + (bf_lo(w.y) * bf_lo(w.y) + bf_hi(w.y) * bf_hi(w.y)) + (bf_lo(w.z) * bf_lo(w.z) + bf_hi(w.z) * bf_hi(w.z)) + (bf_lo(w.w) * bf_lo(w.w) + bf_hi(w.w) * bf_hi(w.w)); }
    return sqrtf(xhalf_sum(ss));
}
template <bool ROPE>
__device__ __forceinline__ void load_q_norm(bf16x8* qr, const bf16_t* qp, const float* g, int hi, int t, const float* rc, const float* rs) {
    float x[8][8]; float ss = 0.f;
#pragma unroll
    for (int d0 = 0; d0 < 8; ++d0) { const u32x4 w = *(const u32x4*)(qp + d0 * 16);
        x[d0][0] = bf_lo(w.x); x[d0][1] = bf_hi(w.x); x[d0][2] = bf_lo(w.y); x[d0][3] = bf_hi(w.y); x[d0][4] = bf_lo(w.z); x[d0][5] = bf_hi(w.z); x[d0][6] = bf_lo(w.w); x[d0][7] = bf_hi(w.w);
#pragma unroll
        for (int j = 0; j < 8; ++j) ss += x[d0][j] * x[d0][j]; }
    ss = xhalf_sum(ss);
    const float r = 1.0f / sqrtf(ss * (1.0f / 128.f) + EPS);
#pragma unroll
    for (int d0 = 0; d0 < 8; ++d0) { const f32x4 ga = *(const f32x4*)(g + d0 * 16 + hi * 8), gb = *(const f32x4*)(g + d0 * 16 + hi * 8 + 4);
        x[d0][0] *= r * ga.x; x[d0][1] *= r * ga.y; x[d0][2] *= r * ga.z; x[d0][3] *= r * ga.w; x[d0][4] *= r * gb.x; x[d0][5] *= r * gb.y; x[d0][6] *= r * gb.z; x[d0][7] *= r * gb.w; }
    if (ROPE) {
        const f32x4 c0 = *(const f32x4*)(rc + t * 16 + hi * 8), c1 = *(const f32x4*)(rc + t * 16 + hi * 8 + 4), s0 = *(const f32x4*)(rs + t * 16 + hi * 8), s1 = *(const f32x4*)(rs + t * 16 + hi * 8 + 4);
        const float cc[8] = {c0.x, c0.y, c0.z, c0.w, c1.x, c1.y, c1.z, c1.w}, sn[8] = {s0.x, s0.y, s0.z, s0.w, s1.x, s1.y, s1.z, s1.w};
#pragma unroll
        for (int j = 0; j < 8; ++j) { const float x1 = x[0][j], x2 = x[1][j]; x[0][j] = x1 * cc[j] - x2 * sn[j]; x[1][j] = x2 * cc[j] + x1 * sn[j]; }
    }
#pragma unroll
    for (int d0 = 0; d0 < 8; ++d0) { u32x4 w; w.x = cvtpk(x[d0][0], x[d0][1]); w.y = cvtpk(x[d0][2], x[d0][3]); w.z = cvtpk(x[d0][4], x[d0][5]); w.w = cvtpk(x[d0][6], x[d0][7]);
        qr[d0] = *reinterpret_cast<bf16x8*>(&w); }
}
struct Stg { bf16x8 k0, k1, v0, v1; };
__device__ __forceinline__ void stg_load(Stg& s, const bf16_t* Kp, const bf16_t* Vp, size_t stride, int sr, int sc) {
    s.k0 = *(const bf16x8*)(Kp + (size_t)sr * stride + sc); s.k1 = *(const bf16x8*)(Kp + (size_t)(32 + sr) * stride + sc);
    s.v0 = *(const bf16x8*)(Vp + (size_t)sr * stride + sc); s.v1 = *(const bf16x8*)(Vp + (size_t)(32 + sr) * stride + sc);
}
__device__ __forceinline__ void stg_write(const Stg& s, lptr lds, int kbuf, int vbuf, int kws, int vst0, int vst1) {
    *(LAS bf16x8*)(lds + OFF_K + kbuf * SHM_K + kws) = s.k0; *(LAS bf16x8*)(lds + OFF_K + kbuf * SHM_K + kws + 32 * 256) = s.k1;
    *(LAS bf16x8*)(lds + OFF_V + vbuf * SHM_V + vst0) = s.v0; *(LAS bf16x8*)(lds + OFF_V + vbuf * SHM_V + vst1) = s.v1;
}
struct Dma { int k[2], v[2]; };
__device__ __forceinline__ Dma dma_offs(int wid, int lane, int stride) {
    Dma d;
#pragma unroll
    for (int i = 0; i < 2; ++i) { const int q = wid + 8 * i;
        { const int r = 4 * q + (lane >> 4), p = lane & 15; d.k[i] = r * stride + ((p ^ (r & 7)) << 3); }
        { const int st = 2 * q + (lane >> 5), kk = (st >> 2) * 8 + ((lane & 31) >> 2), c = (st & 3) * 32 + (lane & 3) * 8;
          const int k = (kk & ~0xC) | ((kk & 4) << 1) | ((kk & 8) >> 1); d.v[i] = k * stride + c; } }
    return d;
}
__device__ __forceinline__ void dma_tile2(const Dma& d, const bf16_t* Kp, const bf16_t* Vp, lptr lds, int kbuf, int vbuf, int wid) {
#pragma unroll
    for (int i = 0; i < 2; ++i) {
        __builtin_amdgcn_global_load_lds((const unsigned*)(Kp + d.k[i]), (LAS unsigned*)(lds + OFF_K + kbuf * SHM_K + (wid + 8 * i) * 1024), 16, 0, 0);
        __builtin_amdgcn_global_load_lds((const unsigned*)(Vp + d.v[i]), (LAS unsigned*)(lds + OFF_V + vbuf * SHM_V + (wid + 8 * i) * 1024), 16, 0, 0); }
}
__device__ __forceinline__ void dma_tile(const Dma& d, const bf16_t* Kp, const bf16_t* Vp, lptr lds, int buf, int wid) {
#pragma unroll
    for (int i = 0; i < 2; ++i) {
        __builtin_amdgcn_global_load_lds((const unsigned*)(Kp + d.k[i]), (LAS unsigned*)(lds + OFF_K + buf * SHM_K + (wid + 8 * i) * 1024), 16, 0, 0);
        __builtin_amdgcn_global_load_lds((const unsigned*)(Vp + d.v[i]), (LAS unsigned*)(lds + OFF_V + buf * SHM_V + (wid + 8 * i) * 1024), 16, 0, 0); }
}
#define DMA_WAIT() asm volatile("s_waitcnt vmcnt(0)" ::: "memory")
#define O_STORE(o, ftab, ROWPTR) do { _Pragma("unroll") for (int r = 0; r < 16; ++r) { const int rr_ = crow(r, hi); bf16_t* rp_ = ROWPTR(rr_); const float f_ = (ftab)[rr_]; \
        _Pragma("unroll") for (int d0 = 0; d0 < 4; ++d0) { const float v_ = o[d0][r] * f_; const float vn_ = __shfl_xor(v_, 1); \
            if ((r32 & 1) == 0) *(unsigned*)(rp_ + d0 * 32 + r32) = cvtpk(v_, vn_); } } } while (0)
struct Lanes { int tid, wid, lane, r32, hi, sr, sc, kws, vst0, vst1, vb0; };
__device__ __forceinline__ Lanes mk_lanes(const Frame& F) {
    Lanes a; a.tid = F.tid; a.wid = F.wave; a.lane = F.lane; a.r32 = a.lane & 31; a.hi = a.lane >> 5;
    a.sr = a.tid >> 4; a.sc = (a.tid & 15) * 8; a.kws = KSWZ(a.sr, a.sc * 2); a.vst0 = v_st(a.sr, a.sc); a.vst1 = v_st(32 + a.sr, a.sc);
    a.vb0 = OFF_V + v_rd_base(a.lane); return a;
}
}

__device__ __forceinline__ void fox_block(Frame& F, int L, int b, int h, int qb) {
    using namespace att;
    RELAUNDER();
    lptr lds = (lptr)F.ldsl; unsigned char* ws = arg_ws();
    const bf16_t* HID = (const bf16_t*)(ws + WS_HID); bf16_t* HN = (bf16_t*)(ws + WS_HN);
    const Lanes A = mk_lanes(F); const int tid = A.tid, wid = A.wid, r32 = A.r32, hi = A.hi;
    LAS float* tab = (LAS float*)(lds + OFF_WS) + wid * 64; LAS float* biasL = (LAS float*)(lds + OFF_BIAS);
    const int tok0 = qb * 256 + wid * 32, t = tok0 + r32;
    const float* cum = (const float*)(ws + WS_CUM) + (size_t)(b * 8 + h) * T;
    bf16x8 qr[8];
    const bf16_t* Kb = HID + (size_t)b * T * LDP + C_FK + h * 128; const bf16_t* Vb = HID + (size_t)b * T * LDP + C_FV + h * 128;
    const int ntiles = 4 * qb + 4;
    f32x16 o[4] = {}; float l = 0.f;
    const Dma D = dma_offs(wid, A.lane, LDP);
    const float NEG = -__builtin_inff();
#define FOX_TRANSFORM(P0, P1, J, SLOT) do { const LAS float* bl_ = biasL + (SLOT) * 64; \
        _Pragma("unroll") for (int g4 = 0; g4 < 4; ++g4) { const f32x4 ba = *(const LAS f32x4*)(bl_ + 8 * g4 + 4 * hi), bb = *(const LAS f32x4*)(bl_ + 32 + 8 * g4 + 4 * hi); \
            _Pragma("unroll") for (int e = 0; e < 4; ++e) { P0[4 * g4 + e] = fmaf(P0[4 * g4 + e], C2, ct2 + ba[e]); P1[4 * g4 + e] = fmaf(P1[4 * g4 + e], C2, ct2 + bb[e]); } } \
        if (64 * (J) + 63 > tok0) { const int dq_ = t - 64 * (J) - 4 * hi; \
            _Pragma("unroll") for (int r = 0; r < 16; ++r) { const int c = (r & 3) + 8 * (r >> 2); if (c > dq_) P0[r] = NEG; if (c + 32 > dq_) P1[r] = NEG; } } } while (0)
    float cb0 = 0.f, cb1 = 0.f;
    if (tid < 64) { cb0 = cum[tid]; cb1 = cum[64 + tid]; }
    __syncthreads();
    dma_tile2(D, Kb, Vb, lds, 0, 0, wid);
    dma_tile2(D, Kb + (size_t)64 * LDP, Vb + (size_t)64 * LDP, lds, 1, 1, wid);
    load_q_norm<false>(qr, HID + ((size_t)b * T + t) * LDP + C_FQ + h * 128 + hi * 8, arg_in(13) + L * 128, hi, t, nullptr, nullptr);
    const float ct2 = cum[t] * LOG2E - C2 * 12.0f * qrow_norm(qr);
    if (tid < 64) { biasL[tid] = -cb0 * LOG2E; biasL[64 + tid] = -cb1 * LOG2E; }
    asm volatile("s_waitcnt vmcnt(4)" ::: "memory"); __syncthreads();
    f32x16 pA0, pA1;
    { qkt(pA0, pA1, lds, 0, r32, hi, qr); FOX_TRANSFORM(pA0, pA1, 0, 0);
      DMA_WAIT(); __syncthreads(); }
    int vs = 1;
    for (int j = 1; j < ntiles; ++j) {
        const int vn = vs == 2 ? 0 : vs + 1, vp = vs == 0 ? 2 : vs - 1;
        if (j + 1 < ntiles) { dma_tile2(D, Kb + (size_t)(64 * (j + 1)) * LDP, Vb + (size_t)(64 * (j + 1)) * LDP, lds, (j + 1) & 1, vn, wid); if (tid < 64) biasL[vn * 64 + tid] = -cum[64 * (j + 1) + tid] * LOG2E; }
        f32x16 pB0, pB1;
        qkt(pB0, pB1, lds, j & 1, r32, hi, qr);
        float ps = 0.f;
#pragma unroll
        for (int r = 0; r < 16; ++r) { pA0[r] = __builtin_amdgcn_exp2f(pA0[r]); ps += pA0[r]; }
#pragma unroll
        for (int r = 0; r < 16; ++r) { pA1[r] = __builtin_amdgcn_exp2f(pA1[r]); ps += pA1[r]; }
        l += ps;
        bf16x8 pa0, pa1, pa2, pa3;
        PK4(pA0, 0, pa0); PK4(pA0, 8, pa1); PK4(pA1, 0, pa2); PK4(pA1, 8, pa3);
        pv_tile<0>(o, A.vb0 + vp * SHM_V, pa0, pa1, pa2, pa3);
        FOX_TRANSFORM(pB0, pB1, j, vs);
        pA0 = pB0; pA1 = pB1;
        DMA_WAIT(); __syncthreads();
        vs = vn;
    }
    {
        const int vp = vs == 0 ? 2 : vs - 1;
        float ps = 0.f;
#pragma unroll
        for (int r = 0; r < 16; ++r) { pA0[r] = __builtin_amdgcn_exp2f(pA0[r]); ps += pA0[r]; }
#pragma unroll
        for (int r = 0; r < 16; ++r) { pA1[r] = __builtin_amdgcn_exp2f(pA1[r]); ps += pA1[r]; }
        l += ps;
        bf16x8 pa0, pa1, pa2, pa3;
        PK4(pA0, 0, pa0); PK4(pA0, 8, pa1); PK4(pA1, 0, pa2); PK4(pA1, 8, pa3);
        SBAR();
        pv_tile<0>(o, A.vb0 + vp * SHM_V, pa0, pa1, pa2, pa3);
    }
#undef FOX_TRANSFORM
    l = xhalf_sum(l);
    if (hi == 0) tab[32 + r32] = 1.0f / l;
    asm volatile("s_waitcnt lgkmcnt(0)" ::: "memory");
    bf16_t* Ob = HN + ((size_t)b * T + tok0) * DM + 1024 + h * 128;
#define FOX_ROWPTR(rr) (Ob + (size_t)(rr) * DM)
    O_STORE(o, tab + 32, FOX_ROWPTR);
#undef FOX_ROWPTR
    asm volatile("s_waitcnt lgkmcnt(0)" ::: "memory");
}

#define NSA_ROWPTR(rr) (Ob + (size_t)((rr) >> 2) * 1024 + ((rr) & 3) * 128)
__device__ __forceinline__ void nsa_cmp_select(Frame& F, int L, int b, int kvh, int jq, const bf16x8* qr) {
    using namespace att;
    (void)L; RELAUNDER();
    lptr lds = (lptr)F.ldsl; unsigned char* ws = arg_ws();
    const bf16_t* HID = (const bf16_t*)(ws + WS_HID); const float* GF = (const float*)(ws + WS_GF);
    const Lanes A = mk_lanes(F); const int tid = A.tid, wid = A.wid, lane = A.lane, r32 = A.r32, hi = A.hi;
    LAS float* tab = (LAS float*)(lds + OFF_WS) + wid * 64;
    LAS float* PgL = (LAS float*)(lds + OFF_PG); LAS float* SC = (LAS float*)(lds + OFF_SC); LAS unsigned* SEL = (LAS unsigned*)(lds + OFF_SEL); LAS unsigned* UNI = (LAS unsigned*)(lds + OFF_UNI);
    const int tl = 8 * wid + (r32 >> 2), g = r32 & 3, t = 64 * jq + tl, hq = kvh * 4 + g;
    const size_t mrow = (size_t)b * T + t;
    const float NEG = -__builtin_inff();

    const float gt0 = GF[mrow * 32 + hq * 3 + 0];
    const bf16_t* KC = (const bf16_t*)(ws + WS_KC) + (size_t)(b * 2 + kvh) * 128 * 128; const bf16_t* VC = (const bf16_t*)(ws + WS_VC) + (size_t)(b * 2 + kvh) * 128 * 128;
    const bool two = jq >= 16;
    { Stg s0; stg_load(s0, KC, VC, 128, A.sr, A.sc);
      __syncthreads();
      stg_write(s0, lds, 0, 0, A.kws, A.vst0, A.vst1);
      if (two) { Stg s1; stg_load(s1, KC + 64 * 128, VC + 64 * 128, 128, A.sr, A.sc); stg_write(s1, lds, 1, 1, A.kws, A.vst0, A.vst1); }
      if (tid == 0) *UNI = 0u;
      __syncthreads(); }
    f32x16 a0, a1, b0, b1;
    qkt(a0, a1, lds, 0, r32, hi, qr);
    if (two) qkt(b0, b1, lds, 1, r32, hi, qr);
    else {
#pragma unroll
        for (int r = 0; r < 16; ++r) { b0[r] = NEG; b1[r] = NEG; } }
    const int cmax = (t - 31) >> 4; float mx = -1e30f;
#pragma unroll
    for (int r = 0; r < 16; ++r) { const int c = crow(r, hi);
        a0[r] = (c <= cmax) ? a0[r] * C2 : NEG; a1[r] = (c + 32 <= cmax) ? a1[r] * C2 : NEG; b0[r] = (c + 64 <= cmax) ? b0[r] * C2 : NEG; b1[r] = (c + 96 <= cmax) ? b1[r] * C2 : NEG;
        mx = fmaxf(mx, fmaxf(fmaxf(a0[r], a1[r]), fmaxf(b0[r], b1[r]))); }
    mx = xhalf_max(mx);
    float ps = 0.f;
#pragma unroll
    for (int r = 0; r < 16; ++r) { a0[r] = __builtin_amdgcn_exp2f(a0[r] - mx); a1[r] = __builtin_amdgcn_exp2f(a1[r] - mx); b0[r] = __builtin_amdgcn_exp2f(b0[r] - mx); b1[r] = __builtin_amdgcn_exp2f(b1[r] - mx);
        ps += (a0[r] + a1[r]) + (b0[r] + b1[r]); }
    ps = xhalf_sum(ps);
    const float inv = ps > 0.f ? 1.0f / ps : 0.f;
#pragma unroll
    for (int r = 0; r < 16; ++r) { a0[r] *= inv; a1[r] *= inv; b0[r] *= inv; b1[r] *= inv; }
#define QSUM(x) ({ float y_ = (x); y_ += __int_as_float(__builtin_amdgcn_update_dpp(0, __float_as_int(y_), 0xB1, 0xf, 0xf, false)); y_ += __int_as_float(__builtin_amdgcn_update_dpp(0, __float_as_int(y_), 0x4E, 0xf, 0xf, false)); y_; })
#pragma unroll
    for (int g4 = 0; g4 < 4; ++g4) {
        f32x4 va, vb, vc, vd;
#pragma unroll
        for (int e = 0; e < 4; ++e) { va[e] = QSUM(a0[4 * g4 + e]); vb[e] = QSUM(a1[4 * g4 + e]); vc[e] = QSUM(b0[4 * g4 + e]); vd[e] = QSUM(b1[4 * g4 + e]); }
        if (g == 0) { LAS float* pr = PgL + tl * 128 + 8 * g4 + 4 * hi; *(LAS f32x4*)pr = va; *(LAS f32x4*)(pr + 32) = vb; *(LAS f32x4*)(pr + 64) = vc; *(LAS f32x4*)(pr + 96) = vd; }
    }
#undef QSUM
    f32x16 o[4] = {};
    { bf16x8 pa0, pa1, pa2, pa3; PK4(a0, 0, pa0); PK4(a0, 8, pa1); PK4(a1, 0, pa2); PK4(a1, 8, pa3); SBAR(); pv_tile<0>(o, A.vb0, pa0, pa1, pa2, pa3); }
    if (two) { bf16x8 pa0, pa1, pa2, pa3; PK4(b0, 0, pa0); PK4(b0, 8, pa1); PK4(b1, 0, pa2); PK4(b1, 8, pa3); SBAR(); pv_tile<1>(o, A.vb0, pa0, pa1, pa2, pa3); }
    if (hi == 0) tab[32 + r32] = gt0;
    asm volatile("s_waitcnt lgkmcnt(0)" ::: "memory");
    { bf16_t* Ob = (bf16_t*)(ws + WS_NSA0) + ((size_t)b * T + 64 * jq + 8 * wid) * 1024 + kvh * 512;
      O_STORE(o, tab + 32, NSA_ROWPTR); }
    asm volatile("s_waitcnt lgkmcnt(0)" ::: "memory");
    __syncthreads();
#pragma unroll
    for (int i = 0; i < 4; ++i) { const int tok = (tid >> 5) + 16 * i, j = tid & 31; const LAS float* pr = PgL + tok * 128;
        float imp = pr[4 * j] + pr[4 * j + 1] + pr[4 * j + 2] + pr[4 * j + 3]; if (j > 0) imp += pr[4 * j - 1];
        const float scv = (j == 0 || j == jq || j == jq - 1) ? 1e9f : (j <= jq ? imp : -1e30f);
        SC[tok * 32 + j] = scv; }
    __syncthreads();
    unsigned uni_w = 0u;
#pragma unroll
    for (int i = 0; i < 4; ++i) { const int tok = (tid >> 5) + 16 * i, j = tid & 31; const float my = SC[tok * 32 + j]; int cnt = 0;
#pragma unroll
        for (int q = 0; q < 8; ++q) { const f32x4 v = *(const LAS f32x4*)(SC + tok * 32 + 4 * q);
#pragma unroll
            for (int e = 0; e < 4; ++e) { const int jj = 4 * q + e; cnt += (v[e] > my || (v[e] == my && jj < j)) ? 1 : 0; } }
        const unsigned long long bal = __ballot(cnt < 8);
        if ((lane & 31) == 0) SEL[tok] = (unsigned)(bal >> (lane & 32));
        uni_w |= (unsigned)bal | (unsigned)(bal >> 32); }
    if (lane == 0) atomicOr((unsigned*)UNI, uni_w);
    __syncthreads();
}
template <int MODE>
__device__ __forceinline__ void nsa_branch(Frame& F, int L, int b, int kvh, int jq, const bf16x8* qr) {
    using namespace att;
    (void)L; RELAUNDER();
    lptr lds = (lptr)F.ldsl; unsigned char* ws = arg_ws();
    const bf16_t* HID = (const bf16_t*)(ws + WS_HID); const float* GF = (const float*)(ws + WS_GF);
    const Lanes A = mk_lanes(F); const int wid = A.wid, r32 = A.r32, hi = A.hi;
    LAS float* tab = (LAS float*)(lds + OFF_WS) + wid * 64;
    LAS unsigned* SEL = (LAS unsigned*)(lds + OFF_SEL); LAS unsigned* UNI = (LAS unsigned*)(lds + OFF_UNI);
    const int tl = 8 * wid + (r32 >> 2), g = r32 & 3, t = 64 * jq + tl, hq = kvh * 4 + g;
    const size_t mrow = (size_t)b * T + t;
    const float NEG = -__builtin_inff();

    const float gt = GF[mrow * 32 + hq * 3 + MODE];
    const float sref = -C2 * 12.0f * qrow_norm(qr);
    const bf16_t* Kb = HID + (size_t)b * T * LDP + C_KV + MODE * 512 + kvh * 128; const bf16_t* Vb = Kb + 256;
    unsigned U, Uw = 0xFFFFFFFFu, selm = 0xFFFFFFFFu;
    if (MODE == 1) {
        const unsigned causal = (jq == 31) ? 0xFFFFFFFFu : ((2u << jq) - 1u);
        selm = SEL[tl] & causal;
        U = (unsigned)__builtin_amdgcn_readfirstlane((int)(*UNI & causal));
        unsigned uw = selm; uw |= __shfl_xor(uw, 4); uw |= __shfl_xor(uw, 8); uw |= __shfl_xor(uw, 16); uw |= __shfl_xor(uw, 32);
        Uw = (unsigned)__builtin_amdgcn_readfirstlane((int)uw);
    } else {
        const int jlo = jq >= 8 ? jq - 8 : 0;
        U = (jq == 31 ? 0xFFFFFFFFu : ((2u << jq) - 1u)) & ~((1u << jlo) - 1u);
    }
    f32x16 o[4] = {}; float l = 0.f;
#define NSA_TRANSFORM(P0, P1, J) do { const bool rowsel_ = (MODE == 1) ? (((selm >> (J)) & 1u) != 0u) : true; \
        const int dhi_ = ((J) == jq) ? (tl - 4 * hi) : 1000; const int dlo_ = (MODE == 2 && (J) == jq - 8) ? (tl - 4 * hi) : -1000; \
        _Pragma("unroll") for (int r = 0; r < 16; ++r) { const int c = (r & 3) + 8 * (r >> 2); \
            P0[r] = (rowsel_ && c <= dhi_ && c > dlo_) ? fmaf(P0[r], C2, sref) : NEG; P1[r] = (rowsel_ && c + 32 <= dhi_ && c + 32 > dlo_) ? fmaf(P1[r], C2, sref) : NEG; } } while (0)
    (void)Uw;
    unsigned rem = U; int j = __builtin_ctz(rem); rem &= rem - 1u;
    const Dma D = dma_offs(wid, A.lane, LDP);
    __syncthreads();
    dma_tile2(D, Kb + (size_t)(64 * j) * LDP, Vb + (size_t)(64 * j) * LDP, lds, 0, 0, wid);
    int jn = -1;
    if (rem) { jn = __builtin_ctz(rem); rem &= rem - 1u; dma_tile2(D, Kb + (size_t)(64 * jn) * LDP, Vb + (size_t)(64 * jn) * LDP, lds, 1, 1, wid);
               asm volatile("s_waitcnt vmcnt(4)" ::: "memory"); }
    else DMA_WAIT();
    __syncthreads();
    f32x16 pA0, pA1;
    { qkt(pA0, pA1, lds, 0, r32, hi, qr); NSA_TRANSFORM(pA0, pA1, j);
      DMA_WAIT(); __syncthreads(); }
    int vs = 1, n = 1;
    while (jn >= 0) {
        j = jn; jn = -1;
        const int vn = vs == 2 ? 0 : vs + 1, vp = vs == 0 ? 2 : vs - 1;
        if (rem) { jn = __builtin_ctz(rem); rem &= rem - 1u; dma_tile2(D, Kb + (size_t)(64 * jn) * LDP, Vb + (size_t)(64 * jn) * LDP, lds, (n + 1) & 1, vn, wid); }
        f32x16 pB0, pB1;
        qkt(pB0, pB1, lds, n & 1, r32, hi, qr);
        float ps = 0.f;
#pragma unroll
        for (int r = 0; r < 16; ++r) { pA0[r] = __builtin_amdgcn_exp2f(pA0[r]); ps += pA0[r]; }
#pragma unroll
        for (int r = 0; r < 16; ++r) { pA1[r] = __builtin_amdgcn_exp2f(pA1[r]); ps += pA1[r]; }
        l += ps;
        bf16x8 pa0, pa1, pa2, pa3;
        PK4(pA0, 0, pa0); PK4(pA0, 8, pa1); PK4(pA1, 0, pa2); PK4(pA1, 8, pa3);
        pv_tile<0>(o, A.vb0 + vp * SHM_V, pa0, pa1, pa2, pa3);
        NSA_TRANSFORM(pB0, pB1, j);
        pA0 = pB0; pA1 = pB1;
        DMA_WAIT(); __syncthreads();
        vs = vn; ++n;
    }
    {
        const int vp = vs == 0 ? 2 : vs - 1;
        float ps = 0.f;
#pragma unroll
        for (int r = 0; r < 16; ++r) { pA0[r] = __builtin_amdgcn_exp2f(pA0[r]); ps += pA0[r]; }
#pragma unroll
        for (int r = 0; r < 16; ++r) { pA1[r] = __builtin_amdgcn_exp2f(pA1[r]); ps += pA1[r]; }
        l += ps;
        bf16x8 pa0, pa1, pa2, pa3;
        PK4(pA0, 0, pa0); PK4(pA0, 8, pa1); PK4(pA1, 0, pa2); PK4(pA1, 8, pa3);
        SBAR();
        pv_tile<0>(o, A.vb0 + vp * SHM_V, pa0, pa1, pa2, pa3);
    }
#undef NSA_TRANSFORM
    l = xhalf_sum(l);
    if (hi == 0) tab[32 + r32] = gt / l;
    asm volatile("s_waitcnt lgkmcnt(0)" ::: "memory");
    { bf16_t* Ob = (bf16_t*)(ws + (MODE == 1 ? WS_NSA1 : WS_NSA2)) + ((size_t)b * T + 64 * jq + 8 * wid) * 1024 + kvh * 512;
      O_STORE(o, tab + 32, NSA_ROWPTR); }
    asm volatile("s_waitcnt lgkmcnt(0)" ::: "memory");
}
#undef NSA_ROWPTR

__device__ __forceinline__ void phase_attn(Frame& F, int L) {
    for (int it = F.vcu; it < 512; it += F.G) { const int b = it >> 5, h = (it >> 2) & 7, p = it & 3;
#if !defined(NO_FOX)
        for (int half = 0; half < 2; ++half) fox_block(F, L, b, h, half ? p : 7 - p);
#endif
    }
    STAMP(11);
    for (int rd = 0; rd * F.G < 1024; ++rd) { const int i = rd * F.G + ((rd & 1) ? (F.G - 1 - F.vcu) : F.vcu); if (i >= 1024) continue;
        const int jq = 31 - (i >> 5), rem = i & 31, b = rem >> 1, kvh = rem & 1;
#if !defined(NO_NSA)
        { using namespace att; RELAUNDER();
          const int wid_ = F.wave, r32_ = F.lane & 31, hi_ = F.lane >> 5, tl_ = 8 * wid_ + (r32_ >> 2), t_ = 64 * jq + tl_, hq_ = kvh * 4 + (r32_ & 3);
          const bf16_t* HID_ = (const bf16_t*)(arg_ws() + WS_HID); const float* rc_ = (const float*)(arg_ws() + WS_ROPE);
          bf16x8 qr[8];
          load_q_norm<true>(qr, HID_ + ((size_t)b * T + t_) * LDP + hq_ * 128 + hi_ * 8, arg_in(7) + L * 128, hi_, t_, rc_, rc_ + T * 16);
          nsa_cmp_select(F, L, b, kvh, jq, qr);
          nsa_branch<1>(F, L, b, kvh, jq, qr);
          nsa_branch<2>(F, L, b, kvh, jq, qr); }
#endif
    }
}

struct Args { const float* in[22]; float* out; unsigned char* ws; };
#define GRID_BAR() do { XcdBarrier bar_; bar_.bar = (unsigned*)(arg_ws() + WS_CTL) + CW_BAR; bar_.x = xb_xcc_id(); bar_.st = (volatile LAS unsigned*)(F.ldsl + MISC_OFF) + 8; xcd_barrier(bar_); RELAUNDER(); } while (0)
__global__ void __launch_bounds__(512, 2) mega_fwd(Args args) {
    extern __shared__ __attribute__((aligned(16))) unsigned char lds[];
    (void)args;
    Frame F;
    F.lds = lds; F.ldsl = (LAS unsigned char*)lds;
    F.tid = threadIdx.x; F.lane = F.tid & 63; F.wave = __builtin_amdgcn_readfirstlane(F.tid >> 6);
    F.G = gridDim.x; { const int bx = blockIdx.x; F.vcu = (F.G % 8 == 0) ? (bx % 8) * (F.G / 8) + bx / 8 : bx; }
    F.gw = F.vcu * 8 + F.wave; F.NGW = F.G * 8;
    for (int u = F.tid; u < (LDS_BYTES - LDSCTL_OFF) / 4; u += 512) ((LAS unsigned*)(F.ldsl + LDSCTL_OFF))[u] = 0u;
    __syncthreads();
    (void)xcd_barrier_post((unsigned*)(arg_ws() + WS_CTL) + CW_BAR, (volatile LAS unsigned*)(F.ldsl + MISC_OFF) + 8);
#if PROBE_MASK
    if (blockIdx.x == 0 && F.tid == 0) { volatile LAS unsigned long long* pa_ = (volatile LAS unsigned long long*)(F.ldsl + MISC_OFF + 64); const unsigned long long r0_ = __builtin_amdgcn_s_memrealtime(); pa_[15] = r0_; pa_[14] = r0_; pa_[13] = __builtin_amdgcn_s_memtime(); }
#endif
    for (int L = 0; L < NL; ++L) {
        for (int sb = 0; sb < 3; ++sb) {
            if (sb != 1) {
                const int first = (L == 0 && sb == 0);
                if (first) {
                    phase_convert(F, 0, F.gw, F.NGW);
                    phase_prenorm(F, arg_in(0), arg_in(1), (bf16_t*)(arg_ws() + WS_XB), (float*)(arg_ws() + WS_PS));
                    GRID_BAR(); STAMP(0);
                }
                { unsigned char* ws = arg_ws();
                  pg8::Gemm g{(const bf16_t*)(ws + WS_XB), (const bf16_t*)(ws + (size_t)(L & 1) * WSET + (sb == 0 ? WS_WGU : WS_WGU2)), M, 2 * DFF, DM}; pg8::StaticOrder S; S.init(M, 2 * DFF, F.G, (int)blockIdx.x);
                  pg8::EpiSwiglu E{(bf16_t*)(ws + WS_HID), DFF, (const float*)(ws + WS_PS) + (size_t)(L * 3 + sb) * M * 32, (LAS float*)(F.ldsl + RL_OFF), -1}; pg8::gemm_phase<pg8::EpiSwiglu, pg8::StaticOrder, true, true>(F.ldsl, g, S, E, F.tid); }
                GRID_BAR(); STAMP(1);
                { unsigned char* ws = arg_ws();
                  const bool last = (L == NL - 1 && sb == 2);
                  pg8::Gemm g{(const bf16_t*)(ws + WS_HID), (const bf16_t*)(ws + (size_t)(L & 1) * WSET + (sb == 0 ? WS_WD : WS_WD2)), M, DM, DFF}; pg8::StaticOrder S; S.init(M, DM, F.G, (int)blockIdx.x); S.rev = 1; S.wgm = 4;
                  pg8::EpiResid E{0.5f, last ? 1 : 0, sb == 0 ? L * 3 + 1 : (L + 1) * 3}; pg8::gemm_phase<pg8::EpiResid, pg8::StaticOrder, false, true>(F.ldsl, g, S, E, F.tid); }
                GRID_BAR(); STAMP(2);
            } else {
                { unsigned char* ws = arg_ws();
                  pg8::Gemm g{(const bf16_t*)(ws + WS_XB), (const bf16_t*)(ws + (size_t)(L & 1) * WSET + WS_WIN), M, NWIN, DM}; pg8::StaticOrder S; S.init(M, NWIN, F.G, (int)blockIdx.x);
                  pg8::EpiProj E{(bf16_t*)(ws + WS_HID), LDP, (float*)(ws + WS_GF), (const float*)(ws + WS_PS) + (size_t)(L * 3 + 1) * M * 32, (LAS float*)(F.ldsl + RL_OFF), -1}; pg8::gemm_phase<pg8::EpiProj, pg8::StaticOrder, true, true>(F.ldsl, g, S, E, F.tid); }
                GRID_BAR(); STAMP(4);
                phase_prep(F, L);
                GRID_BAR(); STAMP(5);
                { unsigned char* ws = arg_ws();
                  pg8::Gemm g{(const bf16_t*)(ws + WS_CMPA), (const bf16_t*)(ws + (size_t)(L & 1) * WSET + WS_WC1), 8192, 512, 4096}; pg8::CmpOrder S{F.G, (int)blockIdx.x};
                  pg8::EpiGeluCmp E{(bf16_t*)(ws + WS_CMPH)}; pg8::gemm_phase<pg8::EpiGeluCmp, pg8::CmpOrder, true, true>(F.ldsl, g, S, E, F.tid); }
                phase_scan(F);
                if (L + 1 < NL && blockIdx.x >= 32) phase_convert(F, L + 1, ((int)blockIdx.x - 32) * 8 + F.wave, (F.G - 32) * 8);
                GRID_BAR(); STAMP(6);
                phase_cmp2(F, L);
                GRID_BAR(); STAMP(7);
                phase_attn(F, L); STAMP(12);
                GRID_BAR(); STAMP(8);
                phase_outnorm(F, L);
                GRID_BAR(); STAMP(9);
                { unsigned char* ws = arg_ws();
                  pg8::Gemm g{(const bf16_t*)(ws + WS_HN), (const bf16_t*)(ws + (size_t)(L & 1) * WSET + WS_WOUT), M, DM, DM}; pg8::StaticOrder S; S.init(M, DM, F.G, (int)blockIdx.x); S.wgm = 4;
                  pg8::EpiResid E{1.0f, 0, L * 3 + 2};
                  pg8::gemm_phase<pg8::EpiResid, pg8::StaticOrder, false, true>(F.ldsl, g, S, E, F.tid); }
                GRID_BAR(); STAMP(10);
            }
        }
    }
#if PROBE_MASK
    if (blockIdx.x == 0 && F.tid == 0) {
        volatile LAS unsigned long long* pa_ = (volatile LAS unsigned long long*)(F.ldsl + MISC_OFF + 64);
        const unsigned long long r1 = __builtin_amdgcn_s_memrealtime(), c1 = __builtin_amdgcn_s_memtime();
        unsigned long long target = 0;
        if (PROBE_MASK & 0x10000) target = (unsigned long long)((float)(c1 - pa_[13]) / (float)(r1 - pa_[14]) * 100000.0f);
        else { for (int t_ = 0; t_ < 13; ++t_) if ((PROBE_MASK >> t_) & 1) target += pa_[t_]; target *= PROBE_K; }
        while (__builtin_amdgcn_s_memrealtime() - r1 < target) __builtin_amdgcn_s_sleep(32);
    }
#endif
}

extern "C" void kernel_launch(void* const* d_in, const int* in_sizes, int n_in, void* d_out, int out_size, void* d_ws, size_t ws_size, hipStream_t stream) {
    static int grid = 0;
    if (grid == 0) {
        if (n_in != 22 || out_size != M * DM || ws_size < WS_END) { fprintf(stderr, "kernel_launch: unexpected shapes (n_in %d out %d ws %zu)\n", n_in, out_size, ws_size); grid = -1; return; }
        int dev = 0, cus = 0, per_cu = 0;
        if (hipGetDevice(&dev) != hipSuccess || hipDeviceGetAttribute(&cus, hipDeviceAttributeMultiprocessorCount, dev) != hipSuccess) { grid = -1; return; }
        if (hipFuncSetAttribute((const void*)mega_fwd, hipFuncAttributeMaxDynamicSharedMemorySize, LDS_BYTES) != hipSuccess) { fprintf(stderr, "kernel_launch: hipFuncSetAttribute failed\n"); grid = -1; return; }
        if (hipOccupancyMaxActiveBlocksPerMultiprocessor(&per_cu, (const void*)mega_fwd, 512, LDS_BYTES) != hipSuccess || per_cu < 1) fprintf(stderr, "kernel_launch: occupancy query reports %d\n", per_cu);
        (void)hipGetLastError();
        grid = cus;
    }
    if (grid < 0) return;
    (void)in_sizes;
    if (hipMemsetAsync((char*)d_ws + WS_CTL, 0, CTL_ZERO_BYTES, stream) != hipSuccess) return;
    Args a{};
    for (int i = 0; i < 22; ++i) a.in[i] = (const float*)d_in[i];
    a.out = (float*)d_out; a.ws = (unsigned char*)d_ws;
    hipLaunchKernelGGL(mega_fwd, dim3(grid), dim3(512), LDS_BYTES, stream, a);
}
```

```cpp
#include <hip/hip_runtime.h>
#include <cstdio>
#include <cstdint>

#ifndef PROBE_MASK
#define PROBE_MASK 0
#endif
#ifndef PROBE_K
#define PROBE_K 1
#endif
#define GAS __attribute__((address_space(1)))
#define LAS __attribute__((address_space(3)))
typedef unsigned short bf16_t;
typedef short bf16x8 __attribute__((ext_vector_type(8)));
typedef short s16x4 __attribute__((ext_vector_type(4)));
typedef float f32x4 __attribute__((ext_vector_type(4)));
typedef float f32x2 __attribute__((ext_vector_type(2)));
typedef float f32x16 __attribute__((ext_vector_type(16)));
typedef unsigned u32x4 __attribute__((ext_vector_type(4)));
typedef unsigned u32x2 __attribute__((ext_vector_type(2)));

constexpr int NB = 16, T = 2048, DM = 2048, M = NB * T, NL = 4, HD = 128, DFF = 5632;
constexpr int LDP = 5632;
constexpr int PROJ_COLS = 5664, NWIN = 5888;
constexpr int C_KV = 1024, C_FQ = 2560, C_FK = 3584, C_FV = 4608;
constexpr int NCMP = 127;
constexpr float EPS = 1e-6f;
constexpr float RS_SCALE = 16777216.0f, RS_INV = 1.0f / 16777216.0f / 2048.0f;
typedef unsigned long long u64_t;
constexpr float LOG2E = 1.4426950408889634f;
constexpr float C2 = 0.08838834764831845f * 1.4426950408889634f;

constexpr size_t MiB = 1u << 20;
constexpr size_t WS_CTL = 0, CTL_ZERO_BYTES = 1 * MiB;
constexpr size_t WS_ROPE = 1 * MiB;
constexpr size_t WS_CUM = 2 * MiB;
constexpr size_t WS_GF = 3 * MiB;
constexpr size_t WS_KC = 7 * MiB;
constexpr size_t WS_VC = 8 * MiB;
constexpr size_t WS_CMPH = 9 * MiB;
constexpr size_t WS_WGU = 16 * MiB;
constexpr size_t WS_WD = 60 * MiB;
constexpr size_t WS_WIN = 82 * MiB;
constexpr size_t WS_WOUT = 105 * MiB;
constexpr size_t WS_WGU2 = 113 * MiB;
constexpr size_t WS_WD2 = 157 * MiB;
constexpr size_t WS_WC1 = 179 * MiB;
constexpr size_t WS_LF = 183 * MiB;
constexpr size_t WS_CMPA = 184 * MiB;
constexpr size_t WS_HN = 248 * MiB;
constexpr size_t WS_HID = 376 * MiB;
constexpr size_t WS_NSA0 = 728 * MiB, WS_NSA1 = 792 * MiB, WS_NSA2 = 856 * MiB;
constexpr size_t WS_XB = 920 * MiB;
constexpr size_t WS_RS = 13 * MiB, RS_BYTES = (size_t)NL * 3 * M * 8;
constexpr size_t WSET = 1032 * MiB;
constexpr size_t WS_PS = 1216 * MiB;
constexpr size_t WS_END = 1216 * MiB + 48 * MiB;
constexpr int CW_BAR = 4096;

constexpr int RING_BYTES = 131072;
constexpr int LDSCTL_OFF = RING_BYTES, MISC_OFF = LDSCTL_OFF + 320;
constexpr int RL_OFF = LDSCTL_OFF + 1024;
constexpr int LDS_BYTES = 147456;

__device__ __forceinline__ unsigned long long karg(int i) {
    const __attribute__((address_space(4))) unsigned char* kp = (const __attribute__((address_space(4))) unsigned char*)__builtin_amdgcn_kernarg_segment_ptr();
    return *(const __attribute__((address_space(4))) unsigned long long volatile*)(kp + 8 * i);
}
__device__ __forceinline__ const float* arg_in(int i) { return (const float*)(const GAS float*)karg(i); }
__device__ __forceinline__ float* arg_out() { return (float*)(GAS float*)karg(22); }
__device__ __forceinline__ unsigned char* arg_ws() { return (unsigned char*)(GAS unsigned char*)karg(23); }
namespace pg8 {
#define PG8_LAS __attribute__((address_space(3)))
constexpr int BM = 256, BK = 64, HALF = 128, HTB = HALF * BK * 2, STAGE_BYTES = 8 * HTB, NXCD = 8, WGM = 8;
__host__ __device__ __forceinline__ int lds_byte(int r, int c) { const int st = (r >> 4) * 2 + (c >> 5), rr = r & 15, cc = c & 31, ob = rr * 64 + cc * 2; return st * 1024 + (ob ^ (((ob >> 9) & 1) << 5)); }
__host__ __device__ __forceinline__ void stage_rc(int b, int& R, int& C) { const int st = b / 1024, sb = b % 1024, swz = sb ^ (((sb >> 9) & 1) << 5); R = (st >> 1) * 16 + swz / 64; C = (st & 1) * 32 + (swz % 64) / 2; }
__host__ __device__ __forceinline__ int perm32(int rho) { const int n = rho >> 4, i = rho & 15; return 8 * (i >> 2) + 4 * n + (i & 3); }
struct Unit { int pm, pn; };
struct Gemm { const bf16_t* A; const bf16_t* Bt; int M, N, K; };
struct StaticOrder {
    int nM, nN, nwg, G, c, rev, wgm;
    __host__ __device__ void init(int M_, int N_, int G_, int c_) { nM = M_ / BM; nN = N_ / BM; nwg = nM * nN; G = G_; c = c_; rev = 0; wgm = WGM; }
    __host__ __device__ bool next(int i, Unit& u) const {
        const long L = (long)i * G + c; if (L >= nwg) return false;
        int wgid = (int)L; { const int q = nwg / NXCD, r = nwg % NXCD, xcd = wgid % NXCD, off = wgid / NXCD; wgid = (xcd < r ? xcd * (q + 1) : r * (q + 1) + (xcd - r) * q) + off; }
        const int nig = wgm * nN, gid = wgid / nig, fm = gid * wgm, gsz = (nM - fm) < wgm ? (nM - fm) : wgm;
        u.pm = fm + ((wgid % nig) % gsz); u.pn = (wgid % nig) / gsz; if (rev) u.pm = nM - 1 - u.pm; return true;
    }
    __device__ __forceinline__ void a_ready(const Unit&) const {}
    __device__ __forceinline__ void done(const Unit&) const {}
};
struct CmpOrder {
    int G, c;
    __device__ bool next(int i, Unit& u) const { const int L = i * G + c; if (L >= 32) return false; u.pm = L; u.pn = L >> 4; return true; }
    __device__ __forceinline__ void a_ready(const Unit&) const {}
    __device__ __forceinline__ void done(const Unit&) const {}
};
typedef float cvf32x2_t __attribute__((ext_vector_type(2)));
typedef __bf16 cvbf16x2_t __attribute__((ext_vector_type(2)));
__device__ __forceinline__ unsigned cvt_pk_bf16(float lo, float hi) { const cvf32x2_t v = {lo, hi}; const cvbf16x2_t b = __builtin_convertvector(v, cvbf16x2_t); return __builtin_bit_cast(unsigned, b); }

__device__ __forceinline__ float silu_f(float g) { return g * __builtin_amdgcn_rcpf(1.0f + __builtin_amdgcn_exp2f(-g * LOG2E)); }
struct EpiSwiglu {
    static constexpr bool PERM = true, AFTER_DRAIN = false;
    bf16_t* O; int ldc; const float* rs; PG8_LAS float* rl; mutable int cpm;
    __device__ __forceinline__ void operator()(const f32x4 (&acc)[2][2][4][2], const Unit& u, int wr, int wc, int fr, int fq) const {
        const int row0 = u.pm * BM + wr * 64 + fr, col0 = u.pn * HALF + wc * 32 + 8 * fq;
        if (u.pm != cpm) {
            const int t = (wr * 4 + wc) * 64 + fq * 16 + fr;
            if (t < 256) { const f32x4* pp = (const f32x4*)(rs + (size_t)(u.pm * BM + t) * 32); float sq = 0.f;
_Pragma("unroll") for (int i = 0; i < 8; ++i) { const f32x4 v = pp[i]; sq += (v[0] + v[1]) + (v[2] + v[3]); }
                rl[t] = 1.0f / sqrtf(sq * (1.0f / DM) + EPS); }
            cpm = u.pm;
            asm volatile("s_waitcnt lgkmcnt(0)" ::: "memory"); __builtin_amdgcn_s_barrier(); asm volatile("" ::: "memory");
        }
#pragma unroll
        for (int ai = 0; ai < 2; ++ai)
#pragma unroll
            for (int m = 0; m < 4; ++m) { bf16_t* rowp = O + (size_t)(row0 + ai * HALF + m * 16) * ldc + col0;
                const float r = rl[wr * 64 + fr + ai * HALF + m * 16];
                const f32x4 g0 = acc[ai][0][m][0] * r, g1 = acc[ai][0][m][1] * r, u0 = acc[ai][1][m][0] * r, u1 = acc[ai][1][m][1] * r;
                u32x4 w;
                w.x = cvt_pk_bf16(silu_f(g0[0]) * u0[0], silu_f(g0[1]) * u0[1]); w.y = cvt_pk_bf16(silu_f(g0[2]) * u0[2], silu_f(g0[3]) * u0[3]);
                w.z = cvt_pk_bf16(silu_f(g1[0]) * u1[0], silu_f(g1[1]) * u1[1]); w.w = cvt_pk_bf16(silu_f(g1[2]) * u1[2], silu_f(g1[3]) * u1[3]);
                __builtin_nontemporal_store(w, (u32x4*)rowp); }
    }
};
struct EpiResid {
    static constexpr bool PERM = true, AFTER_DRAIN = false;
    float scale; int final_out; int rs_idx;
    __device__ __forceinline__ void operator()(const f32x4 (&acc)[2][2][4][2], const Unit& u, int wr, int wc, int fr, int fq) const {
        const int row0 = u.pm * BM + wr * 64 + fr, col0 = u.pn * BM + wc * 32 + 8 * fq;
        constexpr int ldc = DM;
        bf16_t* xb = (bf16_t*)(arg_ws() + WS_XB); float* out = arg_out();
        float* ps = (float*)(arg_ws() + WS_PS) + (size_t)rs_idx * M * 32 + u.pn * 4 + wc;
#pragma unroll
        for (int ai = 0; ai < 2; ++ai) {
            u32x4 bs[4][2];
#pragma unroll
            for (int m = 0; m < 4; ++m) { const size_t off = (size_t)(row0 + ai * HALF + m * 16) * ldc + col0;
#pragma unroll
                for (int bj = 0; bj < 2; ++bj) bs[m][bj] = *(const u32x4*)(xb + off + bj * HALF); }
            __builtin_amdgcn_sched_barrier(0);
#pragma unroll
            for (int m = 0; m < 4; ++m) { const int row = row0 + ai * HALF + m * 16; const size_t off = (size_t)row * ldc + col0; float ss = 0.f;
#pragma unroll
                for (int bj = 0; bj < 2; ++bj) { const u32x4 b = bs[m][bj]; u32x4 w;
#pragma unroll
                    for (int n = 0; n < 2; ++n) { const f32x4 a = acc[ai][bj][m][n]; const unsigned bx = n ? b.z : b.x, by = n ? b.w : b.y;
                        const f32x4 v = {__uint_as_float(bx << 16) + a[0] * scale, __uint_as_float(bx & 0xffff0000u) + a[1] * scale, __uint_as_float(by << 16) + a[2] * scale, __uint_as_float(by & 0xffff0000u) + a[3] * scale};
                        if (final_out) *(f32x4*)(out + off + bj * HALF + 4 * n) = v;
                        else { const unsigned p0 = cvt_pk_bf16(v[0], v[1]), p1 = cvt_pk_bf16(v[2], v[3]); if (n) { w.z = p0; w.w = p1; } else { w.x = p0; w.y = p1; }
                            ss += (v[0] * v[0] + v[1] * v[1]) + (v[2] * v[2] + v[3] * v[3]); } }
                    if (!final_out) *(u32x4*)(xb + off + bj * HALF) = w; }
                if (!final_out) { ss += __shfl_xor(ss, 16); ss += __shfl_xor(ss, 32); if (fq == 0) ps[(size_t)row * 32] = ss; } }
            __builtin_amdgcn_sched_barrier(0);
        }
    }
};
struct EpiProj {
    static constexpr bool PERM = true, AFTER_DRAIN = false;
    bf16_t* O; int ldc; float* GF; const float* rs; PG8_LAS float* rl; mutable int cpm;
    __device__ __forceinline__ void operator()(const f32x4 (&acc)[2][2][4][2], const Unit& u, int wr, int wc, int fr, int fq) const {
        const int row0 = u.pm * BM + wr * 64 + fr;
        if (u.pm != cpm) {
            const int t = (wr * 4 + wc) * 64 + fq * 16 + fr;
            if (t < 256) { const f32x4* pp = (const f32x4*)(rs + (size_t)(u.pm * BM + t) * 32); float sq = 0.f;
_Pragma("unroll") for (int i = 0; i < 8; ++i) { const f32x4 v = pp[i]; sq += (v[0] + v[1]) + (v[2] + v[3]); }
                rl[t] = 1.0f / sqrtf(sq * (1.0f / DM) + EPS); }
            cpm = u.pm;
            asm volatile("s_waitcnt lgkmcnt(0)" ::: "memory"); __builtin_amdgcn_s_barrier(); asm volatile("" ::: "memory");
        }
        float rr[2][4];
#pragma unroll
        for (int ai = 0; ai < 2; ++ai)
#pragma unroll
            for (int m = 0; m < 4; ++m) rr[ai][m] = rl[wr * 64 + fr + ai * HALF + m * 16];
        if (u.pn < 22) {
            const int col0 = u.pn * BM + wc * 32 + 8 * fq;
#pragma unroll
            for (int ai = 0; ai < 2; ++ai)
#pragma unroll
                for (int m = 0; m < 4; ++m) { bf16_t* rowp = O + (size_t)(row0 + ai * HALF + m * 16) * ldc + col0; const float r = rr[ai][m];
#pragma unroll
                    for (int bj = 0; bj < 2; ++bj) { const f32x4 v0 = acc[ai][bj][m][0] * r, v1 = acc[ai][bj][m][1] * r;
                        u32x4 w; w.x = cvt_pk_bf16(v0[0], v0[1]); w.y = cvt_pk_bf16(v0[2], v0[3]); w.z = cvt_pk_bf16(v1[0], v1[1]); w.w = cvt_pk_bf16(v1[2], v1[3]);
                        *(u32x4*)(rowp + bj * HALF) = w; } }
        } else if (wc == 0) {
#pragma unroll
            for (int ai = 0; ai < 2; ++ai)
#pragma unroll
                for (int m = 0; m < 4; ++m) { float* rowp = GF + (size_t)(row0 + ai * HALF + m * 16) * 32 + 8 * fq; const float r = rr[ai][m];
                    *(f32x4*)rowp = acc[ai][0][m][0] * r; *(f32x4*)(rowp + 4) = acc[ai][0][m][1] * r; }
        }
    }
};
__device__ __forceinline__ float gelu_tanh_f(float x) {
    const float u2 = 1.5957691216057308f * (x + 0.044715f * x * x * x);
    return x * __builtin_amdgcn_rcpf(1.0f + __builtin_amdgcn_exp2f(-u2 * LOG2E));
}
struct EpiGeluCmp {
    static constexpr bool PERM = true, AFTER_DRAIN = false;
    bf16_t* O;
    __device__ __forceinline__ void operator()(const f32x4 (&acc)[2][2][4][2], const Unit& u, int wr, int wc, int fr, int fq) const {
        const int row0 = u.pm * BM + wr * 64 + fr, col0 = wc * 32 + 8 * fq;
#pragma unroll
        for (int ai = 0; ai < 2; ++ai)
#pragma unroll
            for (int m = 0; m < 4; ++m) { bf16_t* rowp = O + (size_t)(row0 + ai * HALF + m * 16) * 256 + col0;
#pragma unroll
                for (int bj = 0; bj < 2; ++bj) { const f32x4 v0 = acc[ai][bj][m][0], v1 = acc[ai][bj][m][1];
                    u32x4 w; w.x = cvt_pk_bf16(gelu_tanh_f(v0[0]), gelu_tanh_f(v0[1])); w.y = cvt_pk_bf16(gelu_tanh_f(v0[2]), gelu_tanh_f(v0[3]));
                    w.z = cvt_pk_bf16(gelu_tanh_f(v1[0]), gelu_tanh_f(v1[1])); w.w = cvt_pk_bf16(gelu_tanh_f(v1[2]), gelu_tanh_f(v1[3]));
                    *(u32x4*)(rowp + bj * HALF) = w; } }
    }
};

template <class Epi, class Sched, bool ALIGN_EPI = false, bool SP2 = false>
__device__ __forceinline__ void gemm_phase(PG8_LAS unsigned char* lds, const Gemm g, const Sched& S, const Epi& E, const int tid) {
    const int wid = __builtin_amdgcn_readfirstlane(tid >> 6), lane = tid & 63, wr = wid >> 2, wc = wid & 3, fr = lane & 15, fq = lane >> 4;
    const int K = g.K, nt = K / BK;
    unsigned voffA[2], voffB[2];
#pragma unroll
    for (int i = 0; i < 2; ++i) { int R, C; stage_rc(tid * 16 + i * 8192, R, C); const int Rb = Epi::PERM ? ((R & ~31) + perm32(R & 31)) : R;
        voffA[i] = (unsigned)(R * K + C) * 2u; voffB[i] = (unsigned)(Rb * K + C) * 2u; }
    const size_t kstep = (size_t)(BK * 2);
    const size_t hstep = (size_t)HALF * K * 2;
    const size_t tstep = 2 * hstep;
    const unsigned ldsw = (unsigned)wid * 1024u;
    const int aoff = lds_byte(wr * 64 + fr, fq * 8), boff = lds_byte(wc * 32 + fr, fq * 8);
#define PG8_SA(b, h) (((b) * 2 + (h)) * HTB)
#define PG8_SB(b, h) ((4 + (b) * 2 + (h)) * HTB)
#define PG8_STAGE(bufoff, gbase, voff) do { _Pragma("unroll") for (int _i = 0; _i < 2; ++_i) \
        __builtin_amdgcn_global_load_lds((const unsigned*)((const char*)(gbase) + (voff)[_i]), (PG8_LAS unsigned*)(lds + (bufoff) + ldsw + _i * 8192), 16, 0, 0); } while (0)
#define PG8_LDA(dst, b, h) do { _Pragma("unroll") for (int m = 0; m < 4; ++m) _Pragma("unroll") for (int k = 0; k < 2; ++k) dst[m][k] = *(const PG8_LAS bf16x8*)(lds + PG8_SA(b, h) + aoff + m * 2048 + k * 1024); } while (0)
#define PG8_LDB(dst, b, h) do { _Pragma("unroll") for (int n = 0; n < 2; ++n) _Pragma("unroll") for (int k = 0; k < 2; ++k) dst[n][k] = *(const PG8_LAS bf16x8*)(lds + PG8_SB(b, h) + boff + n * 2048 + k * 1024); } while (0)
#define PG8_MMA(ai, bj, At, Bt) do { __builtin_amdgcn_s_setprio(1); _Pragma("unroll") for (int m = 0; m < 4; ++m) _Pragma("unroll") for (int n = 0; n < 2; ++n) _Pragma("unroll") for (int k = 0; k < 2; ++k) \
        acc[ai][bj][m][n] = __builtin_amdgcn_mfma_f32_16x16x32_bf16(Bt[n][k], At[m][k], acc[ai][bj][m][n], 0, 0, 0); __builtin_amdgcn_s_setprio(0); } while (0)
#define PG8_WAIT_V(n) asm volatile("s_waitcnt vmcnt(" #n ")" ::: "memory")
#define PG8_WAIT_L(n) asm volatile("s_waitcnt lgkmcnt(" #n ")" ::: "memory")
#define PG8_BAR __builtin_amdgcn_s_barrier()
#define PG8_SCHED __builtin_amdgcn_sched_barrier(0)
    Unit cur, nxt; int ui = 0;
    if (!S.next(0, cur)) return;
    f32x4 acc[2][2][4][2];
#pragma unroll
    for (int a = 0; a < 2; ++a)
#pragma unroll
        for (int b = 0; b < 2; ++b)
#pragma unroll
            for (int m = 0; m < 4; ++m)
#pragma unroll
                for (int n = 0; n < 2; ++n) acc[a][b][m][n] = (f32x4){0.f, 0.f, 0.f, 0.f};
    bf16x8 At[4][2], B0[2][2], B1[2][2];
    const char* cA = (const char*)g.A + (size_t)cur.pm * tstep; const char* cB = (const char*)g.Bt + (size_t)cur.pn * tstep;
    S.a_ready(cur);
    if constexpr (SP2) {
        PG8_STAGE(PG8_SB(0, 0), cB, voffB); PG8_STAGE(PG8_SB(0, 1), cB + hstep, voffB); PG8_STAGE(PG8_SA(0, 0), cA, voffA); PG8_STAGE(PG8_SA(0, 1), cA + hstep, voffA);
        if (wr == 1) PG8_BAR;
        PG8_WAIT_V(2); PG8_BAR;
        PG8_STAGE(PG8_SB(1, 0), cB + kstep, voffB); PG8_STAGE(PG8_SA(1, 0), cA + kstep, voffA); PG8_STAGE(PG8_SB(1, 1), cB + hstep + kstep, voffB);
        PG8_WAIT_V(6); PG8_BAR;
    } else {
        PG8_STAGE(PG8_SB(0, 0), cB, voffB); PG8_STAGE(PG8_SA(0, 0), cA, voffA); PG8_STAGE(PG8_SB(0, 1), cB + hstep, voffB); PG8_STAGE(PG8_SA(0, 1), cA + hstep, voffA);
        if (wr == 1) PG8_BAR;
        PG8_WAIT_V(4); PG8_BAR;
        PG8_STAGE(PG8_SB(1, 0), cB + kstep, voffB); PG8_STAGE(PG8_SA(1, 0), cA + kstep, voffA); PG8_STAGE(PG8_SB(1, 1), cB + hstep + kstep, voffB);
        PG8_WAIT_V(6); PG8_BAR;
    }
    for (;;) {
        const bool has_next = S.next(ui + 1, nxt);
        const char* nA = has_next ? (const char*)g.A + (size_t)nxt.pm * tstep : cA; const char* nB = has_next ? (const char*)g.Bt + (size_t)nxt.pn * tstep : cB;
        for (int t = 0; t < nt; t += 2) {
            const bool last = (t == nt - 2);
            const char* a1 = cA + (size_t)(t + 1) * kstep;
            const char* a2 = last ? nA : cA + (size_t)(t + 2) * kstep; const char* b2 = last ? nB : cB + (size_t)(t + 2) * kstep;
            const char* a3 = a2 + kstep; const char* b3 = b2 + kstep;
            if (last && has_next) S.a_ready(nxt);
            if constexpr (SP2) {
            PG8_LDB(B0, 0, 0); PG8_LDB(B1, 0, 1); PG8_SCHED; PG8_LDA(At, 0, 0); PG8_STAGE(PG8_SA(1, 1), a1 + hstep, voffA);
            PG8_WAIT_V(8); PG8_WAIT_L(0); PG8_BAR; PG8_MMA(0, 0, At, B0); PG8_MMA(0, 1, At, B1); PG8_BAR; PG8_SCHED;
            PG8_LDA(At, 0, 1); PG8_STAGE(PG8_SB(0, 0), b2, voffB); PG8_STAGE(PG8_SB(0, 1), b2 + hstep, voffB); PG8_STAGE(PG8_SA(0, 0), a2, voffA);
            PG8_WAIT_V(8); PG8_WAIT_L(0); PG8_BAR; PG8_MMA(1, 0, At, B0); PG8_MMA(1, 1, At, B1); PG8_BAR; PG8_SCHED;
            PG8_LDB(B0, 1, 0); PG8_LDB(B1, 1, 1); PG8_SCHED; PG8_LDA(At, 1, 0); PG8_STAGE(PG8_SA(0, 1), a2 + hstep, voffA);
            PG8_WAIT_V(8); PG8_WAIT_L(0); PG8_BAR; PG8_MMA(0, 0, At, B0); PG8_MMA(0, 1, At, B1); PG8_BAR; PG8_SCHED;
            PG8_LDA(At, 1, 1); PG8_STAGE(PG8_SB(1, 0), b3, voffB); PG8_STAGE(PG8_SB(1, 1), b3 + hstep, voffB); PG8_STAGE(PG8_SA(1, 0), a3, voffA);
            PG8_WAIT_V(8); PG8_WAIT_L(0); PG8_BAR; PG8_MMA(1, 0, At, B0); PG8_MMA(1, 1, At, B1); PG8_BAR; PG8_SCHED;
            } else {
            PG8_LDB(B0, 0, 0); PG8_SCHED; PG8_LDA(At, 0, 0); PG8_STAGE(PG8_SA(1, 1), a1 + hstep, voffA);
            PG8_WAIT_L(8); PG8_BAR; PG8_WAIT_L(0); PG8_MMA(0, 0, At, B0); PG8_BAR; PG8_SCHED;
            PG8_LDB(B1, 0, 1); PG8_STAGE(PG8_SB(0, 0), b2, voffB);
            PG8_BAR; PG8_WAIT_L(0); PG8_MMA(0, 1, At, B1); PG8_BAR;
            PG8_LDA(At, 0, 1); PG8_STAGE(PG8_SA(0, 0), a2, voffA);
            PG8_BAR; PG8_WAIT_L(0); PG8_MMA(1, 0, At, B0); PG8_BAR; PG8_SCHED;
            PG8_STAGE(PG8_SB(0, 1), b2 + hstep, voffB);
            PG8_WAIT_V(6); PG8_BAR; PG8_MMA(1, 1, At, B1); PG8_BAR;
            PG8_LDB(B0, 1, 0); PG8_SCHED; PG8_LDA(At, 1, 0); PG8_STAGE(PG8_SA(0, 1), a2 + hstep, voffA);
            PG8_WAIT_L(8); PG8_BAR; PG8_WAIT_L(0); PG8_MMA(0, 0, At, B0); PG8_BAR; PG8_SCHED;
            PG8_LDB(B1, 1, 1); PG8_STAGE(PG8_SB(1, 0), b3, voffB);
            PG8_BAR; PG8_WAIT_L(0); PG8_MMA(0, 1, At, B1); PG8_BAR;
            PG8_LDA(At, 1, 1); PG8_STAGE(PG8_SA(1, 0), a3, voffA);
            PG8_BAR; PG8_WAIT_L(0); PG8_MMA(1, 0, At, B0); PG8_BAR; PG8_SCHED;
            PG8_STAGE(PG8_SB(1, 1), b3 + hstep, voffB);
            PG8_WAIT_V(6); PG8_BAR; PG8_MMA(1, 1, At, B1); PG8_BAR;
            }
        }
        if constexpr (ALIGN_EPI) { if (wr == 0) PG8_BAR; }
        if constexpr (!Epi::AFTER_DRAIN) { E(acc, cur, wr, wc, fr, fq); S.done(cur); }
        if (!has_next) break;
#pragma unroll
        for (int a = 0; a < 2; ++a)
#pragma unroll
            for (int b = 0; b < 2; ++b)
#pragma unroll
                for (int m = 0; m < 4; ++m)
#pragma unroll
                    for (int n = 0; n < 2; ++n) acc[a][b][m][n] = (f32x4){0.f, 0.f, 0.f, 0.f};
        cur = nxt; cA = nA; cB = nB; ++ui;
        if constexpr (ALIGN_EPI) { if (wr == 1) PG8_BAR; }
    }
    PG8_WAIT_V(0);
    if constexpr (!ALIGN_EPI) { if (wr == 0) PG8_BAR; }
    PG8_BAR;
#undef PG8_SA
#undef PG8_SB
#undef PG8_STAGE
#undef PG8_LDA
#undef PG8_LDB
#undef PG8_MMA
#undef PG8_WAIT_V
#undef PG8_WAIT_L
#undef PG8_BAR
#undef PG8_SCHED
}
}

#define XB_TMO      128
#define XB_XCNT(j)  (256  + 64 * (j))
#define XB_XSUB(j)  (1280 + 64 * (j))
#define XB_XGEN(j)  (2304 + 64 * (j))
#define XB_TOP      3328
#define XB_TOPGEN   3392
#define XCD_BAR_WORDS 3456
#define XB_SPIN_CAP (1u << 18)
__device__ __forceinline__ unsigned xb_ld(unsigned* p)              { return __hip_atomic_load(p, __ATOMIC_RELAXED, __HIP_MEMORY_SCOPE_AGENT); }
__device__ __forceinline__ unsigned xb_add(unsigned* p, unsigned v) { return __hip_atomic_fetch_add(p, v, __ATOMIC_RELAXED, __HIP_MEMORY_SCOPE_AGENT); }
__device__ __forceinline__ unsigned xb_xcc_id() { return (unsigned)__builtin_amdgcn_s_getreg((3 << 11) | 20) & 0xFu; }
#define XB_SPIN(cond, bar) do { unsigned _sp = 0; while (cond) { __builtin_amdgcn_s_sleep(1); \
    if ((++_sp & 255u) == 0u) { if (xb_ld(&(bar)[XB_TMO])) break; if (_sp > XB_SPIN_CAP) { atomicAdd(&(bar)[XB_TMO], 1u); break; } } } } while (0)
struct XcdBarrier { unsigned* bar; unsigned x; volatile LAS unsigned* st; };
__device__ __forceinline__ XcdBarrier xcd_barrier_post(unsigned* bar, volatile LAS unsigned* st) {
    XcdBarrier b; b.bar = bar; b.x = xb_xcc_id(); b.st = st;
    if (threadIdx.x == 0) (void)xb_add(&bar[XB_XCNT(b.x)], 1u);
    return b;
}
__device__ __forceinline__ void xcd_barrier_complete(unsigned* bar, unsigned x, unsigned& nloc, unsigned& nx) {
    const unsigned G = gridDim.x * gridDim.y * gridDim.z;
    unsigned sum, cnt, mine, sp = 0u;
    for (;;) {
        sum = 0u; cnt = 0u; mine = 0u;
#pragma unroll
        for (unsigned j = 0; j < 16; ++j) { const unsigned c = xb_ld(&bar[XB_XCNT(j)]); sum += c; cnt += (c > 0u) ? 1u : 0u; mine = (j == x) ? c : mine; }
        if (sum == G) break;
        __builtin_amdgcn_s_sleep(1);
        if ((++sp & 255u) == 0u) { if (xb_ld(&bar[XB_TMO])) break; if (sp > XB_SPIN_CAP) { atomicAdd(&bar[XB_TMO], 1u); break; } }
    }
    nloc = mine > 0u ? mine : 1u; nx = cnt > 0u ? cnt : 1u;
}
__device__ __forceinline__ void xcd_barrier(const XcdBarrier& b) {
    asm volatile("s_waitcnt vmcnt(0)" ::: "memory");
    __syncthreads();
    if (threadIdx.x == 0) {
        unsigned* bar = b.bar;
        __builtin_amdgcn_s_waitcnt(0);
        unsigned nloc = b.st[0], nx = b.st[1];
        if (nloc == 0u) { xcd_barrier_complete(bar, b.x, nloc, nx); b.st[0] = nloc; b.st[1] = nx; }
        const unsigned old = xb_add(&bar[XB_XSUB(b.x)], 1u);
        const unsigned gen = old / nloc;
        if (old + 1u == (gen + 1u) * nloc) {
            __builtin_amdgcn_fence(__ATOMIC_RELEASE, "agent");
            asm volatile("s_waitcnt vmcnt(0)" ::: "memory");
            const unsigned og = xb_add(&bar[XB_TOP], 1u);
            const unsigned tg = og / nx;
            if (og + 1u == (tg + 1u) * nx) xb_add(&bar[XB_TOPGEN], 1u);
            else XB_SPIN(xb_ld(&bar[XB_TOPGEN]) == tg, bar);
            __builtin_amdgcn_fence(__ATOMIC_ACQUIRE, "agent");
            xb_add(&bar[XB_XGEN(b.x)], 1u);
            asm volatile("s_waitcnt vmcnt(0)" ::: "memory");
        } else {
            XB_SPIN(xb_ld(&bar[XB_XGEN(b.x)]) == gen, bar);
            __builtin_amdgcn_fence(__ATOMIC_ACQUIRE, "agent");
            asm volatile("s_waitcnt vmcnt(0)" ::: "memory");
        }
    }
    __syncthreads();
}

#define LDS_WAIT() asm volatile("s_waitcnt lgkmcnt(0)" ::: "memory")
#define SBAR() __builtin_amdgcn_sched_barrier(0)
__device__ __forceinline__ float wave_sum(float v) {
#pragma unroll
    for (int o = 1; o < 64; o <<= 1) v += __shfl_xor(v, o);
    return v;
}
__device__ __forceinline__ unsigned cvtpk(float lo, float hi) { return pg8::cvt_pk_bf16(lo, hi); }
__device__ __forceinline__ float bf_lo(unsigned w) { return __uint_as_float(w << 16); }
__device__ __forceinline__ float bf_hi(unsigned w) { return __uint_as_float(w & 0xffff0000u); }

struct Frame {
    unsigned char* lds; LAS unsigned char* ldsl;
    int tid, lane, wave, vcu, G, gw, NGW;
};
#if PROBE_MASK
#define STAMP(type) do { if (blockIdx.x == 0 && F.tid == 0) { const unsigned long long now_ = __builtin_amdgcn_s_memrealtime(); volatile LAS unsigned long long* pa_ = (volatile LAS unsigned long long*)(F.ldsl + MISC_OFF + 64); pa_[type] += now_ - pa_[15]; pa_[15] = now_; } } while (0)
#else
#define STAMP(type) do { } while (0)
#endif
#define RELAUNDER() do { int t_ = threadIdx.x; asm volatile("" : "+v"(t_)); F.tid = t_; F.lane = t_ & 63; F.wave = __builtin_amdgcn_readfirstlane(t_ >> 6); F.gw = F.vcu * 8 + F.wave; } while (0)

struct CvItem { const float* src; bf16_t* dst; const float* gain; int K, N, kind, k0, n0; };
__device__ __forceinline__ int cv_rowmap(int kind, int n) {
    if (kind == 1 || kind == 2) return 256 * (n >> 7) + (kind - 1) * 128 + (n & 127);
    if (kind == 3) return n < 2560 ? n : (n < 2584 ? 5632 + (n - 2560) : (n < 5656 ? n - 24 : n));
    if (kind == 4) return 256 + n;
    return n;
}
__device__ __forceinline__ void cv_load(const CvItem& c, float (&v)[32], int lane) {
    const float* p = c.src + (size_t)(c.k0 + (lane >> 5)) * c.N + c.n0 + (lane & 31);
#pragma unroll
    for (int i = 0; i < 32; ++i) v[i] = __builtin_nontemporal_load(p + (size_t)(2 * i) * c.N);
}
__device__ __forceinline__ void cv_store(const CvItem& c, const float (&v)[32], LAS float* scr, int lane) {
#pragma unroll
    for (int i = 0; i < 32; ++i) scr[(2 * i + (lane >> 5)) * 33 + (lane & 31)] = v[i];
    LDS_WAIT(); asm volatile("" ::: "memory");
    const int cc = lane & 7;
    f32x4 ga = {1.f, 1.f, 1.f, 1.f}, gb = ga;
    if (c.gain) { ga = *(const f32x4*)(c.gain + c.k0 + 8 * cc); gb = *(const f32x4*)(c.gain + c.k0 + 8 * cc + 4); }
#pragma unroll
    for (int j = 0; j < 4; ++j) { const int n = (lane >> 3) + 8 * j; const LAS float* s = scr + (8 * cc) * 33 + n;
        u32x4 o; o.x = cvtpk(s[0 * 33] * ga.x, s[1 * 33] * ga.y); o.y = cvtpk(s[2 * 33] * ga.z, s[3 * 33] * ga.w); o.z = cvtpk(s[4 * 33] * gb.x, s[5 * 33] * gb.y); o.w = cvtpk(s[6 * 33] * gb.z, s[7 * 33] * gb.w);
        __builtin_nontemporal_store(o, (u32x4*)(c.dst + (size_t)cv_rowmap(c.kind, c.n0 + n) * c.K + c.k0 + 8 * cc)); }
    LDS_WAIT(); asm volatile("" ::: "memory");
}
__device__ __forceinline__ void prenorm_row(const float* xrow, const float* g, bf16_t* orow, float* rs, int lane) {
    const f32x4* xr = (const f32x4*)xrow + lane; f32x4 v[8]; float s = 0.f;
#pragma unroll
    for (int j = 0; j < 8; ++j) { v[j] = xr[64 * j]; s += (v[j].x * v[j].x + v[j].y * v[j].y) + (v[j].z * v[j].z + v[j].w * v[j].w); }
    s = wave_sum(s);
    (void)g; u32x2* o8 = (u32x2*)orow + lane;
#pragma unroll
    for (int j = 0; j < 8; ++j) { u32x2 w; w.x = cvtpk(v[j].x, v[j].y); w.y = cvtpk(v[j].z, v[j].w); o8[64 * j] = w; }
    if (lane < 32) rs[lane] = lane == 0 ? s : 0.f;
}
__device__ __forceinline__ float rope_inv(int i) {
    constexpr float tab[16] = {1.000000000e+00f, 4.403665960e-01f, 1.939227432e-01f, 8.539710194e-02f, 3.760603070e-02f, 1.656043902e-02f, 7.292664610e-03f, 3.211445874e-03f, 1.414213562e-03f, 6.227723788e-04f, 2.742481884e-04f, 1.207697351e-04f, 5.318296098e-05f, 2.341999971e-05f, 1.031338616e-05f, 4.541670478e-06f};
    float v = tab[0];
#pragma unroll
    for (int k = 1; k < 16; ++k) v = (i == k) ? tab[k] : v;
    return v;
}
__device__ __forceinline__ CvItem cv_decode(int it, int L) {
    const size_t wset = (size_t)(L & 1) * WSET;
    constexpr int I_G = (DM / 64) * (DFF / 32);
    constexpr int I_IN = (DM / 64) * (PROJ_COLS / 32);
    constexpr int I_O = (DM / 64) * (DM / 32);
    constexpr int I_C = (4096 / 64) * (256 / 32);
    unsigned char* ws = arg_ws() + wset; CvItem c; int r = it;
    if (r < 6 * I_G) { const int w = r / I_G; r -= w * I_G; const int ffn = w / 3, part = w % 3;
        c.gain = nullptr;
        if (part < 2) { c.src = arg_in((ffn ? 19 : 2) + part) + (size_t)L * DM * DFF; c.dst = (bf16_t*)(ws + (ffn ? WS_WGU2 : WS_WGU)); c.K = DM; c.N = DFF; c.kind = 1 + part; c.gain = arg_in(ffn ? 18 : 1) + L * DM; }
        else { c.src = arg_in(ffn ? 21 : 4) + (size_t)L * DFF * DM; c.dst = (bf16_t*)(ws + (ffn ? WS_WD2 : WS_WD)); c.K = DFF; c.N = DM; c.kind = 0; } }
    else { r -= 6 * I_G; c.gain = nullptr;
        if (r < I_IN) { c.src = arg_in(6) + (size_t)L * DM * PROJ_COLS; c.dst = (bf16_t*)(ws + WS_WIN); c.K = DM; c.N = PROJ_COLS; c.kind = 3; c.gain = arg_in(5) + L * DM; }
        else { r -= I_IN;
            if (r < I_O) { c.src = arg_in(17) + (size_t)L * DM * DM; c.dst = (bf16_t*)(ws + WS_WOUT); c.K = DM; c.N = DM; c.kind = 0; c.gain = (r / (DM / 32)) * 64 < 1024 ? arg_in(12) + L * 1024 : arg_in(16) + L * 1024 - 1024; }
            else { r -= I_O; const int which = r / I_C; r -= which * I_C;
                c.src = arg_in(10) + ((size_t)L * 2 + which) * 4096 * 256; c.dst = (bf16_t*)(ws + WS_WC1); c.K = 4096; c.N = 256; c.kind = which ? 4 : 0; } } }
    const int nblk = c.N / 32, kb = r / nblk, nb = r - kb * nblk; c.k0 = 64 * kb; c.n0 = 32 * nb;
    return c;
}
__device__ __forceinline__ void phase_convert(Frame& F, int L, int gw, int ngw) {
    LAS float* scr = (LAS float*)(F.ldsl + F.wave * 16384);
    constexpr int NITEMS = 6 * 5632 + 5664 + 2048 + 2 * 512;
    int it = gw;
    if (it < NITEMS) {
        CvItem c = cv_decode(it, L); float va[32]; cv_load(c, va, F.lane);
        for (;;) {
            const int nx = it + ngw; const bool has = nx < NITEMS; CvItem cn = c; float vb[32];
            if (has) { cn = cv_decode(nx, L); cv_load(cn, vb, F.lane); }
            cv_store(c, va, scr, F.lane);
            if (!has) break;
            c = cn; it = nx;
#pragma unroll
            for (int i = 0; i < 32; ++i) va[i] = vb[i];
        }
    }
    if (L == 0) {
        float* rc = (float*)(arg_ws() + WS_ROPE); float* rs = rc + T * 16;
        for (int idx = blockIdx.x * 512 + F.tid; idx < T * 16; idx += F.G * 512) { const int t = idx >> 4, i = idx & 15;
            const float ang = (float)t * rope_inv(i); rc[idx] = cosf(ang); rs[idx] = sinf(ang); }
    }
}
__device__ __forceinline__ void phase_prenorm(Frame& F, const float* x, const float* g, bf16_t* o, float* rs) {
    for (int m = F.gw; m < M; m += F.NGW) prenorm_row(x + (size_t)m * DM, g, o + (size_t)m * DM, rs + (size_t)m * 32, F.lane);
}

__device__ __forceinline__ float log_sigmoid_f(float x) { return x >= 0.f ? -log1pf(expf(-x)) : x - log1pf(expf(x)); }
__device__ __forceinline__ void phase_prep(Frame& F, int L) {
    unsigned char* ws = arg_ws();
    bf16_t* HID = (bf16_t*)(ws + WS_HID); float* GF = (float*)(ws + WS_GF);
    const float* rc = (const float*)(ws + WS_ROPE); const float* rs = rc + T * 16; float* LF = (float*)(ws + WS_LF);
    const int lane = F.lane, sub = lane >> 4, l16 = lane & 15;
    {
        bf16_t* CA = (bf16_t*)(ws + WS_CMPA);
        for (int r = F.gw; r < 2 * 4064; r += F.NGW) {
            const int which = r >= 4064 ? 1 : 0, rr = r - which * 4064, h = rr & 1, bc = rr >> 1, b = bc / NCMP, c = bc - b * NCMP;
            const bf16_t* src = HID + ((size_t)b * T + 16 * c) * LDP + C_KV + which * 256 + h * 128 + l16 * 8;
            const float* pe = arg_in(9) + ((size_t)(L * 2 + which) * 32) * 128 + l16 * 8;
            bf16_t* dst = CA + ((size_t)which * 4096 + rr) * 4096 + l16 * 8;
#pragma unroll
            for (int it = 0; it < 8; ++it) { const int l = 4 * it + sub;
                const u32x4 w = *(const u32x4*)(src + (size_t)l * LDP); const f32x4 p0 = *(const f32x4*)(pe + l * 128), p1 = *(const f32x4*)(pe + l * 128 + 4);
                u32x4 o; o.x = cvtpk(bf_lo(w.x) + p0.x, bf_hi(w.x) + p0.y); o.y = cvtpk(bf_lo(w.y) + p0.z, bf_hi(w.y) + p0.w);
                o.z = cvtpk(bf_lo(w.z) + p1.x, bf_hi(w.z) + p1.y); o.w = cvtpk(bf_lo(w.w) + p1.z, bf_hi(w.w) + p1.w);
                *(u32x4*)(dst + l * 128) = o; }
        }
    }
    const float* gk1 = arg_in(8) + (L * 3 + 1) * 128; const float* gk2 = arg_in(8) + (L * 3 + 2) * 128; const float* gfk = arg_in(14) + L * 128;
    int col[3]; const float* gp[3];
    col[0] = C_KV + (sub < 2 ? 512 + sub * 128 : 1024 + (sub - 2) * 128) + l16 * 8; gp[0] = sub < 2 ? gk1 : gk2;
    col[1] = C_FK + sub * 128 + l16 * 8; gp[1] = gfk; col[2] = C_FK + (4 + sub) * 128 + l16 * 8; gp[2] = gfk;
    const float fbias = (lane >= 24 && lane < 32) ? arg_in(15)[L * 8 + lane - 24] : 0.f;
    u32x4 wa[3]; float gfa = 0.f;
    int m = F.gw;
    if (m < M) {
#pragma unroll
        for (int it = 0; it < 3; ++it) wa[it] = *(const u32x4*)(HID + (size_t)m * LDP + col[it]);
        if (lane < 32) gfa = GF[(size_t)m * 32 + lane];
    }
    while (m < M) {
        const int mn = m + F.NGW; u32x4 wb[3]; float gfb = 0.f;
        if (mn < M) {
#pragma unroll
            for (int it = 0; it < 3; ++it) wb[it] = *(const u32x4*)(HID + (size_t)mn * LDP + col[it]);
            if (lane < 32) gfb = GF[(size_t)mn * 32 + lane];
        }
        __builtin_amdgcn_sched_barrier(0);
        const int t = m & (T - 1);
        bf16_t* prow = HID + (size_t)m * LDP;
#pragma unroll
        for (int it = 0; it < 3; ++it) {
            const u32x4 w = wa[it];
            float x[8] = {bf_lo(w.x), bf_hi(w.x), bf_lo(w.y), bf_hi(w.y), bf_lo(w.z), bf_hi(w.z), bf_lo(w.w), bf_hi(w.w)};
            float ss = 0.f;
#pragma unroll
            for (int e = 0; e < 8; ++e) ss += x[e] * x[e];
            ss += __shfl_xor(ss, 1); ss += __shfl_xor(ss, 2); ss += __shfl_xor(ss, 4); ss += __shfl_xor(ss, 8);
            const float r = 1.0f / sqrtf(ss * (1.0f / 128.f) + EPS);
            const f32x4 g0 = *(const f32x4*)(gp[it] + l16 * 8), g1 = *(const f32x4*)(gp[it] + l16 * 8 + 4);
            x[0] *= r * g0.x; x[1] *= r * g0.y; x[2] *= r * g0.z; x[3] *= r * g0.w; x[4] *= r * g1.x; x[5] *= r * g1.y; x[6] *= r * g1.z; x[7] *= r * g1.w;
            if (it == 0) {
                const int fi = (l16 & 1) * 8;
                const f32x4 c0 = *(const f32x4*)(rc + t * 16 + fi), c1 = *(const f32x4*)(rc + t * 16 + fi + 4);
                const f32x4 s0 = *(const f32x4*)(rs + t * 16 + fi), s1 = *(const f32x4*)(rs + t * 16 + fi + 4);
                const float cc[8] = {c0.x, c0.y, c0.z, c0.w, c1.x, c1.y, c1.z, c1.w}, sn[8] = {s0.x, s0.y, s0.z, s0.w, s1.x, s1.y, s1.z, s1.w};
#pragma unroll
                for (int e = 0; e < 8; ++e) { const float other = __shfl_xor(x[e], 2);
                    const float ro = (l16 & 2) ? (x[e] * cc[e] + other * sn[e]) : (x[e] * cc[e] - other * sn[e]);
                    if (l16 < 4) x[e] = ro; }
            }
            u32x4 o; o.x = cvtpk(x[0], x[1]); o.y = cvtpk(x[2], x[3]); o.z = cvtpk(x[4], x[5]); o.w = cvtpk(x[6], x[7]);
            *(u32x4*)(prow + col[it]) = o;
        }
        if (lane < 24) GF[(size_t)m * 32 + lane] = 1.0f / (1.0f + expf(-gfa));
        else if (lane < 32) LF[((size_t)(m >> 11) * 8 + (lane - 24)) * T + t] = log_sigmoid_f(gfa + fbias);
#pragma unroll
        for (int it = 0; it < 3; ++it) wa[it] = wb[it];
        gfa = gfb; m = mn;
    }
}

__device__ __forceinline__ void phase_scan(Frame& F) {
    if (blockIdx.x < 32) return;
    const int sw = ((int)blockIdx.x - 32) * 8 + F.wave; if (sw >= NB * 8) return;
    const int lane = F.lane;
    const f32x4* src = (const f32x4*)((const float*)(arg_ws() + WS_LF) + (size_t)sw * T + lane * 32);
    f32x4 v[8]; float s = 0.f;
#pragma unroll
    for (int i = 0; i < 8; ++i) { v[i] = src[i]; s += (v[i].x + v[i].y) + (v[i].z + v[i].w); }
    float inc = s;
#pragma unroll
    for (int o = 1; o < 64; o <<= 1) { const float tt = __shfl_up(inc, o); if (lane >= o) inc += tt; }
    float run = inc - s;
    f32x4* dst = (f32x4*)((float*)(arg_ws() + WS_CUM) + (size_t)sw * T + lane * 32);
#pragma unroll
    for (int i = 0; i < 8; ++i) { f32x4 o; run += v[i].x; o.x = run; run += v[i].y; o.y = run; run += v[i].z; o.z = run; run += v[i].w; o.w = run; dst[i] = o; }
}

__device__ __forceinline__ void phase_cmp2(Frame& F, int L) {
    unsigned char* ws = arg_ws(); const int lane = F.lane;
    const bf16_t* CH = (const bf16_t*)(ws + WS_CMPH);
    const float* rc = (const float*)(ws + WS_ROPE); const float* rs = rc + T * 16;
    const float* gk0 = arg_in(8) + (L * 3 + 0) * 128;
    for (int it = F.gw; it < 2032 + 64; it += F.NGW) {
        if (it >= 2032) {
            const int z = it - 2032, which = z >> 5, bh = z & 31;
            bf16_t* dst = (bf16_t*)(ws + (which ? WS_VC : WS_KC)) + ((size_t)bh * 128 + 127) * 128;
            *(unsigned*)(dst + 2 * lane) = 0u; continue;
        }
        const int r0 = it * 4, which = r0 >= 4064 ? 1 : 0;
        const float* w2 = arg_in(11) + (size_t)(L * 2 + which) * 256 * 128;
        LAS float* hs = (LAS float*)(F.ldsl + F.wave * 16384);
#pragma unroll
        for (int q = 0; q < 4; ++q) { const int rr = r0 - which * 4064 + q; const u32x2 w = *(const u32x2*)(CH + ((size_t)which * 4096 + rr) * 256 + 4 * lane);
            *(LAS f32x4*)(hs + q * 256 + 4 * lane) = (f32x4){bf_lo(w.x), bf_hi(w.x), bf_lo(w.y), bf_hi(w.y)}; }
        asm volatile("s_waitcnt lgkmcnt(0)" ::: "memory");
        float a[4][2] = {};
#pragma unroll 8
        for (int kk = 0; kk < 64; ++kk) {
            f32x4 hq[4];
#pragma unroll
            for (int q = 0; q < 4; ++q) hq[q] = *(const LAS f32x4*)(hs + q * 256 + 4 * kk);
#pragma unroll
            for (int j = 0; j < 4; ++j) { const f32x2 wv = *(const f32x2*)(w2 + (size_t)(kk * 4 + j) * 128 + 2 * lane);
#pragma unroll
                for (int q = 0; q < 4; ++q) { a[q][0] += hq[q][j] * wv.x; a[q][1] += hq[q][j] * wv.y; } }
        }
        asm volatile("s_waitcnt lgkmcnt(0)" ::: "memory");
#pragma unroll
        for (int q = 0; q < 4; ++q) { const int rr = r0 - which * 4064 + q, h = rr & 1, bc = rr >> 1, b = bc / NCMP, c = bc - b * NCMP;
            float y0 = a[q][0], y1 = a[q][1];
            if (which == 0) {
                const float ss = wave_sum(y0 * y0 + y1 * y1); const float r = 1.0f / sqrtf(ss * (1.0f / 128.f) + EPS);
                const f32x2 g = *(const f32x2*)(gk0 + 2 * lane); y0 *= r * g.x; y1 *= r * g.y;
                const int pos = 16 * c + 31; const int fi = 2 * (lane & 7);
                const f32x2 cc = *(const f32x2*)(rc + pos * 16 + fi), sn = *(const f32x2*)(rs + pos * 16 + fi);
                const float o0 = __shfl_xor(y0, 8), o1 = __shfl_xor(y1, 8);
                if (lane < 8) { y0 = y0 * cc.x - o0 * sn.x; y1 = y1 * cc.y - o1 * sn.y; }
                else if (lane < 16) { y0 = y0 * cc.x + o0 * sn.x; y1 = y1 * cc.y + o1 * sn.y; }
            }
            bf16_t* dst = (bf16_t*)(ws + (which ? WS_VC : WS_KC)) + ((size_t)(b * 2 + h) * 128 + c) * 128;
            *(unsigned*)(dst + 2 * lane) = cvtpk(y0, y1);
        }
    }
}

__device__ __forceinline__ void unpack8(const u32x4 w, float* x) { x[0] = bf_lo(w.x); x[1] = bf_hi(w.x); x[2] = bf_lo(w.y); x[3] = bf_hi(w.y); x[4] = bf_lo(w.z); x[5] = bf_hi(w.z); x[6] = bf_lo(w.w); x[7] = bf_hi(w.w); }
__device__ __forceinline__ void phase_outnorm(Frame& F, int L) {
    (void)L;
    unsigned char* ws = arg_ws();
    bf16_t* HN = (bf16_t*)(ws + WS_HN); const int lane = F.lane;
    const bf16_t* N0 = (const bf16_t*)(ws + WS_NSA0); const bf16_t* N1 = (const bf16_t*)(ws + WS_NSA1); const bf16_t* N2 = (const bf16_t*)(ws + WS_NSA2);
    u32x4 wa[8];
    int m = F.gw;
#define ONORM_LOAD(w, mm) do { const size_t off_ = (size_t)(mm) * 1024 + (size_t)lane * 8; \
        w[0] = *(const u32x4*)(N0 + off_); w[1] = *(const u32x4*)(N1 + off_); w[2] = *(const u32x4*)(N2 + off_); \
        w[3] = *(const u32x4*)(N0 + off_ + 512); w[4] = *(const u32x4*)(N1 + off_ + 512); w[5] = *(const u32x4*)(N2 + off_ + 512); \
        w[6] = ((const u32x4*)(HN + (size_t)(mm) * DM))[lane + 128]; w[7] = ((const u32x4*)(HN + (size_t)(mm) * DM))[lane + 192]; } while (0)
    if (m < M) ONORM_LOAD(wa, m);
    while (m < M) {
        const int mn = m + F.NGW; u32x4 wb[8];
        if (mn < M) ONORM_LOAD(wb, mn);
        __builtin_amdgcn_sched_barrier(0);
        float x[4][8]; float sa = 0.f, sb = 0.f;
#pragma unroll
        for (int j = 0; j < 4; ++j) {
            if (j < 2) { float y0[8], y1[8], y2[8]; unpack8(wa[3 * j], y0); unpack8(wa[3 * j + 1], y1); unpack8(wa[3 * j + 2], y2);
#pragma unroll
                for (int e = 0; e < 8; ++e) x[j][e] = y0[e] + y1[e] + y2[e]; }
            else unpack8(wa[4 + j], x[j]);
            float s = 0.f;
#pragma unroll
            for (int e = 0; e < 8; ++e) s += x[j][e] * x[j][e];
            if (j < 2) sa += s; else sb += s; }
        const float ra = 1.0f / sqrtf(wave_sum(sa) * (1.0f / 1024.f) + EPS), rb = 1.0f / sqrtf(wave_sum(sb) * (1.0f / 1024.f) + EPS);
        u32x4* row = (u32x4*)(HN + (size_t)m * DM) + lane;
#pragma unroll
        for (int j = 0; j < 4; ++j) { const float r = j < 2 ? ra : rb;
            u32x4 o; o.x = cvtpk(x[j][0] * r, x[j][1] * r); o.y = cvtpk(x[j][2] * r, x[j][3] * r); o.z = cvtpk(x[j][4] * r, x[j][5] * r); o.w = cvtpk(x[j][6] * r, x[j][7] * r);
            row[64 * j] = o; }
#pragma unroll
        for (int i = 0; i < 8; ++i) wa[i] = wb[i];
        m = mn;
    }
#undef ONORM_LOAD
}

namespace att {
constexpr int SHM_V = 16384, SHM_K = 16384;
constexpr int OFF_V = 0, OFF_K = 3 * SHM_V, OFF_WS = 81920, OFF_BIAS = OFF_WS + 2048, OFF_PG = 86016, OFF_SC = OFF_PG + 32768, OFF_SEL = OFF_SC + 8192, OFF_UNI = OFF_SEL + 256;
static_assert(OFF_UNI + 16 <= 131072, "attention LDS map");
typedef LAS char* lptr;
#define KSWZ(row, colB) ((row) * 256 + ((colB) ^ (((row) & 7) << 4)))
__device__ __forceinline__ int v_st(int k, int c) { const int kk = (k & ~0xC) | ((k & 4) << 1) | ((k & 8) >> 1); return ((kk >> 3) * 4 + (c >> 5)) * 512 + ((kk & 7) * 32 + (c & 31)) * 2; }
__device__ __forceinline__ int v_rd_base(int lane) { return ((lane & 3) << 3) | (((lane >> 2) & 3) << 6) | (((lane >> 4) & 1) << 5) | (((lane >> 5) & 1) << 8); }
constexpr int v_rd_off(int d0, int ks, int half) { return d0 * 512 + ks * 4096 + half * 2048; }
__device__ __forceinline__ int crow(int r, int hi) { return (r & 3) + 8 * (r >> 2) + 4 * hi; }

__device__ __forceinline__ void qkt(f32x16& p0, f32x16& p1, lptr lds, int kbuf, int r32, int hi, const bf16x8* qr) {
    p0 = f32x16{}; p1 = f32x16{};
    lptr kb[4];
#pragma unroll
    for (int dd = 0; dd < 4; ++dd) kb[dd] = lds + OFF_K + kbuf * SHM_K + KSWZ(r32, (dd * 16 + hi * 8) * 2);
    bf16x8 ka[3], kc[3];
    ka[0] = *reinterpret_cast<const LAS bf16x8*>(kb[0]); kc[0] = *reinterpret_cast<const LAS bf16x8*>(kb[0] + 32 * 256);
    ka[1] = *reinterpret_cast<const LAS bf16x8*>(kb[1]); kc[1] = *reinterpret_cast<const LAS bf16x8*>(kb[1] + 32 * 256);
#pragma unroll
    for (int d0 = 0; d0 < 8; ++d0) {
        if (d0 + 2 < 8) { lptr a = kb[(d0 + 2) & 3] + ((d0 + 2) >> 2) * 128; ka[(d0 + 2) % 3] = *reinterpret_cast<const LAS bf16x8*>(a); kc[(d0 + 2) % 3] = *reinterpret_cast<const LAS bf16x8*>(a + 32 * 256); }
        p0 = __builtin_amdgcn_mfma_f32_32x32x16_bf16(ka[d0 % 3], qr[d0], p0, 0, 0, 0);
        p1 = __builtin_amdgcn_mfma_f32_32x32x16_bf16(kc[d0 % 3], qr[d0], p1, 0, 0, 0); }
}
template <int VB>
__device__ __forceinline__ void pv_tile(f32x16* o, int vb0, bf16x8 pa0, bf16x8 pa1, bf16x8 pa2, bf16x8 pa3) {
#define TRRD(dst, off) asm volatile("ds_read_b64_tr_b16 %0, %1 offset:%2" : "=&v"(dst) : "v"(vb0), "i"(off) : "memory")
#define PV_D0(d0) do { s16x4 l0, l1, l2, l3, h0, h1, h2, h3; constexpr int b_ = VB * SHM_V + v_rd_off(d0, 0, 0); \
        TRRD(l0, b_); TRRD(h0, b_ + 2048); TRRD(l1, b_ + 4096); TRRD(h1, b_ + 6144); TRRD(l2, b_ + 8192); TRRD(h2, b_ + 10240); TRRD(l3, b_ + 12288); TRRD(h3, b_ + 14336); \
        asm volatile("s_waitcnt lgkmcnt(0)" ::: "memory"); SBAR(); \
        o[d0] = __builtin_amdgcn_mfma_f32_32x32x16_bf16(pa0, (bf16x8){l0[0], l0[1], l0[2], l0[3], h0[0], h0[1], h0[2], h0[3]}, o[d0], 0, 0, 0);   \
        o[d0] = __builtin_amdgcn_mfma_f32_32x32x16_bf16(pa1, (bf16x8){l1[0], l1[1], l1[2], l1[3], h1[0], h1[1], h1[2], h1[3]}, o[d0], 0, 0, 0);   \
        o[d0] = __builtin_amdgcn_mfma_f32_32x32x16_bf16(pa2, (bf16x8){l2[0], l2[1], l2[2], l2[3], h2[0], h2[1], h2[2], h2[3]}, o[d0], 0, 0, 0);   \
        o[d0] = __builtin_amdgcn_mfma_f32_32x32x16_bf16(pa3, (bf16x8){l3[0], l3[1], l3[2], l3[3], h3[0], h3[1], h3[2], h3[3]}, o[d0], 0, 0, 0); } while (0)
    PV_D0(0); PV_D0(1); PV_D0(2); PV_D0(3);
#undef PV_D0
#undef TRRD
}
__device__ __forceinline__ float xhalf_max(float x) { auto rr = __builtin_amdgcn_permlane32_swap(__float_as_uint(x), __float_as_uint(x), false, false); return fmaxf(__uint_as_float(rr[0]), __uint_as_float(rr[1])); }
__device__ __forceinline__ float xhalf_sum(float x) { auto rr = __builtin_amdgcn_permlane32_swap(__float_as_uint(x), __float_as_uint(x), false, false); return __uint_as_float(rr[0]) + __uint_as_float(rr[1]); }
#define PK4(P, B_, OUT) do { unsigned xa0_ = cvtpk(P[B_+0], P[B_+1]), xa1_ = cvtpk(P[B_+2], P[B_+3]);                          \
        unsigned xb0_ = cvtpk(P[B_+4], P[B_+5]), xb1_ = cvtpk(P[B_+6], P[B_+7]);                                             \
        auto xr0_ = __builtin_amdgcn_permlane32_swap(xa0_, xb0_, false, false); auto xr1_ = __builtin_amdgcn_permlane32_swap(xa1_, xb1_, false, false); \
        u32x4 xw_ = {xr0_[0], xr1_[0], xr0_[1], xr1_[1]}; OUT = *reinterpret_cast<bf16x8*>(&xw_); } while (0)
__device__ __forceinline__ void scale_rows(f32x16* o, LAS float* tab, float v, int r32, int hi) {
    if (hi == 0) tab[r32] = v;
    asm volatile("s_waitcnt lgkmcnt(0)" ::: "memory");
#pragma unroll
    for (int g4 = 0; g4 < 4; ++g4) { const f32x4 f = *(const LAS f32x4*)(tab + 8 * g4 + 4 * hi);
#pragma unroll
        for (int e = 0; e < 4; ++e)
#pragma unroll
            for (int d = 0; d < 4; ++d) o[d][4 * g4 + e] *= f[e]; }
    asm volatile("s_waitcnt lgkmcnt(0)" ::: "memory");
}
__device__ __forceinline__ void softmax_pv(f32x16& p0, f32x16& p1, f32x16* o, float& m, float& l, int vb0, LAS float* tab, int r32, int hi) {
    float pmax = p0[0];
#pragma unroll
    for (int r = 1; r < 16; ++r) pmax = fmaxf(pmax, p0[r]);
#pragma unroll
    for (int r = 0; r < 16; ++r) pmax = fmaxf(pmax, p1[r]);
    pmax = xhalf_max(pmax);
    const float mn = fmaxf(m, pmax);
    if (__any(mn > m)) {
        const float alpha = __builtin_amdgcn_exp2f(m - mn);
        l *= alpha; m = mn;
        scale_rows(o, tab, alpha, r32, hi);
    }
    float ps = 0.f;
#pragma unroll
    for (int r = 0; r < 16; ++r) { p0[r] = __builtin_amdgcn_exp2f(p0[r] - m); ps += p0[r]; }
#pragma unroll
    for (int r = 0; r < 16; ++r) { p1[r] = __builtin_amdgcn_exp2f(p1[r] - m); ps += p1[r]; }
    l += xhalf_sum(ps);
    bf16x8 pa0, pa1, pa2, pa3;
    PK4(p0, 0, pa0); PK4(p0, 8, pa1); PK4(p1, 0, pa2); PK4(p1, 8, pa3);
    SBAR();
    pv_tile<0>(o, vb0, pa0, pa1, pa2, pa3);
}
__device__ __forceinline__ void expsum_pv(f32x16& p0, f32x16& p1, f32x16* o, float& lp, int vb0) {
    float ps = 0.f;
#pragma unroll
    for (int r = 0; r < 16; ++r) { p0[r] = __builtin_amdgcn_exp2f(p0[r]); ps += p0[r]; }
#pragma unroll
    for (int r = 0; r < 16; ++r) { p1[r] = __builtin_amdgcn_exp2f(p1[r]); ps += p1[r]; }
    lp += ps;
    bf16x8 pa0, pa1, pa2, pa3;
    PK4(p0, 0, pa0); PK4(p0, 8, pa1); PK4(p1, 0, pa2); PK4(p1, 8, pa3);
    SBAR();
    pv_tile<0>(o, vb0, pa0, pa1, pa2, pa3);
}
__device__ __forceinline__ float qrow_norm(const bf16x8* qr) {
    float ss = 0.f;
#pragma unroll
    for (int d0 = 0; d0 < 8; ++d0) { const u32x4 w = *reinterpret_cast<const u32x4*>(&qr[d0]);
        ss += (bf_lo(w.x) * bf_lo(w.x) + bf_hi(w.x) * bf_hi(w.x)) + (bf_lo(w.y) * bf_lo(w.y) + bf_hi(w.y) * bf_hi(w.y)) + (bf_lo(w.z) * bf_lo(w.z) + bf_hi(w.z) * bf_hi(w.z)) + (bf_lo(w.w) * bf_lo(w.w) + bf_hi(w.w) * bf_hi(w.w)); }
    return sqrtf(xhalf_sum(ss));
}
template <bool ROPE>
__device__ __forceinline__ void load_q_norm(bf16x8* qr, const bf16_t* qp, const float* g, int hi, int t, const float* rc, const float* rs) {
    float x[8][8]; float ss = 0.f;
#pragma unroll
    for (int d0 = 0; d0 < 8; ++d0) { const u32x4 w = *(const u32x4*)(qp + d0 * 16);
        x[d0][0] = bf_lo(w.x); x[d0][1] = bf_hi(w.x); x[d0][2] = bf_lo(w.y); x[d0][3] = bf_hi(w.y); x[d0][4] = bf_lo(w.z); x[d0][5] = bf_hi(w.z); x[d0][6] = bf_lo(w.w); x[d0][7] = bf_hi(w.w);
#pragma unroll
        for (int j = 0; j < 8; ++j) ss += x[d0][j] * x[d0][j]; }
    ss = xhalf_sum(ss);
    const float r = 1.0f / sqrtf(ss * (1.0f / 128.f) + EPS);
#pragma unroll
    for (int d0 = 0; d0 < 8; ++d0) { const f32x4 ga = *(const f32x4*)(g + d0 * 16 + hi * 8), gb = *(const f32x4*)(g + d0 * 16 + hi * 8 + 4);
        x[d0][0] *= r * ga.x; x[d0][1] *= r * ga.y; x[d0][2] *= r * ga.z; x[d0][3] *= r * ga.w; x[d0][4] *= r * gb.x; x[d0][5] *= r * gb.y; x[d0][6] *= r * gb.z; x[d0][7] *= r * gb.w; }
    if (ROPE) {
        const f32x4 c0 = *(const f32x4*)(rc + t * 16 + hi * 8), c1 = *(const f32x4*)(rc + t * 16 + hi * 8 + 4), s0 = *(const f32x4*)(rs + t * 16 + hi * 8), s1 = *(const f32x4*)(rs + t * 16 + hi * 8 + 4);
        const float cc[8] = {c0.x, c0.y, c0.z, c0.w, c1.x, c1.y, c1.z, c1.w}, sn[8] = {s0.x, s0.y, s0.z, s0.w, s1.x, s1.y, s1.z, s1.w};
#pragma unroll
        for (int j = 0; j < 8; ++j) { const float x1 = x[0][j], x2 = x[1][j]; x[0][j] = x1 * cc[j] - x2 * sn[j]; x[1][j] = x2 * cc[j] + x1 * sn[j]; }
    }
#pragma unroll
    for (int d0 = 0; d0 < 8; ++d0) { u32x4 w; w.x = cvtpk(x[d0][0], x[d0][1]); w.y = cvtpk(x[d0][2], x[d0][3]); w.z = cvtpk(x[d0][4], x[d0][5]); w.w = cvtpk(x[d0][6], x[d0][7]);
        qr[d0] = *reinterpret_cast<bf16x8*>(&w); }
}
struct Stg { bf16x8 k0, k1, v0, v1; };
__device__ __forceinline__ void stg_load(Stg& s, const bf16_t* Kp, const bf16_t* Vp, size_t stride, int sr, int sc) {
    s.k0 = *(const bf16x8*)(Kp + (size_t)sr * stride + sc); s.k1 = *(const bf16x8*)(Kp + (size_t)(32 + sr) * stride + sc);
    s.v0 = *(const bf16x8*)(Vp + (size_t)sr * stride + sc); s.v1 = *(const bf16x8*)(Vp + (size_t)(32 + sr) * stride + sc);
}
__device__ __forceinline__ void stg_write(const Stg& s, lptr lds, int kbuf, int vbuf, int kws, int vst0, int vst1) {
    *(LAS bf16x8*)(lds + OFF_K + kbuf * SHM_K + kws) = s.k0; *(LAS bf16x8*)(lds + OFF_K + kbuf * SHM_K + kws + 32 * 256) = s.k1;
    *(LAS bf16x8*)(lds + OFF_V + vbuf * SHM_V + vst0) = s.v0; *(LAS bf16x8*)(lds + OFF_V + vbuf * SHM_V + vst1) = s.v1;
}
struct Dma { int k[2], v[2]; };
__device__ __forceinline__ Dma dma_offs(int wid, int lane, int stride) {
    Dma d;
#pragma unroll
    for (int i = 0; i < 2; ++i) { const int q = wid + 8 * i;
        { const int r = 4 * q + (lane >> 4), p = lane & 15; d.k[i] = r * stride + ((p ^ (r & 7)) << 3); }
        { const int st = 2 * q + (lane >> 5), kk = (st >> 2) * 8 + ((lane & 31) >> 2), c = (st & 3) * 32 + (lane & 3) * 8;
          const int k = (kk & ~0xC) | ((kk & 4) << 1) | ((kk & 8) >> 1); d.v[i] = k * stride + c; } }
    return d;
}
__device__ __forceinline__ void dma_tile2(const Dma& d, const bf16_t* Kp, const bf16_t* Vp, lptr lds, int kbuf, int vbuf, int wid) {
#pragma unroll
    for (int i = 0; i < 2; ++i) {
        __builtin_amdgcn_global_load_lds((const unsigned*)(Kp + d.k[i]), (LAS unsigned*)(lds + OFF_K + kbuf * SHM_K + (wid + 8 * i) * 1024), 16, 0, 0);
        __builtin_amdgcn_global_load_lds((const unsigned*)(Vp + d.v[i]), (LAS unsigned*)(lds + OFF_V + vbuf * SHM_V + (wid + 8 * i) * 1024), 16, 0, 0); }
}
__device__ __forceinline__ void dma_tile(const Dma& d, const bf16_t* Kp, const bf16_t* Vp, lptr lds, int buf, int wid) {
#pragma unroll
    for (int i = 0; i < 2; ++i) {
        __builtin_amdgcn_global_load_lds((const unsigned*)(Kp + d.k[i]), (LAS unsigned*)(lds + OFF_K + buf * SHM_K + (wid + 8 * i) * 1024), 16, 0, 0);
        __builtin_amdgcn_global_load_lds((const unsigned*)(Vp + d.v[i]), (LAS unsigned*)(lds + OFF_V + buf * SHM_V + (wid + 8 * i) * 1024), 16, 0, 0); }
}
#define DMA_WAIT() asm volatile("s_waitcnt vmcnt(0)" ::: "memory")
#define O_STORE(o, ftab, ROWPTR) do { const bool odd_ = (r32 & 1) != 0; \
    _Pragma("unroll") for (int rp = 0; rp < 8; ++rp) { const int ra_ = crow(2 * rp, hi), rb_ = ra_ + 1; const float fa_ = (ftab)[ra_], fb_ = (ftab)[rb_]; \
        bf16_t* rp_ = odd_ ? (ROWPTR(rb_) + r32 - 1) : (ROWPTR(ra_) + r32); \
        _Pragma("unroll") for (int d0 = 0; d0 < 4; ++d0) { const float va_ = o[d0][2 * rp] * fa_, vb_ = o[d0][2 * rp + 1] * fb_; \
            const float vy_ = __shfl_xor(odd_ ? va_ : vb_, 1); \
            *(unsigned*)(rp_ + d0 * 32) = odd_ ? cvtpk(vy_, vb_) : cvtpk(va_, vy_); } } } while (0)
struct Lanes { int tid, wid, lane, r32, hi, sr, sc, kws, vst0, vst1, vb0; };
__device__ __forceinline__ Lanes mk_lanes(const Frame& F) {
    Lanes a; a.tid = F.tid; a.wid = F.wave; a.lane = F.lane; a.r32 = a.lane & 31; a.hi = a.lane >> 5;
    a.sr = a.tid >> 4; a.sc = (a.tid & 15) * 8; a.kws = KSWZ(a.sr, a.sc * 2); a.vst0 = v_st(a.sr, a.sc); a.vst1 = v_st(32 + a.sr, a.sc);
    a.vb0 = OFF_V + v_rd_base(a.lane); return a;
}
}

__device__ __forceinline__ void fox_block(Frame& F, int L, int b, int h, int qb) {
    using namespace att;
    RELAUNDER();
    lptr lds = (lptr)F.ldsl; unsigned char* ws = arg_ws();
    const bf16_t* HID = (const bf16_t*)(ws + WS_HID); bf16_t* HN = (bf16_t*)(ws + WS_HN);
    const Lanes A = mk_lanes(F); const int tid = A.tid, wid = A.wid, r32 = A.r32, hi = A.hi;
    LAS float* tab = (LAS float*)(lds + OFF_WS) + wid * 64; LAS float* biasL = (LAS float*)(lds + OFF_BIAS);
    const int tok0 = qb * 256 + wid * 32, t = tok0 + r32;
    const float* cum = (const float*)(ws + WS_CUM) + (size_t)(b * 8 + h) * T;
    bf16x8 qr[8];
    const bf16_t* Kb = HID + (size_t)b * T * LDP + C_FK + h * 128; const bf16_t* Vb = HID + (size_t)b * T * LDP + C_FV + h * 128;
    const int ntiles = 4 * qb + 4;
    f32x16 o[4] = {}; float l = 0.f;
    const Dma D = dma_offs(wid, A.lane, LDP);
    const float NEG = -__builtin_inff();
#define FOX_TRANSFORM(P0, P1, J, SLOT) do { const LAS float* bl_ = biasL + (SLOT) * 64; \
        _Pragma("unroll") for (int g4 = 0; g4 < 4; ++g4) { const f32x4 ba = *(const LAS f32x4*)(bl_ + 8 * g4 + 4 * hi), bb = *(const LAS f32x4*)(bl_ + 32 + 8 * g4 + 4 * hi); \
            _Pragma("unroll") for (int e = 0; e < 4; ++e) { P0[4 * g4 + e] = fmaf(P0[4 * g4 + e], C2, ct2 + ba[e]); P1[4 * g4 + e] = fmaf(P1[4 * g4 + e], C2, ct2 + bb[e]); } } \
        if (64 * (J) + 63 > tok0) { const int dq_ = t - 64 * (J) - 4 * hi; \
            _Pragma("unroll") for (int r = 0; r < 16; ++r) { const int c = (r & 3) + 8 * (r >> 2); if (c > dq_) P0[r] = NEG; if (c + 32 > dq_) P1[r] = NEG; } } } while (0)
    float cb0 = 0.f, cb1 = 0.f;
    if (tid < 64) { cb0 = cum[tid]; cb1 = cum[64 + tid]; }
    __syncthreads();
    dma_tile2(D, Kb, Vb, lds, 0, 0, wid);
    dma_tile2(D, Kb + (size_t)64 * LDP, Vb + (size_t)64 * LDP, lds, 1, 1, wid);
    load_q_norm<false>(qr, HID + ((size_t)b * T + t) * LDP + C_FQ + h * 128 + hi * 8, arg_in(13) + L * 128, hi, t, nullptr, nullptr);
    const float ct2 = cum[t] * LOG2E - C2 * 12.0f * qrow_norm(qr);
    if (tid < 64) { biasL[tid] = -cb0 * LOG2E; biasL[64 + tid] = -cb1 * LOG2E; }
    asm volatile("s_waitcnt vmcnt(4)" ::: "memory"); __syncthreads();
    f32x16 pA0, pA1;
    { qkt(pA0, pA1, lds, 0, r32, hi, qr); FOX_TRANSFORM(pA0, pA1, 0, 0);
      DMA_WAIT(); __syncthreads(); }
    int vs = 1;
    for (int j = 1; j < ntiles; ++j) {
        const int vn = vs == 2 ? 0 : vs + 1, vp = vs == 0 ? 2 : vs - 1;
        if (j + 1 < ntiles) { dma_tile2(D, Kb + (size_t)(64 * (j + 1)) * LDP, Vb + (size_t)(64 * (j + 1)) * LDP, lds, (j + 1) & 1, vn, wid); if (tid < 64) biasL[vn * 64 + tid] = -cum[64 * (j + 1) + tid] * LOG2E; }
        f32x16 pB0, pB1;
        qkt(pB0, pB1, lds, j & 1, r32, hi, qr);
        float ps = 0.f;
#pragma unroll
        for (int r = 0; r < 16; ++r) { pA0[r] = __builtin_amdgcn_exp2f(pA0[r]); ps += pA0[r]; }
#pragma unroll
        for (int r = 0; r < 16; ++r) { pA1[r] = __builtin_amdgcn_exp2f(pA1[r]); ps += pA1[r]; }
        l += ps;
        bf16x8 pa0, pa1, pa2, pa3;
        PK4(pA0, 0, pa0); PK4(pA0, 8, pa1); PK4(pA1, 0, pa2); PK4(pA1, 8, pa3);
        pv_tile<0>(o, A.vb0 + vp * SHM_V, pa0, pa1, pa2, pa3);
        FOX_TRANSFORM(pB0, pB1, j, vs);
        pA0 = pB0; pA1 = pB1;
        DMA_WAIT(); __syncthreads();
        vs = vn;
    }
    {
        const int vp = vs == 0 ? 2 : vs - 1;
        float ps = 0.f;
#pragma unroll
        for (int r = 0; r < 16; ++r) { pA0[r] = __builtin_amdgcn_exp2f(pA0[r]); ps += pA0[r]; }
#pragma unroll
        for (int r = 0; r < 16; ++r) { pA1[r] = __builtin_amdgcn_exp2f(pA1[r]); ps += pA1[r]; }
        l += ps;
        bf16x8 pa0, pa1, pa2, pa3;
        PK4(pA0, 0, pa0); PK4(pA0, 8, pa1); PK4(pA1, 0, pa2); PK4(pA1, 8, pa3);
        SBAR();
        pv_tile<0>(o, A.vb0 + vp * SHM_V, pa0, pa1, pa2, pa3);
    }
#undef FOX_TRANSFORM
    l = xhalf_sum(l);
    if (hi == 0) tab[32 + r32] = 1.0f / l;
    asm volatile("s_waitcnt lgkmcnt(0)" ::: "memory");
    bf16_t* Ob = HN + ((size_t)b * T + tok0) * DM + 1024 + h * 128;
#define FOX_ROWPTR(rr) (Ob + (size_t)(rr) * DM)
    O_STORE(o, tab + 32, FOX_ROWPTR);
#undef FOX_ROWPTR
    asm volatile("s_waitcnt lgkmcnt(0)" ::: "memory");
}

#define NSA_ROWPTR(rr) (Ob + (size_t)((rr) >> 2) * 1024 + ((rr) & 3) * 128)
__device__ __forceinline__ void nsa_cmp_select(Frame& F, int L, int b, int kvh, int jq, const bf16x8* qr) {
    using namespace att;
    (void)L; RELAUNDER();
    lptr lds = (lptr)F.ldsl; unsigned char* ws = arg_ws();
    const bf16_t* HID = (const bf16_t*)(ws + WS_HID); const float* GF = (const float*)(ws + WS_GF);
    const Lanes A = mk_lanes(F); const int tid = A.tid, wid = A.wid, lane = A.lane, r32 = A.r32, hi = A.hi;
    LAS float* tab = (LAS float*)(lds + OFF_WS) + wid * 64;
    LAS float* PgL = (LAS float*)(lds + OFF_PG); LAS float* SC = (LAS float*)(lds + OFF_SC); LAS unsigned* SEL = (LAS unsigned*)(lds + OFF_SEL); LAS unsigned* UNI = (LAS unsigned*)(lds + OFF_UNI);
    const int tl = 8 * wid + (r32 >> 2), g = r32 & 3, t = 64 * jq + tl, hq = kvh * 4 + g;
    const size_t mrow = (size_t)b * T + t;
    const float NEG = -__builtin_inff();

    const float gt0 = GF[mrow * 32 + hq * 3 + 0];
    const bf16_t* KC = (const bf16_t*)(ws + WS_KC) + (size_t)(b * 2 + kvh) * 128 * 128; const bf16_t* VC = (const bf16_t*)(ws + WS_VC) + (size_t)(b * 2 + kvh) * 128 * 128;
    const bool two = jq >= 16;
    { Stg s0; stg_load(s0, KC, VC, 128, A.sr, A.sc);
      __syncthreads();
      stg_write(s0, lds, 0, 0, A.kws, A.vst0, A.vst1);
      if (two) { Stg s1; stg_load(s1, KC + 64 * 128, VC + 64 * 128, 128, A.sr, A.sc); stg_write(s1, lds, 1, 1, A.kws, A.vst0, A.vst1); }
      if (tid == 0) *UNI = 0u;
      __syncthreads(); }
    f32x16 a0, a1, b0, b1;
    qkt(a0, a1, lds, 0, r32, hi, qr);
    if (two) qkt(b0, b1, lds, 1, r32, hi, qr);
    else {
#pragma unroll
        for (int r = 0; r < 16; ++r) { b0[r] = NEG; b1[r] = NEG; } }
    const int cmax = (t - 31) >> 4; float mx = -1e30f;
#pragma unroll
    for (int r = 0; r < 16; ++r) { const int c = crow(r, hi);
        a0[r] = (c <= cmax) ? a0[r] * C2 : NEG; a1[r] = (c + 32 <= cmax) ? a1[r] * C2 : NEG; b0[r] = (c + 64 <= cmax) ? b0[r] * C2 : NEG; b1[r] = (c + 96 <= cmax) ? b1[r] * C2 : NEG;
        mx = fmaxf(mx, fmaxf(fmaxf(a0[r], a1[r]), fmaxf(b0[r], b1[r]))); }
    mx = xhalf_max(mx);
    float ps = 0.f;
#pragma unroll
    for (int r = 0; r < 16; ++r) { a0[r] = __builtin_amdgcn_exp2f(a0[r] - mx); a1[r] = __builtin_amdgcn_exp2f(a1[r] - mx); b0[r] = __builtin_amdgcn_exp2f(b0[r] - mx); b1[r] = __builtin_amdgcn_exp2f(b1[r] - mx);
        ps += (a0[r] + a1[r]) + (b0[r] + b1[r]); }
    ps = xhalf_sum(ps);
    const float inv = ps > 0.f ? 1.0f / ps : 0.f;
#pragma unroll
    for (int r = 0; r < 16; ++r) { a0[r] *= inv; a1[r] *= inv; b0[r] *= inv; b1[r] *= inv; }
#define QSUM(x) ({ float y_ = (x); y_ += __int_as_float(__builtin_amdgcn_update_dpp(0, __float_as_int(y_), 0xB1, 0xf, 0xf, false)); y_ += __int_as_float(__builtin_amdgcn_update_dpp(0, __float_as_int(y_), 0x4E, 0xf, 0xf, false)); y_; })
#pragma unroll
    for (int g4 = 0; g4 < 4; ++g4) {
        f32x4 va, vb, vc, vd;
#pragma unroll
        for (int e = 0; e < 4; ++e) { va[e] = QSUM(a0[4 * g4 + e]); vb[e] = QSUM(a1[4 * g4 + e]); vc[e] = QSUM(b0[4 * g4 + e]); vd[e] = QSUM(b1[4 * g4 + e]); }
        if (g == 0) { LAS float* pr = PgL + tl * 128 + 8 * g4 + 4 * hi; *(LAS f32x4*)pr = va; *(LAS f32x4*)(pr + 32) = vb; *(LAS f32x4*)(pr + 64) = vc; *(LAS f32x4*)(pr + 96) = vd; }
    }
#undef QSUM
    f32x16 o[4] = {};
    { bf16x8 pa0, pa1, pa2, pa3; PK4(a0, 0, pa0); PK4(a0, 8, pa1); PK4(a1, 0, pa2); PK4(a1, 8, pa3); SBAR(); pv_tile<0>(o, A.vb0, pa0, pa1, pa2, pa3); }
    if (two) { bf16x8 pa0, pa1, pa2, pa3; PK4(b0, 0, pa0); PK4(b0, 8, pa1); PK4(b1, 0, pa2); PK4(b1, 8, pa3); SBAR(); pv_tile<1>(o, A.vb0, pa0, pa1, pa2, pa3); }
    if (hi == 0) tab[32 + r32] = gt0;
    asm volatile("s_waitcnt lgkmcnt(0)" ::: "memory");
    { bf16_t* Ob = (bf16_t*)(ws + WS_NSA0) + ((size_t)b * T + 64 * jq + 8 * wid) * 1024 + kvh * 512;
      O_STORE(o, tab + 32, NSA_ROWPTR); }
    asm volatile("s_waitcnt lgkmcnt(0)" ::: "memory");
    __syncthreads();
#pragma unroll
    for (int i = 0; i < 4; ++i) { const int tok = (tid >> 5) + 16 * i, j = tid & 31; const LAS float* pr = PgL + tok * 128;
        float imp = pr[4 * j] + pr[4 * j + 1] + pr[4 * j + 2] + pr[4 * j + 3]; if (j > 0) imp += pr[4 * j - 1];
        const float scv = (j == 0 || j == jq || j == jq - 1) ? 1e9f : (j <= jq ? imp : -1e30f);
        SC[tok * 32 + j] = scv; }
    __syncthreads();
    unsigned uni_w = 0u;
#pragma unroll
    for (int i = 0; i < 4; ++i) { const int tok = (tid >> 5) + 16 * i, j = tid & 31; const float my = SC[tok * 32 + j]; int cnt = 0;
#pragma unroll
        for (int q = 0; q < 8; ++q) { const f32x4 v = *(const LAS f32x4*)(SC + tok * 32 + 4 * q);
#pragma unroll
            for (int e = 0; e < 4; ++e) { const int jj = 4 * q + e; cnt += (v[e] > my || (v[e] == my && jj < j)) ? 1 : 0; } }
        const unsigned long long bal = __ballot(cnt < 8);
        if ((lane & 31) == 0) SEL[tok] = (unsigned)(bal >> (lane & 32));
        uni_w |= (unsigned)bal | (unsigned)(bal >> 32); }
    if (lane == 0) atomicOr((unsigned*)UNI, uni_w);
    __syncthreads();
}
template <int MODE>
__device__ __forceinline__ void nsa_branch(Frame& F, int L, int b, int kvh, int jq, const bf16x8* qr) {
    using namespace att;
    (void)L; RELAUNDER();
    lptr lds = (lptr)F.ldsl; unsigned char* ws = arg_ws();
    const bf16_t* HID = (const bf16_t*)(ws + WS_HID); const float* GF = (const float*)(ws + WS_GF);
    const Lanes A = mk_lanes(F); const int wid = A.wid, r32 = A.r32, hi = A.hi;
    LAS float* tab = (LAS float*)(lds + OFF_WS) + wid * 64;
    LAS unsigned* SEL = (LAS unsigned*)(lds + OFF_SEL); LAS unsigned* UNI = (LAS unsigned*)(lds + OFF_UNI);
    const int tl = 8 * wid + (r32 >> 2), g = r32 & 3, t = 64 * jq + tl, hq = kvh * 4 + g;
    const size_t mrow = (size_t)b * T + t;
    const float NEG = -__builtin_inff();

    const float gt = GF[mrow * 32 + hq * 3 + MODE];
    const float sref = -C2 * 12.0f * qrow_norm(qr);
    const bf16_t* Kb = HID + (size_t)b * T * LDP + C_KV + MODE * 512 + kvh * 128; const bf16_t* Vb = Kb + 256;
    unsigned U, Uw = 0xFFFFFFFFu, selm = 0xFFFFFFFFu;
    if (MODE == 1) {
        const unsigned causal = (jq == 31) ? 0xFFFFFFFFu : ((2u << jq) - 1u);
        selm = SEL[tl] & causal;
        U = (unsigned)__builtin_amdgcn_readfirstlane((int)(*UNI & causal));
        unsigned uw = selm; uw |= __shfl_xor(uw, 4); uw |= __shfl_xor(uw, 8); uw |= __shfl_xor(uw, 16); uw |= __shfl_xor(uw, 32);
        Uw = (unsigned)__builtin_amdgcn_readfirstlane((int)uw);
    } else {
        const int jlo = jq >= 8 ? jq - 8 : 0;
        U = (jq == 31 ? 0xFFFFFFFFu : ((2u << jq) - 1u)) & ~((1u << jlo) - 1u);
    }
    f32x16 o[4] = {}; float l = 0.f;
#define NSA_TRANSFORM(P0, P1, J) do { const bool rowsel_ = (MODE == 1) ? (((selm >> (J)) & 1u) != 0u) : true; \
        const int dhi_ = ((J) == jq) ? (tl - 4 * hi) : 1000; const int dlo_ = (MODE == 2 && (J) == jq - 8) ? (tl - 4 * hi) : -1000; \
        _Pragma("unroll") for (int r = 0; r < 16; ++r) { const int c = (r & 3) + 8 * (r >> 2); \
            P0[r] = (rowsel_ && c <= dhi_ && c > dlo_) ? fmaf(P0[r], C2, sref) : NEG; P1[r] = (rowsel_ && c + 32 <= dhi_ && c + 32 > dlo_) ? fmaf(P1[r], C2, sref) : NEG; } } while (0)
    (void)Uw;
    unsigned rem = U; int j = __builtin_ctz(rem); rem &= rem - 1u;
    const Dma D = dma_offs(wid, A.lane, LDP);
    __syncthreads();
    dma_tile2(D, Kb + (size_t)(64 * j) * LDP, Vb + (size_t)(64 * j) * LDP, lds, 0, 0, wid);
    int jn = -1;
    if (rem) { jn = __builtin_ctz(rem); rem &= rem - 1u; dma_tile2(D, Kb + (size_t)(64 * jn) * LDP, Vb + (size_t)(64 * jn) * LDP, lds, 1, 1, wid);
               asm volatile("s_waitcnt vmcnt(4)" ::: "memory"); }
    else DMA_WAIT();
    __syncthreads();
    f32x16 pA0, pA1;
    { qkt(pA0, pA1, lds, 0, r32, hi, qr); NSA_TRANSFORM(pA0, pA1, j);
      DMA_WAIT(); __syncthreads(); }
    int vs = 1, n = 1;
    while (jn >= 0) {
        j = jn; jn = -1;
        const int vn = vs == 2 ? 0 : vs + 1, vp = vs == 0 ? 2 : vs - 1;
        if (rem) { jn = __builtin_ctz(rem); rem &= rem - 1u; dma_tile2(D, Kb + (size_t)(64 * jn) * LDP, Vb + (size_t)(64 * jn) * LDP, lds, (n + 1) & 1, vn, wid); }
        f32x16 pB0, pB1;
        qkt(pB0, pB1, lds, n & 1, r32, hi, qr);
        float ps = 0.f;
#pragma unroll
        for (int r = 0; r < 16; ++r) { pA0[r] = __builtin_amdgcn_exp2f(pA0[r]); ps += pA0[r]; }
#pragma unroll
        for (int r = 0; r < 16; ++r) { pA1[r] = __builtin_amdgcn_exp2f(pA1[r]); ps += pA1[r]; }
        l += ps;
        bf16x8 pa0, pa1, pa2, pa3;
        PK4(pA0, 0, pa0); PK4(pA0, 8, pa1); PK4(pA1, 0, pa2); PK4(pA1, 8, pa3);
        pv_tile<0>(o, A.vb0 + vp * SHM_V, pa0, pa1, pa2, pa3);
        NSA_TRANSFORM(pB0, pB1, j);
        pA0 = pB0; pA1 = pB1;
        DMA_WAIT(); __syncthreads();
        vs = vn; ++n;
    }
    {
        const int vp = vs == 0 ? 2 : vs - 1;
        float ps = 0.f;
#pragma unroll
        for (int r = 0; r < 16; ++r) { pA0[r] = __builtin_amdgcn_exp2f(pA0[r]); ps += pA0[r]; }
#pragma unroll
        for (int r = 0; r < 16; ++r) { pA1[r] = __builtin_amdgcn_exp2f(pA1[r]); ps += pA1[r]; }
        l += ps;
        bf16x8 pa0, pa1, pa2, pa3;
        PK4(pA0, 0, pa0); PK4(pA0, 8, pa1); PK4(pA1, 0, pa2); PK4(pA1, 8, pa3);
        SBAR();
        pv_tile<0>(o, A.vb0 + vp * SHM_V, pa0, pa1, pa2, pa3);
    }
#undef NSA_TRANSFORM
    l = xhalf_sum(l);
    if (hi == 0) tab[32 + r32] = gt / l;
    asm volatile("s_waitcnt lgkmcnt(0)" ::: "memory");
    { bf16_t* Ob = (bf16_t*)(ws + (MODE == 1 ? WS_NSA1 : WS_NSA2)) + ((size_t)b * T + 64 * jq + 8 * wid) * 1024 + kvh * 512;
      O_STORE(o, tab + 32, NSA_ROWPTR); }
    asm volatile("s_waitcnt lgkmcnt(0)" ::: "memory");
}
#undef NSA_ROWPTR

__device__ __forceinline__ void phase_attn(Frame& F, int L) {
    for (int it = F.vcu; it < 512; it += F.G) { const int b = it >> 5, h = (it >> 2) & 7, p = it & 3;
#if !defined(NO_FOX)
        for (int half = 0; half < 2; ++half) fox_block(F, L, b, h, half ? p : 7 - p);
#endif
    }
    STAMP(11);
    for (int rd = 0; rd * F.G < 1024; ++rd) { const int i = rd * F.G + ((rd & 1) ? (F.G - 1 - F.vcu) : F.vcu); if (i >= 1024) continue;
        const int jq = 31 - (i >> 5), rem = i & 31, b = rem >> 1, kvh = rem & 1;
#if !defined(NO_NSA)
        { using namespace att; RELAUNDER();
          const int wid_ = F.wave, r32_ = F.lane & 31, hi_ = F.lane >> 5, tl_ = 8 * wid_ + (r32_ >> 2), t_ = 64 * jq + tl_, hq_ = kvh * 4 + (r32_ & 3);
          const bf16_t* HID_ = (const bf16_t*)(arg_ws() + WS_HID); const float* rc_ = (const float*)(arg_ws() + WS_ROPE);
          bf16x8 qr[8];
          load_q_norm<true>(qr, HID_ + ((size_t)b * T + t_) * LDP + hq_ * 128 + hi_ * 8, arg_in(7) + L * 128, hi_, t_, rc_, rc_ + T * 16);
          nsa_cmp_select(F, L, b, kvh, jq, qr);
          nsa_branch<1>(F, L, b, kvh, jq, qr);
          nsa_branch<2>(F, L, b, kvh, jq, qr); }
#endif
    }
}

struct Args { const float* in[22]; float* out; unsigned char* ws; };
#define GRID_BAR() do { XcdBarrier bar_; bar_.bar = (unsigned*)(arg_ws() + WS_CTL) + CW_BAR; bar_.x = xb_xcc_id(); bar_.st = (volatile LAS unsigned*)(F.ldsl + MISC_OFF) + 8; xcd_barrier(bar_); RELAUNDER(); } while (0)
__global__ void __launch_bounds__(512, 2) mega_fwd(Args args) {
    extern __shared__ __attribute__((aligned(16))) unsigned char lds[];
    (void)args;
    Frame F;
    F.lds = lds; F.ldsl = (LAS unsigned char*)lds;
    F.tid = threadIdx.x; F.lane = F.tid & 63; F.wave = __builtin_amdgcn_readfirstlane(F.tid >> 6);
    F.G = gridDim.x; { const int bx = blockIdx.x; F.vcu = (F.G % 8 == 0) ? (bx % 8) * (F.G / 8) + bx / 8 : bx; }
    F.gw = F.vcu * 8 + F.wave; F.NGW = F.G * 8;
    for (int u = F.tid; u < (LDS_BYTES - LDSCTL_OFF) / 4; u += 512) ((LAS unsigned*)(F.ldsl + LDSCTL_OFF))[u] = 0u;
    __syncthreads();
    (void)xcd_barrier_post((unsigned*)(arg_ws() + WS_CTL) + CW_BAR, (volatile LAS unsigned*)(F.ldsl + MISC_OFF) + 8);
#if PROBE_MASK
    if (blockIdx.x == 0 && F.tid == 0) { volatile LAS unsigned long long* pa_ = (volatile LAS unsigned long long*)(F.ldsl + MISC_OFF + 64); const unsigned long long r0_ = __builtin_amdgcn_s_memrealtime(); pa_[15] = r0_; pa_[14] = r0_; pa_[13] = __builtin_amdgcn_s_memtime(); }
#endif
    for (int L = 0; L < NL; ++L) {
        for (int sb = 0; sb < 3; ++sb) {
            if (sb != 1) {
                const int first = (L == 0 && sb == 0);
                if (first) {
                    phase_convert(F, 0, F.gw, F.NGW);
                    phase_prenorm(F, arg_in(0), arg_in(1), (bf16_t*)(arg_ws() + WS_XB), (float*)(arg_ws() + WS_PS));
                    GRID_BAR(); STAMP(0);
                }
                { unsigned char* ws = arg_ws();
                  pg8::Gemm g{(const bf16_t*)(ws + WS_XB), (const bf16_t*)(ws + (size_t)(L & 1) * WSET + (sb == 0 ? WS_WGU : WS_WGU2)), M, 2 * DFF, DM}; pg8::StaticOrder S; S.init(M, 2 * DFF, F.G, (int)blockIdx.x);
                  pg8::EpiSwiglu E{(bf16_t*)(ws + WS_HID), DFF, (const float*)(ws + WS_PS) + (size_t)(L * 3 + sb) * M * 32, (LAS float*)(F.ldsl + RL_OFF), -1}; pg8::gemm_phase<pg8::EpiSwiglu, pg8::StaticOrder, true, true>(F.ldsl, g, S, E, F.tid); }
                GRID_BAR(); STAMP(1);
                { unsigned char* ws = arg_ws();
                  const bool last = (L == NL - 1 && sb == 2);
                  pg8::Gemm g{(const bf16_t*)(ws + WS_HID), (const bf16_t*)(ws + (size_t)(L & 1) * WSET + (sb == 0 ? WS_WD : WS_WD2)), M, DM, DFF}; pg8::StaticOrder S; S.init(M, DM, F.G, (int)blockIdx.x); S.rev = 1; S.wgm = 4;
                  pg8::EpiResid E{0.5f, last ? 1 : 0, sb == 0 ? L * 3 + 1 : (L + 1) * 3}; pg8::gemm_phase<pg8::EpiResid, pg8::StaticOrder, false, true>(F.ldsl, g, S, E, F.tid); }
                GRID_BAR(); STAMP(2);
            } else {
                { unsigned char* ws = arg_ws();
                  pg8::Gemm g{(const bf16_t*)(ws + WS_XB), (const bf16_t*)(ws + (size_t)(L & 1) * WSET + WS_WIN), M, NWIN, DM}; pg8::StaticOrder S; S.init(M, NWIN, F.G, (int)blockIdx.x);
                  pg8::EpiProj E{(bf16_t*)(ws + WS_HID), LDP, (float*)(ws + WS_GF), (const float*)(ws + WS_PS) + (size_t)(L * 3 + 1) * M * 32, (LAS float*)(F.ldsl + RL_OFF), -1}; pg8::gemm_phase<pg8::EpiProj, pg8::StaticOrder, true, true>(F.ldsl, g, S, E, F.tid); }
                GRID_BAR(); STAMP(4);
                phase_prep(F, L);
                GRID_BAR(); STAMP(5);
                { unsigned char* ws = arg_ws();
                  pg8::Gemm g{(const bf16_t*)(ws + WS_CMPA), (const bf16_t*)(ws + (size_t)(L & 1) * WSET + WS_WC1), 8192, 512, 4096}; pg8::CmpOrder S{F.G, (int)blockIdx.x};
                  pg8::EpiGeluCmp E{(bf16_t*)(ws + WS_CMPH)}; pg8::gemm_phase<pg8::EpiGeluCmp, pg8::CmpOrder, true, true>(F.ldsl, g, S, E, F.tid); }
                phase_scan(F);
                if (L + 1 < NL && blockIdx.x >= 32) phase_convert(F, L + 1, ((int)blockIdx.x - 32) * 8 + F.wave, (F.G - 32) * 8);
                GRID_BAR(); STAMP(6);
                phase_cmp2(F, L);
                GRID_BAR(); STAMP(7);
                phase_attn(F, L); STAMP(12);
                GRID_BAR(); STAMP(8);
                phase_outnorm(F, L);
                GRID_BAR(); STAMP(9);
                { unsigned char* ws = arg_ws();
                  pg8::Gemm g{(const bf16_t*)(ws + WS_HN), (const bf16_t*)(ws + (size_t)(L & 1) * WSET + WS_WOUT), M, DM, DM}; pg8::StaticOrder S; S.init(M, DM, F.G, (int)blockIdx.x); S.wgm = 4;
                  pg8::EpiResid E{1.0f, 0, L * 3 + 2};
                  pg8::gemm_phase<pg8::EpiResid, pg8::StaticOrder, false, true>(F.ldsl, g, S, E, F.tid); }
                GRID_BAR(); STAMP(10);
            }
        }
    }
#if PROBE_MASK
    if (blockIdx.x == 0 && F.tid == 0) {
        volatile LAS unsigned long long* pa_ = (volatile LAS unsigned long long*)(F.ldsl + MISC_OFF + 64);
        const unsigned long long r1 = __builtin_amdgcn_s_memrealtime(), c1 = __builtin_amdgcn_s_memtime();
        unsigned long long target = 0;
        if (PROBE_MASK & 0x10000) target = (unsigned long long)((float)(c1 - pa_[13]) / (float)(r1 - pa_[14]) * 100000.0f);
        else { for (int t_ = 0; t_ < 13; ++t_) if ((PROBE_MASK >> t_) & 1) target += pa_[t_]; target *= PROBE_K; }
        while (__builtin_amdgcn_s_memrealtime() - r1 < target) __builtin_amdgcn_s_sleep(32);
    }
#endif
}

extern "C" void kernel_launch(void* const* d_in, const int* in_sizes, int n_in, void* d_out, int out_size, void* d_ws, size_t ws_size, hipStream_t stream) {
    static int grid = 0;
    if (grid == 0) {
        if (n_in != 22 || out_size != M * DM || ws_size < WS_END) { fprintf(stderr, "kernel_launch: unexpected shapes (n_in %d out %d ws %zu)\n", n_in, out_size, ws_size); grid = -1; return; }
        int dev = 0, cus = 0, per_cu = 0;
        if (hipGetDevice(&dev) != hipSuccess || hipDeviceGetAttribute(&cus, hipDeviceAttributeMultiprocessorCount, dev) != hipSuccess) { grid = -1; return; }
        if (hipFuncSetAttribute((const void*)mega_fwd, hipFuncAttributeMaxDynamicSharedMemorySize, LDS_BYTES) != hipSuccess) { fprintf(stderr, "kernel_launch: hipFuncSetAttribute failed\n"); grid = -1; return; }
        if (hipOccupancyMaxActiveBlocksPerMultiprocessor(&per_cu, (const void*)mega_fwd, 512, LDS_BYTES) != hipSuccess || per_cu < 1) fprintf(stderr, "kernel_launch: occupancy query reports %d\n", per_cu);
        (void)hipGetLastError();
        grid = cus;
    }
    if (grid < 0) return;
    (void)in_sizes;
    if (hipMemsetAsync((char*)d_ws + WS_CTL, 0, CTL_ZERO_BYTES, stream) != hipSuccess) return;
    Args a{};
    for (int i = 0; i < 22; ++i) a.in[i] = (const float*)d_in[i];
    a.out = (float*)d_out; a.ws = (unsigned char*)d_ws;
    hipLaunchKernelGGL(mega_fwd, dim3(grid), dim3(512), LDS_BYTES, stream, a);
}
```
